# Optimizing an MI355X kernel written in HIP

```python
import math
import jax, jax.numpy as jnp
from jax import lax
import numpy as np

D_MODEL = 1024
BATCH = 8
SEQ = 2048
DEPTH = 2
DEC_BATCH = 8
DEC_SEQ = 64
PAST_LEN = 4096

CHUNK = 64
HEAD_DIM = 64
N_EVEN = (DEPTH + 1) // 2
N_ODD = DEPTH // 2
EPS = 1e-6
A_HEADS = 8
A_KV_HEADS = 2
A_GROUP = A_HEADS // A_KV_HEADS
WINDOW = 128
A_PREV_CHUNKS = WINDOW // CHUNK
T5_BUCKETS = 32
T5_MAX_DIST = 128
B_HEADS = 8
B_PREV_CHUNKS = 8
B_REACH = B_PREV_CHUNKS * CHUNK
B_MAX_REL = 128
C_WIDTH = 512
CONV_W = 3
D_HEADS = 8
D_Q_LORA = 256
D_KV_LORA = 128
D_NOPE = 64
D_ROPE = 32
D_V = 64
ROPE_THETA = 10000.0
Q_BLOCK = 128
FFN_DIM = 2816
A_Q = A_HEADS * HEAD_DIM
A_KV = A_KV_HEADS * HEAD_DIM
B_QKV = B_HEADS * HEAD_DIM
EVEN_IN = A_Q + 2 * A_KV + 3 * B_QKV
EVEN_MIX = A_Q + B_QKV
ODD_IN = 3 * C_WIDTH + D_Q_LORA + D_KV_LORA + D_ROPE
ODD_MIX = C_WIDTH + D_HEADS * D_V

kernel_name = "hybrid_streaming_encoder_step"


def rms_norm(x, g):
    xf = x.astype(jnp.float32)
    y = xf * lax.rsqrt(jnp.mean(xf * xf, axis=-1, keepdims=True) + EPS)
    return (y * g.astype(jnp.float32)).astype(x.dtype)


def split_cols(z, sizes):
    idx, acc = [], 0
    for s in sizes[:-1]:
        acc += s
        idx.append(acc)
    return jnp.split(z, idx, axis=-1)


def swiglu(h, w_gu, w_down):
    g, u = jnp.split(h @ w_gu, 2, axis=-1)
    return (jax.nn.silu(g) * u) @ w_down


def rope(x, pos):
    half = D_ROPE // 2
    inv = 1.0 / (ROPE_THETA ** (jnp.arange(half, dtype=jnp.float32) / half))
    ang = pos.astype(jnp.float32)[:, None] * inv[None, :]
    cos = jnp.cos(ang)[:, None, :]
    sin = jnp.sin(ang)[:, None, :]
    xf = x.astype(jnp.float32)
    x1, x2 = xf[..., :half], xf[..., half:]
    return jnp.concatenate([x1 * cos - x2 * sin, x1 * sin + x2 * cos], axis=-1).astype(x.dtype)


def t5_bucket(rel):
    nb = T5_BUCKETS // 2
    max_exact = nb // 2
    n = -rel
    ret = jnp.where(n < 0, nb, 0)
    n = jnp.abs(n)
    nf = jnp.maximum(n, 1).astype(jnp.float32)
    large = max_exact + (jnp.log(nf / max_exact) / math.log(T5_MAX_DIST / max_exact) * (nb - max_exact)).astype(jnp.int32)
    large = jnp.minimum(large, nb - 1)
    return ret + jnp.where(n < max_exact, n, large)


def t5_bias(table, q_pos, k_pos):
    b = table.astype(jnp.float32)[t5_bucket(k_pos[None, :] - q_pos[:, None])]
    return b.transpose(2, 0, 1).reshape(A_KV_HEADS, A_GROUP, q_pos.shape[0], k_pos.shape[0])


def rel_bias(table, q_pos, k_pos):
    idx = jnp.clip(k_pos[None, :] - q_pos[:, None], -B_MAX_REL, B_MAX_REL) + B_MAX_REL
    return table.astype(jnp.float32)[:, idx][:, None]


def chunk_visible(q_pos, k_pos, n_prev):
    qc = q_pos[:, None] // CHUNK
    kc = k_pos[None, :] // CHUNK
    m = (kc <= qc) & (k_pos[None, :] >= 0)
    if n_prev is not None:
        m = m & (kc >= qc - n_prev)
    return m


def attend(q, k, v, q_pos, k_pos, n_prev, bias=None, sinks=None):
    b, tq = q.shape[0], q.shape[1]
    s = jnp.einsum('bqkgd,bskd->bkgqs', q, k, preferred_element_type=jnp.float32) * (q.shape[-1] ** -0.5)
    if bias is not None:
        s = s + bias
    s = jnp.where(chunk_visible(q_pos, k_pos, n_prev), s, -jnp.inf)
    if sinks is None:
        p = jax.nn.softmax(s, axis=-1)
    else:
        sk = sinks.astype(jnp.float32)[None, :, :, None, None]
        m = jnp.maximum(jnp.max(s, axis=-1, keepdims=True), sk)
        e = jnp.exp(s - m)
        p = e / (jnp.sum(e, axis=-1, keepdims=True) + jnp.exp(sk - m))
    o = jnp.einsum('bkgqs,bskd->bqkgd', p.astype(v.dtype), v)
    return o.reshape(b, tq, -1)


def band_attention_prompt(q, k, v, n_prev, bias_fn, sinks):
    b, s = q.shape[0], q.shape[1]
    pad = n_prev * CHUNK
    band = pad + CHUNK
    kp = jnp.pad(k, ((0, 0), (pad, 0), (0, 0), (0, 0)))
    vp = jnp.pad(v, ((0, 0), (pad, 0), (0, 0), (0, 0)))

    def one_chunk(c):
        start = c * CHUNK
        qb = lax.dynamic_slice_in_dim(q, start, CHUNK, axis=1)
        kb = lax.dynamic_slice_in_dim(kp, start, band, axis=1)
        vb = lax.dynamic_slice_in_dim(vp, start, band, axis=1)
        q_pos = start + jnp.arange(CHUNK)
        k_pos = start - pad + jnp.arange(band)
        return attend(qb, kb, vb, q_pos, k_pos, n_prev, bias_fn(q_pos, k_pos), sinks)

    out = lax.map(one_chunk, jnp.arange(s // CHUNK))
    return out.transpose(1, 0, 2, 3).reshape(b, s, -1)


def even_qkv(h, p):
    b, t, _ = h.shape
    aq, ak, av, bq, bk, bv = split_cols(h @ p['w_in'], (A_Q, A_KV, A_KV, B_QKV, B_QKV, B_QKV))
    aq = rms_norm(aq.reshape(b, t, A_KV_HEADS, A_GROUP, HEAD_DIM), p['a_qn'])
    ak = rms_norm(ak.reshape(b, t, A_KV_HEADS, HEAD_DIM), p['a_kn'])
    av = av.reshape(b, t, A_KV_HEADS, HEAD_DIM)
    bq = rms_norm(bq.reshape(b, t, B_HEADS, 1, HEAD_DIM), p['b_qn'])
    bk = rms_norm(bk.reshape(b, t, B_HEADS, HEAD_DIM), p['b_kn'])
    bv = bv.reshape(b, t, B_HEADS, HEAD_DIM)
    return aq, ak, av, bq, bk, bv


def even_prompt(h, p, t5_table):
    s = h.shape[1]
    aq, ak, av, bq, bk, bv = even_qkv(h, p)
    sinks = p['a_sinks'].reshape(A_KV_HEADS, A_GROUP)
    ya = band_attention_prompt(aq, ak, av, A_PREV_CHUNKS, lambda qp, kp: t5_bias(t5_table, qp, kp), sinks)
    yb = band_attention_prompt(bq, bk, bv, B_PREV_CHUNKS, lambda qp, kp: rel_bias(p['b_rel'], qp, kp), None)
    y = jnp.concatenate([ya, yb], axis=-1) @ p['w_out']
    la, lb = min(WINDOW, s), min(B_REACH, s)
    return y, (ak[:, s - la:], av[:, s - la:], bk[:, s - lb:], bv[:, s - lb:])


def even_sample(h, p, t5_table, ck_a, cv_a, ck_b, cv_b):
    t = h.shape[1]
    la, lb = ck_a.shape[1], ck_b.shape[1]
    aq, ak, av, bq, bk, bv = even_qkv(h, p)
    q_pos = PAST_LEN + jnp.arange(t)
    ka = jnp.concatenate([ck_a, ak], axis=1)
    va = jnp.concatenate([cv_a, av], axis=1)
    kpa = jnp.concatenate([PAST_LEN - la + jnp.arange(la), q_pos])
    ya = attend(aq, ka, va, q_pos, kpa, A_PREV_CHUNKS, t5_bias(t5_table, q_pos, kpa), p['a_sinks'].reshape(A_KV_HEADS, A_GROUP))
    kb = jnp.concatenate([ck_b, bk], axis=1)
    vb = jnp.concatenate([cv_b, bv], axis=1)
    kpb = jnp.concatenate([PAST_LEN - lb + jnp.arange(lb), q_pos])
    yb = attend(bq, kb, vb, q_pos, kpb, B_PREV_CHUNKS, rel_bias(p['b_rel'], q_pos, kpb), None)
    y = jnp.concatenate([ya, yb], axis=-1) @ p['w_out']
    return y, (ka[:, -la:], va[:, -la:], kb[:, -lb:], vb[:, -lb:])


def odd_project(h, p, pos):
    b, t, _ = h.shape
    cb, cc, ch, qa, kva, kr = split_cols(h @ p['w_in'], (C_WIDTH, C_WIDTH, C_WIDTH, D_Q_LORA, D_KV_LORA, D_ROPE))
    u = cc * ch
    q = (rms_norm(qa, p['q_a_norm']) @ p['w_q_b']).reshape(b, t, D_HEADS, D_NOPE + D_ROPE)
    q = jnp.concatenate([rms_norm(q[..., :D_NOPE], p['qn_nope']),
                         rope(rms_norm(q[..., D_NOPE:], p['qn_rope']), pos)], axis=-1)
    ckv = rms_norm(kva, p['kv_a_norm'])
    kpe = rope(rms_norm(kr, p['kn_rope'])[:, :, None, :], pos)[:, :, 0, :]
    return cb, u, q[:, :, :, None, :], ckv, kpe


def short_conv(u, prev, w):
    t = u.shape[1]
    up = jnp.concatenate([prev, u], axis=1)
    y = w[0] * up[:, 0:t]
    for j in range(1, CONV_W):
        y = y + w[j] * up[:, j:j + t]
    return y, up[:, -(CONV_W - 1):]


def mla_keys(ckv, kpe, p):
    b, tk, _ = ckv.shape
    kv = (ckv @ p['w_kv_b']).reshape(b, tk, D_HEADS, D_NOPE + D_V)
    k = jnp.concatenate([rms_norm(kv[..., :D_NOPE], p['kn_nope']),
                         jnp.broadcast_to(kpe[:, :, None, :], (b, tk, D_HEADS, D_ROPE))], axis=-1)
    return k, kv[..., D_NOPE:]


def odd_prompt(h, p):
    b, s, _ = h.shape
    pos = jnp.arange(s)
    cb, u, q, ckv, kpe = odd_project(h, p, pos)
    yconv, conv_state = short_conv(u, jnp.zeros((b, CONV_W - 1, C_WIDTH), u.dtype), p['conv_w'])
    yc = cb * yconv
    k, v = mla_keys(ckv, kpe, p)

    def one_block(i):
        start = i * Q_BLOCK
        qb = lax.dynamic_slice_in_dim(q, start, Q_BLOCK, axis=1)
        return attend(qb, k, v, start + jnp.arange(Q_BLOCK), pos, None)

    yd = lax.map(one_block, jnp.arange(s // Q_BLOCK))
    yd = yd.transpose(1, 0, 2, 3).reshape(b, s, -1)
    y = jnp.concatenate([yc, yd], axis=-1) @ p['w_out']
    return y, (conv_state, ckv, kpe)


def odd_sample(h, p, conv_prev, c_ckv, c_kpe):
    t = h.shape[1]
    pos = PAST_LEN + jnp.arange(t)
    cb, u, q, ckv, kpe = odd_project(h, p, pos)
    yconv, conv_state = short_conv(u, conv_prev, p['conv_w'])
    yc = cb * yconv
    k, v = mla_keys(jnp.concatenate([c_ckv, ckv], axis=1), jnp.concatenate([c_kpe, kpe], axis=1), p)
    yd = attend(q, k, v, pos, jnp.arange(PAST_LEN + t), None)
    y = jnp.concatenate([yc, yd], axis=-1) @ p['w_out']
    return y, (conv_state, ckv, kpe)


def setup_inputs(seed: int = 0) -> dict:
    key = jax.random.key(seed)
    ks = jax.random.split(key, 48)
    cnt = [0]

    def nk():
        cnt[0] += 1
        return ks[cnt[0] - 1]

    def nrm(shape, scale):
        return jax.random.normal(nk(), shape, jnp.float32) * scale

    def gain(shape):
        return 1.0 + 0.02 * jax.random.normal(nk(), shape, jnp.float32)

    la = min(WINDOW, PAST_LEN)
    lb = min(B_REACH, PAST_LEN)
    return {
        'x_prompt': nrm((BATCH, SEQ, D_MODEL), 1.0),
        'x_sample': nrm((DEC_BATCH, DEC_SEQ, D_MODEL), 1.0),
        'cache_a_k': nrm((N_EVEN, DEC_BATCH, la, A_KV_HEADS, HEAD_DIM), 1.0),
        'cache_a_v': nrm((N_EVEN, DEC_BATCH, la, A_KV_HEADS, HEAD_DIM), 1.0),
        'cache_b_k': nrm((N_EVEN, DEC_BATCH, lb, B_HEADS, HEAD_DIM), 1.0),
        'cache_b_v': nrm((N_EVEN, DEC_BATCH, lb, B_HEADS, HEAD_DIM), 1.0),
        'state_c_conv': nrm((N_ODD, DEC_BATCH, CONV_W - 1, C_WIDTH), 1.0),
        'cache_d_ckv': nrm((N_ODD, DEC_BATCH, PAST_LEN, D_KV_LORA), 1.0),
        'cache_d_kpe': nrm((N_ODD, DEC_BATCH, PAST_LEN, D_ROPE), 1.0),
        'ff1_norm': gain((DEPTH, D_MODEL)),
        'ff1_w_gu': nrm((DEPTH, D_MODEL, 2 * FFN_DIM), D_MODEL ** -0.5),
        'ff1_w_down': nrm((DEPTH, FFN_DIM, D_MODEL), FFN_DIM ** -0.5),
        'mix_norm': gain((DEPTH, D_MODEL)),
        'ff2_norm': gain((DEPTH, D_MODEL)),
        'ff2_w_gu': nrm((DEPTH, D_MODEL, 2 * FFN_DIM), D_MODEL ** -0.5),
        'ff2_w_down': nrm((DEPTH, FFN_DIM, D_MODEL), FFN_DIM ** -0.5),
        't5_bias_table': nrm((T5_BUCKETS, A_HEADS), 0.5),
        'ev_w_in': nrm((N_EVEN, D_MODEL, EVEN_IN), D_MODEL ** -0.5),
        'ev_w_out': nrm((N_EVEN, EVEN_MIX, D_MODEL), EVEN_MIX ** -0.5),
        'a_q_norm': gain((N_EVEN, HEAD_DIM)),
        'a_k_norm': gain((N_EVEN, HEAD_DIM)),
        'a_sinks': nrm((N_EVEN, A_HEADS), 1.0),
        'b_q_norm': gain((N_EVEN, HEAD_DIM)),
        'b_k_norm': gain((N_EVEN, HEAD_DIM)),
        'b_rel_bias': nrm((N_EVEN, B_HEADS, 2 * B_MAX_REL + 1), 0.5),
        'od_w_in': nrm((N_ODD, D_MODEL, ODD_IN), D_MODEL ** -0.5),
        'od_w_out': nrm((N_ODD, ODD_MIX, D_MODEL), ODD_MIX ** -0.5),
        'c_conv_w': nrm((N_ODD, CONV_W, C_WIDTH), CONV_W ** -0.5),
        'd_q_a_norm': gain((N_ODD, D_Q_LORA)),
        'd_w_q_b': nrm((N_ODD, D_Q_LORA, D_HEADS * (D_NOPE + D_ROPE)), D_Q_LORA ** -0.5),
        'd_kv_a_norm': gain((N_ODD, D_KV_LORA)),
        'd_w_kv_b': nrm((N_ODD, D_KV_LORA, D_HEADS * (D_NOPE + D_V)), D_KV_LORA ** -0.5),
        'd_q_nope_norm': gain((N_ODD, D_NOPE)),
        'd_q_rope_norm': gain((N_ODD, D_ROPE)),
        'd_k_nope_norm': gain((N_ODD, D_NOPE)),
        'd_k_rope_norm': gain((N_ODD, D_ROPE)),
    }


def reference(x_prompt, x_sample, cache_a_k, cache_a_v, cache_b_k, cache_b_v, state_c_conv, cache_d_ckv, cache_d_kpe,
              ff1_norm, ff1_w_gu, ff1_w_down, mix_norm, ff2_norm, ff2_w_gu, ff2_w_down, t5_bias_table,
              ev_w_in, ev_w_out, a_q_norm, a_k_norm, a_sinks, b_q_norm, b_k_norm, b_rel_bias,
              od_w_in, od_w_out, c_conv_w, d_q_a_norm, d_w_q_b, d_kv_a_norm, d_w_kv_b,
              d_q_nope_norm, d_q_rope_norm, d_k_nope_norm, d_k_rope_norm):
    xp, xs = x_prompt, x_sample
    st = {n: [] for n in ('akp', 'avp', 'bkp', 'bvp', 'cp', 'ckvp', 'kpep',
                          'aks', 'avs', 'bks', 'bvs', 'cs', 'ckvs', 'kpes')}
    for l in range(DEPTH):
        i = l // 2
        xp = xp + 0.5 * swiglu(rms_norm(xp, ff1_norm[l]), ff1_w_gu[l], ff1_w_down[l])
        xs = xs + 0.5 * swiglu(rms_norm(xs, ff1_norm[l]), ff1_w_gu[l], ff1_w_down[l])
        hp = rms_norm(xp, mix_norm[l])
        hs = rms_norm(xs, mix_norm[l])
        if l % 2 == 0:
            p = {'w_in': ev_w_in[i], 'w_out': ev_w_out[i], 'a_qn': a_q_norm[i], 'a_kn': a_k_norm[i],
                 'a_sinks': a_sinks[i], 'b_qn': b_q_norm[i], 'b_kn': b_k_norm[i], 'b_rel': b_rel_bias[i]}
            yp, (akp, avp, bkp, bvp) = even_prompt(hp, p, t5_bias_table)
            ys, (aks, avs, bks, bvs) = even_sample(hs, p, t5_bias_table, cache_a_k[i], cache_a_v[i],
                                                   cache_b_k[i], cache_b_v[i])
            for n, a in (('akp', akp), ('avp', avp), ('bkp', bkp), ('bvp', bvp),
                         ('aks', aks), ('avs', avs), ('bks', bks), ('bvs', bvs)):
                st[n].append(a)
        else:
            p = {'w_in': od_w_in[i], 'w_out': od_w_out[i], 'conv_w': c_conv_w[i], 'q_a_norm': d_q_a_norm[i],
                 'w_q_b': d_w_q_b[i], 'kv_a_norm': d_kv_a_norm[i], 'w_kv_b': d_w_kv_b[i],
                 'qn_nope': d_q_nope_norm[i], 'qn_rope': d_q_rope_norm[i],
                 'kn_nope': d_k_nope_norm[i], 'kn_rope': d_k_rope_norm[i]}
            yp, (cp, ckvp, kpep) = odd_prompt(hp, p)
            ys, (cs, ckvs, kpes) = odd_sample(hs, p, state_c_conv[i], cache_d_ckv[i], cache_d_kpe[i])
            for n, a in (('cp', cp), ('ckvp', ckvp), ('kpep', kpep), ('cs', cs), ('ckvs', ckvs), ('kpes', kpes)):
                st[n].append(a)
        xp = xp + yp
        xs = xs + ys
        xp = xp + 0.5 * swiglu(rms_norm(xp, ff2_norm[l]), ff2_w_gu[l], ff2_w_down[l])
        xs = xs + 0.5 * swiglu(rms_norm(xs, ff2_norm[l]), ff2_w_gu[l], ff2_w_down[l])
    return (xp, xs,
            jnp.stack(st['akp']), jnp.stack(st['avp']), jnp.stack(st['bkp']), jnp.stack(st['bvp']),
            jnp.stack(st['cp']), jnp.stack(st['ckvp']), jnp.stack(st['kpep']),
            jnp.stack(st['aks']), jnp.stack(st['avs']), jnp.stack(st['bks']), jnp.stack(st['bvs']),
            jnp.stack(st['cs']), jnp.stack(st['ckvs']), jnp.stack(st['kpes']))
```

```cpp
#include <hip/hip_runtime.h>
#include <cstdio>
#include <cstdint>
#define GAS __attribute__((address_space(1)))
#define LAS __attribute__((address_space(3)))
typedef unsigned short bf16;
typedef unsigned v4u __attribute__((ext_vector_type(4)));
typedef float f32x4 __attribute__((ext_vector_type(4)));
typedef short bf16x8 __attribute__((ext_vector_type(8)));
typedef GAS unsigned gu32;
typedef GAS unsigned long long gu64;
#define RLX_AGENT __ATOMIC_RELAXED, __HIP_MEMORY_SCOPE_AGENT
#define LDS_WAIT() asm volatile("s_waitcnt lgkmcnt(0)" ::: "memory")
#define VM_WAIT() asm volatile("s_waitcnt vmcnt(0)" ::: "memory")
__device__ __forceinline__ unsigned long long rt() { return __builtin_amdgcn_s_memrealtime(); }
__device__ __forceinline__ unsigned f2bf(float f) { unsigned u = __builtin_bit_cast(unsigned, f); return (u + 0x7fffu + ((u >> 16) & 1u)) >> 16; }
__device__ __forceinline__ unsigned pk2(float lo, float hi) { return f2bf(lo) | (f2bf(hi) << 16); }
typedef float f32x2v __attribute__((ext_vector_type(2)));
#define XB_TMO      128
#define XB_XCNT(j)  (256  + 64 * (j))
#define XB_XSUB(j)  (1280 + 64 * (j))
#define XB_XGEN(j)  (2304 + 64 * (j))
#define XB_TOP      3328
#define XB_TOPGEN   3392
#define XCD_BAR_WORDS 3456
#define XB_SPIN_CAP (1u << 18)

__device__ __forceinline__ unsigned xb_ld(unsigned* p)              { return __hip_atomic_load(p, __ATOMIC_RELAXED, __HIP_MEMORY_SCOPE_AGENT); }
__device__ __forceinline__ unsigned xb_add(unsigned* p, unsigned v) { return __hip_atomic_fetch_add(p, v, __ATOMIC_RELAXED, __HIP_MEMORY_SCOPE_AGENT); }
__device__ __forceinline__ unsigned xb_xcc_id() { return (unsigned)__builtin_amdgcn_s_getreg((3 << 11) | 20) & 0xFu; }
#define XB_SPIN(cond, bar) do { unsigned _sp = 0; while (cond) { __builtin_amdgcn_s_sleep(1); \
    if ((++_sp & 255u) == 0u) { if (xb_ld(&(bar)[XB_TMO])) break; if (_sp > XB_SPIN_CAP) { atomicAdd(&(bar)[XB_TMO], 1u); break; } } } } while (0)

struct XcdBarrier {
    unsigned* bar; unsigned x; unsigned w0;
    volatile LAS unsigned* st;
};

__device__ __forceinline__ XcdBarrier xcd_barrier_post(unsigned* bar, volatile LAS unsigned* st) {
    XcdBarrier b; b.bar = bar; b.x = xb_xcc_id(); b.st = st;
    if (threadIdx.x == 0) (void)xb_add(&bar[XB_XCNT(b.x)], 1u);
    return b;
}
__device__ __forceinline__ void xcd_barrier_complete(unsigned* bar, unsigned x, unsigned& nloc, unsigned& nx) {
    const unsigned G = gridDim.x * gridDim.y * gridDim.z;
    unsigned sum, cnt, mine, sp = 0u;
    for (;;) {
        sum = 0u; cnt = 0u; mine = 0u;
#pragma unroll
        for (unsigned j = 0; j < 16; ++j) { const unsigned c = xb_ld(&bar[XB_XCNT(j)]); sum += c; cnt += (c > 0u) ? 1u : 0u; mine = (j == x) ? c : mine; }
        if (sum == G) break;
        __builtin_amdgcn_s_sleep(1);
        if ((++sp & 255u) == 0u) { if (xb_ld(&bar[XB_TMO])) break; if (sp > XB_SPIN_CAP) { atomicAdd(&bar[XB_TMO], 1u); break; } }
    }
    nloc = mine > 0u ? mine : 1u; nx = cnt > 0u ? cnt : 1u;
}

__device__ __forceinline__ void xcd_barrier(const XcdBarrier& b) {
    asm volatile("s_waitcnt vmcnt(0)" ::: "memory");
    __syncthreads();
    if (b.w0 && __builtin_amdgcn_mbcnt_hi(~0u, __builtin_amdgcn_mbcnt_lo(~0u, 0u)) == 0u) {
        unsigned* bar = b.bar;
        __builtin_amdgcn_s_waitcnt(0);
        unsigned nloc = b.st[0], nx = b.st[1];
        if (nloc == 0u) { xcd_barrier_complete(bar, b.x, nloc, nx); b.st[0] = nloc; b.st[1] = nx; }
        const unsigned old = xb_add(&bar[XB_XSUB(b.x)], 1u);
        const unsigned gen = old / nloc;
        if (old + 1u == (gen + 1u) * nloc) {
            __builtin_amdgcn_fence(__ATOMIC_RELEASE, "agent");
            asm volatile("s_waitcnt vmcnt(0)" ::: "memory");
            const unsigned og = xb_add(&bar[XB_TOP], 1u);
            const unsigned tg = og / nx;
            if (og + 1u == (tg + 1u) * nx) xb_add(&bar[XB_TOPGEN], 1u);
            else XB_SPIN(xb_ld(&bar[XB_TOPGEN]) == tg, bar);
            __builtin_amdgcn_fence(__ATOMIC_ACQUIRE, "agent");
            xb_add(&bar[XB_XGEN(b.x)], 1u);
            asm volatile("s_waitcnt vmcnt(0)" ::: "memory");
        } else {
            XB_SPIN(xb_ld(&bar[XB_XGEN(b.x)]) == gen, bar);
            __builtin_amdgcn_fence(__ATOMIC_ACQUIRE, "agent");
            asm volatile("s_waitcnt vmcnt(0)" ::: "memory");
        }
    }
    __syncthreads();
}
namespace pg8 {
#define PG8_LAS __attribute__((address_space(3)))
typedef unsigned short bf16_t;
typedef short bf16x8 __attribute__((ext_vector_type(8)));
typedef float f32x4 __attribute__((ext_vector_type(4)));
typedef unsigned u32x4 __attribute__((ext_vector_type(4)));
constexpr int BM = 256, BK = 64, HALF = 128, HTB = HALF * BK * 2  , STAGE_BYTES = 8 * HTB, NXCD = 8, WGM = 8;

__host__ __device__ __forceinline__ int lds_byte(int r, int c) { const int st = (r >> 4) * 2 + (c >> 5), rr = r & 15, cc = c & 31, ob = rr * 64 + cc * 2; return st * 1024 + (ob ^ (((ob >> 9) & 1) << 5)); }
__host__ __device__ __forceinline__ void stage_rc(int b, int& R, int& C) { const int st = b / 1024, sb = b % 1024, swz = sb ^ (((sb >> 9) & 1) << 5); R = (st >> 1) * 16 + swz / 64; C = (st & 1) * 32 + (swz % 64) / 2; }
__host__ __device__ __forceinline__ int perm32(int rho) { const int n = rho >> 4, i = rho & 15; return 8 * (i >> 2) + 4 * n + (i & 3); }

struct Unit { int pm, pn; };
struct Gemm { const bf16_t* A; const bf16_t* Bt; int M, N, K; };

struct StaticOrder {
    int nM, nN, nwg, G, c;
    __host__ __device__ void init(int M, int N, int G_, int c_) { nM = M / BM; nN = N / BM; nwg = nM * nN; G = G_; c = c_; }
    __host__ __device__ bool next(int i, Unit& u) const {
        const long L = (long)i * G + c; if (L >= nwg) return false;
        int wgid = (int)L; { const int q = nwg / NXCD, r = nwg % NXCD, xcd = wgid % NXCD, off = wgid / NXCD; wgid = (xcd < r ? xcd * (q + 1) : r * (q + 1) + (xcd - r) * q) + off; }
        const int nig = WGM * nN, gid = wgid / nig, fm = gid * WGM, gsz = (nM - fm) < WGM ? (nM - fm) : WGM;
        u.pm = fm + ((wgid % nig) % gsz); u.pn = (wgid % nig) / gsz; return true;
    }
    __device__ __forceinline__ void a_ready(const Unit&) const {}
    __device__ __forceinline__ void done(const Unit&) const {}
};

__device__ __forceinline__ unsigned cvt_pk_bf16(float lo, float hi) { unsigned r; asm volatile("v_cvt_pk_bf16_f32 %0, %1, %2" : "=v"(r) : "v"(lo), "v"(hi)); return r; }
typedef float f32x2 __attribute__((ext_vector_type(2)));
template <class Epi, class Sched, bool ALIGN_EPI = false, bool SP2 = false>
__device__ __forceinline__ void gemm_phase(PG8_LAS unsigned char* lds, const Gemm g, const Sched& S, const Epi& E, const int wid  ) {
    int lane_ = (int)__builtin_amdgcn_mbcnt_hi(~0u, __builtin_amdgcn_mbcnt_lo(~0u, 0u)); asm volatile("" : "+v"(lane_));
    const int lane = lane_, tid = wid * 64 + lane, wr = wid >> 2, wc = wid & 3, fr = lane & 15, fq = lane >> 4;
    int K_ = g.K; asm volatile("" : "+s"(K_));
    const int K = K_, nt = K / BK;
    unsigned voffA[2], voffB[2];
#pragma unroll
    for (int i = 0; i < 2; ++i) { int R, C; stage_rc(tid * 16 + i * 8192, R, C); const int Rb = Epi::PERM ? ((R & ~31) + perm32(R & 31)) : R;
        voffA[i] = (unsigned)(R * K + C) * 2u; voffB[i] = (unsigned)(Rb * K + C) * 2u; }
    const size_t kstep = (size_t)(BK * 2);
    const size_t hstep = (size_t)HALF * K * 2;
    const size_t tstep = 2 * hstep;
    const unsigned ldsw = (unsigned)wid * 1024u;
    const int aoff = lds_byte(wr * 64 + fr, fq * 8), boff = lds_byte(wc * 32 + fr, fq * 8);
#define PG8_SA(b, h) (((b) * 2 + (h)) * HTB)
#define PG8_SB(b, h) ((4 + (b) * 2 + (h)) * HTB)
#define PG8_STAGE(bufoff, gbase, voff) do { _Pragma("unroll") for (int _i = 0; _i < 2; ++_i) \
        __builtin_amdgcn_global_load_lds((const unsigned*)((const char*)(gbase) + (voff)[_i]), (PG8_LAS unsigned*)(lds + (bufoff) + ldsw + _i * 8192), 16, 0, 0); } while (0)
#define PG8_LDA(dst, b, h) do { _Pragma("unroll") for (int m = 0; m < 4; ++m) _Pragma("unroll") for (int k = 0; k < 2; ++k) dst[m][k] = *(const PG8_LAS bf16x8*)(lds + PG8_SA(b, h) + aoff + m * 2048 + k * 1024); } while (0)
#define PG8_LDB(dst, b, h) do { _Pragma("unroll") for (int n = 0; n < 2; ++n) _Pragma("unroll") for (int k = 0; k < 2; ++k) dst[n][k] = *(const PG8_LAS bf16x8*)(lds + PG8_SB(b, h) + boff + n * 2048 + k * 1024); } while (0)
#define PG8_MMA(ai, bj, At, Bt) do { __builtin_amdgcn_s_setprio(1); _Pragma("unroll") for (int m = 0; m < 4; ++m) _Pragma("unroll") for (int n = 0; n < 2; ++n) _Pragma("unroll") for (int k = 0; k < 2; ++k) \
        acc[ai][bj][m][n] = __builtin_amdgcn_mfma_f32_16x16x32_bf16(Bt[n][k], At[m][k], acc[ai][bj][m][n], 0, 0, 0); __builtin_amdgcn_s_setprio(0); } while (0)
#define PG8_WAIT_V(n) asm volatile("s_waitcnt vmcnt(" #n ")" ::: "memory")
#define PG8_WAIT_L(n) asm volatile("s_waitcnt lgkmcnt(" #n ")" ::: "memory")
#define PG8_BAR __builtin_amdgcn_s_barrier()
#define PG8_SCHED __builtin_amdgcn_sched_barrier(0)
    Unit cur, nxt; int ui = 0;
    if (!S.next(0, cur)) return;
    f32x4 acc[2][2][4][2];
#pragma unroll
    for (int a = 0; a < 2; ++a)
#pragma unroll
        for (int b = 0; b < 2; ++b)
#pragma unroll
            for (int m = 0; m < 4; ++m)
#pragma unroll
                for (int n = 0; n < 2; ++n) acc[a][b][m][n] = (f32x4){0.f, 0.f, 0.f, 0.f};
    bf16x8 At[4][2], B0[2][2], B1[2][2];
    const char* cA = (const char*)g.A + (size_t)cur.pm * tstep; const char* cB = (const char*)g.Bt + (size_t)cur.pn * tstep;
    S.a_ready(cur);
    if constexpr (SP2) {
        PG8_STAGE(PG8_SB(0, 0), cB, voffB); PG8_STAGE(PG8_SB(0, 1), cB + hstep, voffB); PG8_STAGE(PG8_SA(0, 0), cA, voffA); PG8_STAGE(PG8_SA(0, 1), cA + hstep, voffA);
        if (wr == 1) PG8_BAR;
        PG8_WAIT_V(2); PG8_BAR;
        PG8_STAGE(PG8_SB(1, 0), cB + kstep, voffB); PG8_STAGE(PG8_SA(1, 0), cA + kstep, voffA); PG8_STAGE(PG8_SB(1, 1), cB + hstep + kstep, voffB);
        PG8_WAIT_V(6); PG8_BAR;
    } else {
        PG8_STAGE(PG8_SB(0, 0), cB, voffB); PG8_STAGE(PG8_SA(0, 0), cA, voffA); PG8_STAGE(PG8_SB(0, 1), cB + hstep, voffB); PG8_STAGE(PG8_SA(0, 1), cA + hstep, voffA);
        if (wr == 1) PG8_BAR;
        PG8_WAIT_V(4); PG8_BAR;
        PG8_STAGE(PG8_SB(1, 0), cB + kstep, voffB); PG8_STAGE(PG8_SA(1, 0), cA + kstep, voffA); PG8_STAGE(PG8_SB(1, 1), cB + hstep + kstep, voffB);
        PG8_WAIT_V(6); PG8_BAR;
    }
    for (;;) {
        const bool has_next = S.next(ui + 1, nxt);
        const char* nA = has_next ? (const char*)g.A + (size_t)nxt.pm * tstep : cA; const char* nB = has_next ? (const char*)g.Bt + (size_t)nxt.pn * tstep : cB;
        for (int t = 0; t < nt; t += 2) {
            const bool last = (t == nt - 2);
            const char* a1 = cA + (size_t)(t + 1) * kstep;
            const char* a2 = last ? nA : cA + (size_t)(t + 2) * kstep; const char* b2 = last ? nB : cB + (size_t)(t + 2) * kstep;
            const char* a3 = a2 + kstep; const char* b3 = b2 + kstep;
            if (last && has_next) S.a_ready(nxt);
            if constexpr (SP2) {
            PG8_LDB(B0, 0, 0); PG8_LDB(B1, 0, 1); PG8_SCHED; PG8_LDA(At, 0, 0); PG8_STAGE(PG8_SA(1, 1), a1 + hstep, voffA);
            PG8_WAIT_V(8); PG8_WAIT_L(0); PG8_BAR; PG8_MMA(0, 0, At, B0); PG8_MMA(0, 1, At, B1); PG8_BAR; PG8_SCHED;
            PG8_LDA(At, 0, 1); PG8_STAGE(PG8_SB(0, 0), b2, voffB); PG8_STAGE(PG8_SB(0, 1), b2 + hstep, voffB); PG8_STAGE(PG8_SA(0, 0), a2, voffA);
            PG8_WAIT_V(8); PG8_WAIT_L(0); PG8_BAR; PG8_MMA(1, 0, At, B0); PG8_MMA(1, 1, At, B1); PG8_BAR; PG8_SCHED;
            PG8_LDB(B0, 1, 0); PG8_LDB(B1, 1, 1); PG8_SCHED; PG8_LDA(At, 1, 0); PG8_STAGE(PG8_SA(0, 1), a2 + hstep, voffA);
            PG8_WAIT_V(8); PG8_WAIT_L(0); PG8_BAR; PG8_MMA(0, 0, At, B0); PG8_MMA(0, 1, At, B1); PG8_BAR; PG8_SCHED;
            PG8_LDA(At, 1, 1); PG8_STAGE(PG8_SB(1, 0), b3, voffB); PG8_STAGE(PG8_SB(1, 1), b3 + hstep, voffB); PG8_STAGE(PG8_SA(1, 0), a3, voffA);
            PG8_WAIT_V(8); PG8_WAIT_L(0); PG8_BAR; PG8_MMA(1, 0, At, B0); PG8_MMA(1, 1, At, B1); PG8_BAR; PG8_SCHED;
            } else {
            PG8_LDB(B0, 0, 0); PG8_SCHED; PG8_LDA(At, 0, 0); PG8_STAGE(PG8_SA(1, 1), a1 + hstep, voffA);
            PG8_WAIT_L(8); PG8_BAR; PG8_WAIT_L(0); PG8_MMA(0, 0, At, B0); PG8_BAR; PG8_SCHED;
            PG8_LDB(B1, 0, 1); PG8_STAGE(PG8_SB(0, 0), b2, voffB);
            PG8_BAR; PG8_WAIT_L(0); PG8_MMA(0, 1, At, B1); PG8_BAR;
            PG8_LDA(At, 0, 1); PG8_STAGE(PG8_SA(0, 0), a2, voffA);
            PG8_BAR; PG8_WAIT_L(0); PG8_MMA(1, 0, At, B0); PG8_BAR; PG8_SCHED;
            PG8_STAGE(PG8_SB(0, 1), b2 + hstep, voffB);
            PG8_WAIT_V(6); PG8_BAR; PG8_MMA(1, 1, At, B1); PG8_BAR;
            PG8_LDB(B0, 1, 0); PG8_SCHED; PG8_LDA(At, 1, 0); PG8_STAGE(PG8_SA(0, 1), a2 + hstep, voffA);
            PG8_WAIT_L(8); PG8_BAR; PG8_WAIT_L(0); PG8_MMA(0, 0, At, B0); PG8_BAR; PG8_SCHED;
            PG8_LDB(B1, 1, 1); PG8_STAGE(PG8_SB(1, 0), b3, voffB);
            PG8_BAR; PG8_WAIT_L(0); PG8_MMA(0, 1, At, B1); PG8_BAR;
            PG8_LDA(At, 1, 1); PG8_STAGE(PG8_SA(1, 0), a3, voffA);
            PG8_BAR; PG8_WAIT_L(0); PG8_MMA(1, 0, At, B0); PG8_BAR; PG8_SCHED;
            PG8_STAGE(PG8_SB(1, 1), b3 + hstep, voffB);
            PG8_WAIT_V(6); PG8_BAR; PG8_MMA(1, 1, At, B1); PG8_BAR;
            }
        }
        if constexpr (ALIGN_EPI) { if (wr == 0) PG8_BAR; }
        if constexpr (!Epi::AFTER_DRAIN) { E(acc, cur, wr, wc, fr, fq); S.done(cur); }
        if (!has_next) break;
#pragma unroll
        for (int a = 0; a < 2; ++a)
#pragma unroll
            for (int b = 0; b < 2; ++b)
#pragma unroll
                for (int m = 0; m < 4; ++m)
#pragma unroll
                    for (int n = 0; n < 2; ++n) acc[a][b][m][n] = (f32x4){0.f, 0.f, 0.f, 0.f};
        cur = nxt; cA = nA; cB = nB; ++ui;
        if constexpr (ALIGN_EPI) { if (wr == 1) PG8_BAR; }
    }
    PG8_WAIT_V(0);
    if constexpr (!ALIGN_EPI) { if (wr == 0) PG8_BAR; }
    PG8_BAR;
    if constexpr (Epi::AFTER_DRAIN) { E.fused(acc, cur, wr, wc, fr, fq, lds, wid, lane); S.done(cur); }
#undef PG8_SA
#undef PG8_SB
#undef PG8_STAGE
#undef PG8_LDA
#undef PG8_LDB
#undef PG8_MMA
#undef PG8_WAIT_V
#undef PG8_WAIT_L
#undef PG8_BAR
#undef PG8_SCHED
}
}

constexpr int DM = 1024, NB = 8, SEQ = 2048, TP = NB * SEQ, DSEQ = 64, TS = NB * DSEQ, T = TP + TS, PAST = 4096;
constexpr int FF = 2816, NGU = 2 * FF;
constexpr int EV_IN = 2304, OD_IN = 1952, OD_INP = 2048;
constexpr float EPS = 1e-6f;
constexpr float LOG2E = 1.4426950408889634f;
constexpr float QS64 = 0.125f * LOG2E;
constexpr float QS96 = 0.10206207261596575f * LOG2E;

constexpr size_t O_Y = 0;
constexpr size_t O_AKP = (size_t)T * DM;
constexpr size_t O_AVP = O_AKP + 131072;
constexpr size_t O_BKP = O_AVP + 131072;
constexpr size_t O_BVP = O_BKP + 2097152;
constexpr size_t O_CP = O_BVP + 2097152;
constexpr size_t O_CKVP = O_CP + 8192;
constexpr size_t O_KPEP = O_CKVP + 2097152;
constexpr size_t O_AKS = O_KPEP + 524288;
constexpr size_t O_AVS = O_AKS + 131072;
constexpr size_t O_BKS = O_AVS + 131072;
constexpr size_t O_BVS = O_BKS + 2097152;
constexpr size_t O_CS = O_BVS + 2097152;
constexpr size_t O_CKVS = O_CS + 8192;
constexpr size_t O_KPES = O_CKVS + 65536;
constexpr size_t O_END = O_KPES + 16384;

constexpr size_t MiB = 1u << 20;
constexpr size_t WS_CTL = 0, CTL_ZERO_BYTES = 2 * MiB;
constexpr int CW_BAR = 4096;
constexpr size_t WS_ROWSQ = 65536;
constexpr size_t ROWSQ_STRIDE = (size_t)T * 4;
constexpr size_t WS_TAB = 2 * MiB;
constexpr size_t TAB_BIASA = 0, TAB_BIASB = 8192, TAB_ROPE = 32768;
constexpr int NPOS = 2112;
constexpr size_t WS_W = 3 * MiB;
constexpr size_t W_GU_BYTES = (size_t)NGU * DM * 2, W_D_BYTES = (size_t)DM * FF * 2;
constexpr size_t W_GU0 = 0;
constexpr size_t W_D0 = 4 * W_GU_BYTES;
constexpr size_t W_EVIN = W_D0 + 4 * W_D_BYTES;
constexpr size_t W_EVOUT = W_EVIN + (size_t)EV_IN * DM * 2;
constexpr size_t W_ODIN = W_EVOUT + (size_t)DM * DM * 2;
constexpr size_t W_ODOUT = W_ODIN + (size_t)OD_INP * DM * 2;
constexpr size_t W_QB = W_ODOUT + (size_t)DM * DM * 2;
constexpr size_t W_KVB = W_QB + (size_t)768 * 256 * 2;
constexpr size_t W_KVP = W_KVB + (size_t)1024 * 256 * 2;
constexpr size_t W_END = W_KVP + (size_t)1024 * 128 * 2;
static_assert(W_END <= 80 * MiB, "weights");
constexpr size_t WS_XB = 83 * MiB;
constexpr size_t WS_R = 116 * MiB;
constexpr size_t R_H = 0;
constexpr size_t R_QKV = 0;
constexpr size_t R_CAK = 96 * MiB, R_CAV = R_CAK + 262144, R_CBK = R_CAV + 262144, R_CBV = R_CBK + 4194304;
constexpr size_t R_MIX = 105 * MiB;
constexpr size_t R_U = 0;
constexpr size_t R_QA = R_U + (size_t)T * 512 * 2;
constexpr size_t R_KVA = R_QA + (size_t)T * 256 * 2;
constexpr size_t R_KPE = R_KVA + (size_t)T * 256 * 2;
constexpr size_t R_QD = R_KPE + (size_t)T * 32 * 2;
constexpr size_t R_KD = R_QD + (size_t)T * 768 * 2;
constexpr size_t R_VD = R_KD + (size_t)TP * 512 * 2;
constexpr size_t R_CKVS = R_VD + (size_t)TP * 512 * 2;
constexpr size_t R_PART = R_CKVS + (size_t)TS * 128 * 2;
constexpr int NSPLIT = 8;
constexpr size_t PART_BYTES = (size_t)64 * 66 * 4;
constexpr size_t R_PART_END = R_PART + (size_t)NB * 8 * NSPLIT * PART_BYTES;
static_assert(R_CBV + 4194304 <= R_MIX && R_PART_END <= R_MIX && (size_t)T * FF * 2 <= R_CAK, "region R map");
constexpr size_t WS_END = WS_R + R_MIX + (size_t)T * DM * 2;
static_assert(WS_END <= 256 * MiB, "workspace");

constexpr int RING_OFF = 0, RING_BYTES = 131072;
constexpr int LDSCTL_OFF = RING_BYTES, MISC_OFF = LDSCTL_OFF + 320;
constexpr int LDS_BYTES = 147456;
constexpr int NWAVES = 8;

namespace ep {
using pg8::f32x4; using pg8::u32x4; using pg8::Unit; using pg8::bf16_t;
typedef unsigned u32x2 __attribute__((ext_vector_type(2)));
__device__ __forceinline__ unsigned pkbf(float lo, float hi) { return pg8::cvt_pk_bf16(lo, hi); }
__device__ __forceinline__ u32x4 pack8(const float* v) { u32x4 w; w.x = pkbf(v[0], v[1]); w.y = pkbf(v[2], v[3]); w.z = pkbf(v[4], v[5]); w.w = pkbf(v[6], v[7]); return w; }
__device__ __forceinline__ float red_fq(float s) { s += __shfl_xor(s, 16); s += __shfl_xor(s, 32); return s; }
struct Ctx { unsigned char* ws; float* out; const float* const* in; };
#define EP_OPEN() int z_ = 0; asm volatile("" : "+s"(z_)); asm volatile("" : "+v"(fr), "+v"(fq)); unsigned char* const ws_ = C.ws + z_; float* const out = C.out + z_; const float* const* const in_ = C.in + z_; (void)ws_; (void)out; (void)in_
#define EPW(T_, off) ((T_*)(ws_ + (off)))
__device__ __forceinline__ int pos_index(int row) { return row < TP ? (row & (SEQ - 1)) : SEQ + ((row - TP) & (DSEQ - 1)); }

struct EpiGU {
    static constexpr bool PERM = false, AFTER_DRAIN = false;
    Ctx C; int rsi;
    __device__ __forceinline__ void operator()(const f32x4 (&acc)[2][2][4][2], const Unit& u, int wr, int wc, int fr, int fq) const {
        EP_OPEN(); bf16_t* const H = EPW(bf16_t, WS_R + R_H); const float* const rowsq = EPW(float, WS_ROWSQ + (size_t)rsi * ROWSQ_STRIDE);
#pragma unroll
        for (int ai = 0; ai < 2; ++ai)
#pragma unroll
            for (int m = 0; m < 4; ++m) {
                const int row = u.pm * 256 + ai * 128 + wr * 64 + m * 16 + fr;
                const float r = __builtin_amdgcn_rsqf(rowsq[row] * (1.0f / DM) + EPS);
                float hv[8];
#pragma unroll
                for (int n = 0; n < 2; ++n)
#pragma unroll
                    for (int e = 0; e < 4; ++e) { const float g = acc[ai][0][m][n][e] * r, uu = acc[ai][1][m][n][e] * r;
                        hv[4 * n + e] = g * uu * __builtin_amdgcn_rcpf(1.0f + __builtin_amdgcn_exp2f(-g * LOG2E)); }
                *(u32x4*)(H + (size_t)row * FF + u.pn * 128 + wc * 32 + 8 * fq) = pack8(hv);
                asm volatile("" ::: "memory");
            }
    }
};

struct EpiResid {
    static constexpr bool PERM = false, AFTER_DRAIN = false;
    Ctx C; int first, last, rsi; float alpha;
    __device__ __forceinline__ void operator()(const f32x4 (&acc)[2][2][4][2], const Unit& u, int wr, int wc, int fr, int fq) const {
        EP_OPEN(); float* const xout = out; const float* const xin_p = first ? in_[0] : out; const float* const xin_s = first ? in_[1] : out + (size_t)TP * DM;
        bf16_t* const xb = last ? nullptr : EPW(bf16_t, WS_XB); float* const rowsq = last ? nullptr : EPW(float, WS_ROWSQ + (size_t)rsi * ROWSQ_STRIDE);
#pragma unroll
        for (int ai = 0; ai < 2; ++ai)
#pragma unroll
            for (int m = 0; m < 4; ++m) {
                const int row = u.pm * 256 + ai * 128 + wr * 64 + m * 16 + fr;
                const float* src = row < TP ? xin_p + (size_t)row * DM : xin_s + (size_t)(row - TP) * DM;
                float ss = 0.f;
#pragma unroll
                for (int bj = 0; bj < 2; ++bj) {
                    const int col = u.pn * 256 + bj * 128 + wc * 32 + 8 * fq;
                    const f32x4 x0 = *(const f32x4*)(src + col), x1 = *(const f32x4*)(src + col + 4);
                    const f32x4 v0 = x0 + acc[ai][bj][m][0] * alpha, v1 = x1 + acc[ai][bj][m][1] * alpha;
                    *(f32x4*)(xout + (size_t)row * DM + col) = v0; *(f32x4*)(xout + (size_t)row * DM + col + 4) = v1;
                    if (xb) { u32x4 w; w.x = pkbf(v0[0], v0[1]); w.y = pkbf(v0[2], v0[3]); w.z = pkbf(v1[0], v1[1]); w.w = pkbf(v1[2], v1[3]); *(u32x4*)(xb + (size_t)row * DM + col) = w; }
                    ss += (v0[0] * v0[0] + v0[1] * v0[1]) + (v0[2] * v0[2] + v0[3] * v0[3]) + (v1[0] * v1[0] + v1[1] * v1[1]) + (v1[2] * v1[2] + v1[3] * v1[3]);
                }
                if (rowsq) { ss = red_fq(ss); if (fq == 0) atomicAdd(rowsq + row, ss); }
                asm volatile("" ::: "memory");
            }
    }
};

struct EpiEvIn {
    static constexpr bool PERM = false, AFTER_DRAIN = false;
    Ctx C;
    __device__ __forceinline__ void operator()(const f32x4 (&acc)[2][2][4][2], const Unit& u, int wr, int wc, int fr, int fq) const {
        EP_OPEN(); bf16_t* const QKV = EPW(bf16_t, WS_R + R_QKV); const float* const rowsq = EPW(float, WS_ROWSQ + 1 * ROWSQ_STRIDE);
        const int hs = 4 * u.pn + wc;
        const float* gp = hs < 8 ? in_[19] : hs < 10 ? in_[20] : hs < 12 ? nullptr : hs < 20 ? in_[22] : hs < 28 ? in_[23] : nullptr;
        const float qs = (hs < 8 || (hs >= 12 && hs < 20)) ? QS64 : 1.0f;
        float gv[2][8];
#pragma unroll
        for (int bj = 0; bj < 2; ++bj)
#pragma unroll
            for (int j = 0; j < 8; ++j) gv[bj][j] = gp ? gp[32 * bj + 8 * fq + j] * qs : 1.0f;
        int kind = 0; int hh = 0;
        if (hs >= 8 && hs < 10) { kind = 1; hh = hs - 8; } else if (hs >= 10 && hs < 12) { kind = 2; hh = hs - 10; } else if (hs >= 20 && hs < 28) { kind = 3; hh = hs - 20; } else if (hs >= 28) { kind = 4; hh = hs - 28; }
#pragma unroll
        for (int ai = 0; ai < 2; ++ai)
#pragma unroll
            for (int m = 0; m < 4; ++m) {
                const int row = u.pm * 256 + ai * 128 + wr * 64 + m * 16 + fr;
                const float r = __builtin_amdgcn_rsqf(rowsq[row] * (1.0f / DM) + EPS);
                float v[2][8]; float ss = 0.f;
#pragma unroll
                for (int bj = 0; bj < 2; ++bj)
#pragma unroll
                    for (int n = 0; n < 2; ++n)
#pragma unroll
                        for (int e = 0; e < 4; ++e) { const float x = acc[ai][bj][m][n][e] * r; v[bj][4 * n + e] = x; ss += x * x; }
                if (gp) { ss = red_fq(ss); const float r2 = __builtin_amdgcn_rsqf(ss * (1.0f / 64.0f) + EPS);
#pragma unroll
                    for (int bj = 0; bj < 2; ++bj)
#pragma unroll
                        for (int j = 0; j < 8; ++j) v[bj][j] = v[bj][j] * r2 * gv[bj][j]; }
#pragma unroll
                for (int bj = 0; bj < 2; ++bj) *(u32x4*)(QKV + (size_t)row * EV_IN + 64 * hs + 32 * bj + 8 * fq) = pack8(v[bj]);
                if (kind) {
                    float* dst = nullptr;
                    if (row < TP) { const int b = row >> 11, t = row & (SEQ - 1);
                        if (kind <= 2) { if (t >= SEQ - 128) dst = out + (kind == 1 ? O_AKP : O_AVP) + ((size_t)(b * 128 + t - (SEQ - 128)) * 2 + hh) * 64; }
                        else { if (t >= SEQ - 512) dst = out + (kind == 3 ? O_BKP : O_BVP) + ((size_t)(b * 512 + t - (SEQ - 512)) * 8 + hh) * 64; }
                    } else { const int b = (row - TP) >> 6, t = (row - TP) & 63;
                        if (kind <= 2) dst = out + (kind == 1 ? O_AKS : O_AVS) + ((size_t)(b * 128 + 64 + t) * 2 + hh) * 64;
                        else dst = out + (kind == 3 ? O_BKS : O_BVS) + ((size_t)(b * 512 + 448 + t) * 8 + hh) * 64;
                    }
                    if (dst) {
#pragma unroll
                        for (int bj = 0; bj < 2; ++bj) { float* d = dst + 32 * bj + 8 * fq;
                            *(f32x4*)d = (f32x4){v[bj][0], v[bj][1], v[bj][2], v[bj][3]}; *(f32x4*)(d + 4) = (f32x4){v[bj][4], v[bj][5], v[bj][6], v[bj][7]}; }
                    }
                }
                asm volatile("" ::: "memory");
            }
    }
};

__device__ __forceinline__ void rope8(float (&v)[8], int fq, const float* ropetab, int pidx) {
    const float* ct = ropetab + (size_t)pidx * 16 + 8 * (fq & 1); const float* st = ct + (size_t)NPOS * 16;
#pragma unroll
    for (int j = 0; j < 8; ++j) { const float other = __shfl_xor(v[j], 32); const float c = ct[j], s = st[j];
        v[j] = fq < 2 ? v[j] * c - other * s : other * s + v[j] * c; }
}

struct EpiOdIn {
    static constexpr bool PERM = false, AFTER_DRAIN = false;
    Ctx C;
    __device__ __forceinline__ void operator()(const f32x4 (&acc)[2][2][4][2], const Unit& u, int wr, int wc, int fr, int fq) const {
        EP_OPEN(); bf16_t* const MIX = EPW(bf16_t, WS_R + R_MIX); bf16_t* const U = EPW(bf16_t, WS_R + R_U); bf16_t* const QA = EPW(bf16_t, WS_R + R_QA); bf16_t* const KVA = EPW(bf16_t, WS_R + R_KVA); bf16_t* const KPE = EPW(bf16_t, WS_R + R_KPE);
        const float* const rowsq = EPW(float, WS_ROWSQ + 4 * ROWSQ_STRIDE); float* const rsq_qa = EPW(float, WS_ROWSQ + 6 * ROWSQ_STRIDE); float* const rsq_kva = EPW(float, WS_ROWSQ + 7 * ROWSQ_STRIDE);
        const float* const knr = in_[35]; const float* const ropetab = EPW(float, WS_TAB + TAB_ROPE);
        const int pn = u.pn;
#pragma unroll
        for (int ai = 0; ai < 2; ++ai)
#pragma unroll
            for (int m = 0; m < 4; ++m) {
                const int row = u.pm * 256 + ai * 128 + wr * 64 + m * 16 + fr;
                const float r = __builtin_amdgcn_rsqf(rowsq[row] * (1.0f / DM) + EPS);
                float v[2][8];
#pragma unroll
                for (int bj = 0; bj < 2; ++bj)
#pragma unroll
                    for (int n = 0; n < 2; ++n)
#pragma unroll
                        for (int e = 0; e < 4; ++e) v[bj][4 * n + e] = acc[ai][bj][m][n][e] * r;
                if (pn < 2) {
#pragma unroll
                    for (int bj = 0; bj < 2; ++bj) *(u32x4*)(MIX + (size_t)row * DM + 256 * pn + 128 * bj + 32 * wc + 8 * fq) = pack8(v[bj]);
                } else if (pn < 6) {
                    float uu[8];
#pragma unroll
                    for (int j = 0; j < 8; ++j) uu[j] = v[0][j] * v[1][j];
                    const int idx = 128 * (pn - 2) + 32 * wc + 8 * fq;
                    *(u32x4*)(U + (size_t)row * 512 + idx) = pack8(uu);
                    float* dst = nullptr;
                    if (row < TP) { const int b = row >> 11, t = row & (SEQ - 1); if (t >= SEQ - 2) dst = out + O_CP + (size_t)(b * 2 + t - (SEQ - 2)) * 512 + idx; }
                    else { const int b = (row - TP) >> 6, t = (row - TP) & 63; if (t >= 62) dst = out + O_CS + (size_t)(b * 2 + t - 62) * 512 + idx; }
                    if (dst) { *(f32x4*)dst = (f32x4){uu[0], uu[1], uu[2], uu[3]}; *(f32x4*)(dst + 4) = (f32x4){uu[4], uu[5], uu[6], uu[7]}; }
                } else if (pn == 6) {
                    float ss = 0.f;
#pragma unroll
                    for (int bj = 0; bj < 2; ++bj) { *(u32x4*)(QA + (size_t)row * 256 + 128 * bj + 32 * wc + 8 * fq) = pack8(v[bj]);
#pragma unroll
                        for (int j = 0; j < 8; ++j) ss += v[bj][j] * v[bj][j]; }
                    ss = red_fq(ss); if (fq == 0) atomicAdd(rsq_qa + row, ss);
                } else {
                    float ss = 0.f;
#pragma unroll
                    for (int j = 0; j < 8; ++j) ss += v[0][j] * v[0][j];
                    *(u32x4*)(KVA + (size_t)row * 256 + 32 * wc + 8 * fq) = pack8(v[0]);
                    *(u32x4*)(KVA + (size_t)row * 256 + 128 + 32 * wc + 8 * fq) = (u32x4){0u, 0u, 0u, 0u};
                    ss = red_fq(ss); if (fq == 0) atomicAdd(rsq_kva + row, ss);
                    if (wc == 0) {
                        float s2 = 0.f;
#pragma unroll
                        for (int j = 0; j < 8; ++j) s2 += v[1][j] * v[1][j];
                        s2 = red_fq(s2); const float r2 = __builtin_amdgcn_rsqf(s2 * (1.0f / 32.0f) + EPS);
                        float k[8];
#pragma unroll
                        for (int j = 0; j < 8; ++j) k[j] = v[1][j] * r2 * knr[8 * fq + j];
                        rope8(k, fq, ropetab, pos_index(row));
                        float* dst = row < TP ? out + O_KPEP + (size_t)row * 32 + 8 * fq : out + O_KPES + (size_t)(row - TP) * 32 + 8 * fq;
                        *(f32x4*)dst = (f32x4){k[0], k[1], k[2], k[3]}; *(f32x4*)(dst + 4) = (f32x4){k[4], k[5], k[6], k[7]};
                        *(u32x4*)(KPE + (size_t)row * 32 + 8 * fq) = pack8(k);
                    }
                }
                asm volatile("" ::: "memory");
            }
    }
};

struct EpiQb {
    static constexpr bool PERM = false, AFTER_DRAIN = false;
    Ctx C;
    __device__ __forceinline__ void operator()(const f32x4 (&acc)[2][2][4][2], const Unit& u, int wr, int wc, int fr, int fq) const {
        EP_OPEN(); bf16_t* const QD = EPW(bf16_t, WS_R + R_QD); const float* const rsq_qa = EPW(float, WS_ROWSQ + 6 * ROWSQ_STRIDE); const float* const qnn = in_[32]; const float* const qnr = in_[33]; const float* const ropetab = EPW(float, WS_TAB + TAB_ROPE);
        const int pn = u.pn;
        float gv[2][8];
#pragma unroll
        for (int bj = 0; bj < 2; ++bj)
#pragma unroll
            for (int j = 0; j < 8; ++j) gv[bj][j] = (pn < 2 ? qnn[32 * bj + 8 * fq + j] : qnr[8 * fq + j]) * QS96;
#pragma unroll
        for (int ai = 0; ai < 2; ++ai)
#pragma unroll
            for (int m = 0; m < 4; ++m) {
                const int row = u.pm * 256 + ai * 128 + wr * 64 + m * 16 + fr;
                const float r = __builtin_amdgcn_rsqf(rsq_qa[row] * (1.0f / 256.0f) + EPS);
                float v[2][8]; float ss[2] = {0.f, 0.f};
#pragma unroll
                for (int bj = 0; bj < 2; ++bj)
#pragma unroll
                    for (int n = 0; n < 2; ++n)
#pragma unroll
                        for (int e = 0; e < 4; ++e) { const float x = acc[ai][bj][m][n][e] * r; v[bj][4 * n + e] = x; ss[bj] += x * x; }
                if (pn < 2) {
                    const float s = red_fq(ss[0] + ss[1]); const float r2 = __builtin_amdgcn_rsqf(s * (1.0f / 64.0f) + EPS);
                    const int head = 4 * pn + wc;
#pragma unroll
                    for (int bj = 0; bj < 2; ++bj) {
#pragma unroll
                        for (int j = 0; j < 8; ++j) v[bj][j] = v[bj][j] * r2 * gv[bj][j];
                        *(u32x4*)(QD + (size_t)row * 768 + head * 96 + 32 * bj + 8 * fq) = pack8(v[bj]); }
                } else {
                    const int pidx = pos_index(row);
#pragma unroll
                    for (int bj = 0; bj < 2; ++bj) {
                        const float s = red_fq(ss[bj]); const float r2 = __builtin_amdgcn_rsqf(s * (1.0f / 32.0f) + EPS);
#pragma unroll
                        for (int j = 0; j < 8; ++j) v[bj][j] = v[bj][j] * r2 * gv[bj][j];
                        rope8(v[bj], fq, ropetab, pidx);
                        const int head = 2 * wc + bj;
                        *(u32x4*)(QD + (size_t)row * 768 + head * 96 + 64 + 8 * fq) = pack8(v[bj]); }
                }
                asm volatile("" ::: "memory");
            }
    }
};

struct EpiKvb {
    static constexpr bool PERM = false, AFTER_DRAIN = false;
    Ctx C;
    __device__ __forceinline__ void operator()(const f32x4 (&acc)[2][2][4][2], const Unit& u, int wr, int wc, int fr, int fq) const {
        EP_OPEN(); bf16_t* const KD = EPW(bf16_t, WS_R + R_KD); bf16_t* const VD = EPW(bf16_t, WS_R + R_VD); const float* const rsq_kva = EPW(float, WS_ROWSQ + 7 * ROWSQ_STRIDE); const float* const knn = in_[34];
        const int head = 2 * u.pn + (wc >> 1), part = wc & 1;
        float gv[2][8];
#pragma unroll
        for (int bj = 0; bj < 2; ++bj)
#pragma unroll
            for (int j = 0; j < 8; ++j) gv[bj][j] = knn[32 * bj + 8 * fq + j];
#pragma unroll
        for (int ai = 0; ai < 2; ++ai)
#pragma unroll
            for (int m = 0; m < 4; ++m) {
                const int row = u.pm * 256 + ai * 128 + wr * 64 + m * 16 + fr;
                const float r = __builtin_amdgcn_rsqf(rsq_kva[row] * (1.0f / 128.0f) + EPS);
                float v[2][8]; float ss = 0.f;
#pragma unroll
                for (int bj = 0; bj < 2; ++bj)
#pragma unroll
                    for (int n = 0; n < 2; ++n)
#pragma unroll
                        for (int e = 0; e < 4; ++e) { const float x = acc[ai][bj][m][n][e] * r; v[bj][4 * n + e] = x; ss += x * x; }
                if (part == 0) { ss = red_fq(ss); const float r2 = __builtin_amdgcn_rsqf(ss * (1.0f / 64.0f) + EPS);
#pragma unroll
                    for (int bj = 0; bj < 2; ++bj)
#pragma unroll
                        for (int j = 0; j < 8; ++j) v[bj][j] = v[bj][j] * r2 * gv[bj][j]; }
                bf16_t* dst = (part == 0 ? KD : VD) + (size_t)row * 512 + head * 64 + 8 * fq;
#pragma unroll
                for (int bj = 0; bj < 2; ++bj) *(u32x4*)(dst + 32 * bj) = pack8(v[bj]);
                asm volatile("" ::: "memory");
            }
    }
};
}

typedef unsigned u32x2t __attribute__((ext_vector_type(2)));
struct Frame {
    LAS unsigned char* lds;
    volatile LAS unsigned* MISC;
    gu32* ctl;
    int vcu, G, wave_s;
    const float* const* in;
    float* out; unsigned char* ws;
};
#define WSP(T_, off) ((T_*)(F.ws + (off)))
#define LOCAL_IDS() int lane_ = (int)__builtin_amdgcn_mbcnt_hi(~0u, __builtin_amdgcn_mbcnt_lo(~0u, 0u)); asm volatile("" : "+v"(lane_)); const int lane = lane_; const int wave = F.wave_s; const int tid = wave * 64 + lane; (void)tid
__device__ __forceinline__ float wave_sum(float v) {
#pragma unroll
    for (int o = 1; o < 64; o <<= 1) v += __shfl_xor(v, o);
    return v;
}

struct WMat { const float* W; int K, Nsrc; bf16* dst; int Kdst, ngroups; const float* gain; int kind; int natural; };
__device__ __forceinline__ int wsrc_base(int kind, int G) {
    const int pn = G >> 3, bj = (G >> 2) & 1, wc = G & 3;
    switch (kind) {
    case 0: return 32 * G;
    case 1: return bj * FF + 128 * pn + 32 * wc;
    case 2: return 256 * pn + 64 * wc + 32 * bj;
    case 3: if (pn < 2) return 32 * G; if (pn < 6) return (bj ? 1024 : 512) + 128 * (pn - 2) + 32 * wc; if (pn == 6) return 1536 + 128 * bj + 32 * wc;
            return bj == 0 ? 1792 + 32 * wc : (wc == 0 ? 1920 : -1);
    case 4: if (pn < 2) return 96 * (4 * pn + wc) + 32 * bj; return 96 * (2 * wc + bj) + 64;
    default: return 128 * (2 * pn + (wc >> 1)) + 64 * (wc & 1) + 32 * bj;
    }
}
__device__ __forceinline__ void wconv_item(const WMat& M, int item, LAS float* scr, int lane) {
    const int nkb = M.Kdst / 64, G = item / nkb, kb = item % nkb, k0 = 64 * kb;
    const int sb = wsrc_base(M.kind, G);
    const bool zero = (sb < 0) || (k0 >= M.K);
    if (!zero) {
#pragma unroll 8
        for (int i = 0; i < 32; ++i) { const int kk = 2 * i + (lane >> 5); float w = M.W[(size_t)(k0 + kk) * M.Nsrc + sb + (lane & 31)]; if (M.gain) w *= M.gain[k0 + kk]; scr[kk * 33 + (lane & 31)] = w; }
    }
    LDS_WAIT(); asm volatile("" ::: "memory");
    const int c = lane & 7;
#pragma unroll
    for (int j = 0; j < 4; ++j) { const int rho = (lane >> 3) + 8 * j; const int n = M.natural ? rho : pg8::perm32(rho); const LAS float* s = scr + (8 * c) * 33 + n;
        v4u o; if (zero) o = (v4u){0u, 0u, 0u, 0u}; else { o.x = pk2(s[0 * 33], s[1 * 33]); o.y = pk2(s[2 * 33], s[3 * 33]); o.z = pk2(s[4 * 33], s[5 * 33]); o.w = pk2(s[6 * 33], s[7 * 33]); }
        *(GAS v4u*)(M.dst + (size_t)(32 * G + rho) * M.Kdst + k0 + 8 * c) = o; }
    LDS_WAIT(); asm volatile("" ::: "memory");
}

__device__ __forceinline__ int t5_bucket(int rel) {
    int n = -rel; int ret = n < 0 ? 16 : 0; n = n < 0 ? -n : n;
    if (n < 8) return ret + n;
    const int q = (n * n) >> 6; int lg = 31 - __builtin_clz(q); int large = 8 + lg; if (large > 15) large = 15;
    return ret + large;
}

__device__ __forceinline__ WMat get_mat(const Frame& F, int mi) {
    const float* const* in = F.in; WMat M;
    if (mi < 8) { const int l = mi >> 2, f = (mi >> 1) & 1;
        if ((mi & 1) == 0) { M.W = (f ? in[14] : in[10]) + (size_t)l * DM * NGU; M.K = DM; M.Nsrc = NGU; M.dst = (bf16*)(F.ws + WS_W + W_GU0 + (size_t)(l * 2 + f) * W_GU_BYTES); M.Kdst = DM; M.ngroups = NGU / 32; M.gain = (f ? in[13] : in[9]) + l * DM; M.kind = 1; M.natural = 0; }
        else { M.W = (f ? in[15] : in[11]) + (size_t)l * FF * DM; M.K = FF; M.Nsrc = DM; M.dst = (bf16*)(F.ws + WS_W + W_D0 + (size_t)(l * 2 + f) * W_D_BYTES); M.Kdst = FF; M.ngroups = DM / 32; M.gain = nullptr; M.kind = 0; M.natural = 0; }
    } else if (mi == 8) { M.W = in[17]; M.K = DM; M.Nsrc = EV_IN; M.dst = (bf16*)(F.ws + WS_W + W_EVIN); M.Kdst = DM; M.ngroups = EV_IN / 32; M.gain = in[12]; M.kind = 2; M.natural = 0; }
    else if (mi == 9) { M.W = in[18]; M.K = DM; M.Nsrc = DM; M.dst = (bf16*)(F.ws + WS_W + W_EVOUT); M.Kdst = DM; M.ngroups = DM / 32; M.gain = nullptr; M.kind = 0; M.natural = 0; }
    else if (mi == 10) { M.W = in[25]; M.K = DM; M.Nsrc = OD_IN; M.dst = (bf16*)(F.ws + WS_W + W_ODIN); M.Kdst = DM; M.ngroups = OD_INP / 32; M.gain = in[12] + DM; M.kind = 3; M.natural = 0; }
    else if (mi == 11) { M.W = in[26]; M.K = DM; M.Nsrc = DM; M.dst = (bf16*)(F.ws + WS_W + W_ODOUT); M.Kdst = DM; M.ngroups = DM / 32; M.gain = nullptr; M.kind = 0; M.natural = 0; }
    else if (mi == 12) { M.W = in[29]; M.K = 256; M.Nsrc = 768; M.dst = (bf16*)(F.ws + WS_W + W_QB); M.Kdst = 256; M.ngroups = 768 / 32; M.gain = in[28]; M.kind = 4; M.natural = 0; }
    else if (mi == 13) { M.W = in[31]; M.K = 128; M.Nsrc = 1024; M.dst = (bf16*)(F.ws + WS_W + W_KVB); M.Kdst = 256; M.ngroups = 1024 / 32; M.gain = in[30]; M.kind = 5; M.natural = 0; }
    else { M.W = in[31]; M.K = 128; M.Nsrc = 1024; M.dst = (bf16*)(F.ws + WS_W + W_KVP); M.Kdst = 128; M.ngroups = 1024 / 32; M.gain = nullptr; M.kind = 0; M.natural = 1; }
    return M;
}

__device__ __forceinline__ void p0_prologue(Frame& F) {
    LOCAL_IDS();
    LAS float* scr = (LAS float*)(F.lds + RING_OFF + wave * 16384);
    const int gw = F.vcu * NWAVES + wave, NGW = F.G * NWAVES;
    const float* const* in = F.in;
    {
        int base = 0;
#pragma unroll 1
        for (int mi = 0; mi < 15; ++mi) {
            const WMat M = get_mat(F, mi);
            const int nitems = M.ngroups * (M.Kdst / 64);
            for (int it = (gw + NGW - (base % NGW)) % NGW; it < nitems; it += NGW) wconv_item(M, it, scr, lane);
            base += nitems;
        }
    }
    {
        bf16* XB = WSP(bf16, WS_XB); float* rs0 = WSP(float, WS_ROWSQ);
        for (int m = gw; m < T; m += NGW) {
            const float* xr = m < TP ? in[0] + (size_t)m * DM : in[1] + (size_t)(m - TP) * DM;
            const GAS f32x4* xv = (const GAS f32x4*)xr + lane; float s = 0.f;
            GAS unsigned long long* o8 = (GAS unsigned long long*)(XB + (size_t)m * DM) + lane;
#pragma unroll
            for (int j = 0; j < 4; ++j) { const f32x4 v = xv[64 * j]; s += (v.x * v.x + v.y * v.y) + (v.z * v.z + v.w * v.w);
                o8[64 * j] = (unsigned long long)pk2(v.x, v.y) | ((unsigned long long)pk2(v.z, v.w) << 32); }
            s = wave_sum(s); if (lane == 0) rs0[m] = s;
        }
    }
    {
        const size_t gt = (size_t)gw * 64 + lane, NT_ = (size_t)NGW * 64;
        bf16* cak = WSP(bf16, WS_R + R_CAK); bf16* cav = WSP(bf16, WS_R + R_CAV); bf16* cbk = WSP(bf16, WS_R + R_CBK); bf16* cbv = WSP(bf16, WS_R + R_CBV);
        for (size_t i = gt; i < 131072 / 4; i += NT_) { const f32x4 a = ((const f32x4*)in[2])[i], b = ((const f32x4*)in[3])[i];
            ((u32x2t*)cak)[i] = (u32x2t){pk2(a.x, a.y), pk2(a.z, a.w)}; ((u32x2t*)cav)[i] = (u32x2t){pk2(b.x, b.y), pk2(b.z, b.w)}; }
        for (size_t i = gt; i < 2097152 / 4; i += NT_) { const f32x4 a = ((const f32x4*)in[4])[i], b = ((const f32x4*)in[5])[i];
            ((u32x2t*)cbk)[i] = (u32x2t){pk2(a.x, a.y), pk2(a.z, a.w)}; ((u32x2t*)cbv)[i] = (u32x2t){pk2(b.x, b.y), pk2(b.z, b.w)}; }
        for (size_t i = gt; i < (size_t)NB * 64 * 32; i += NT_) { const size_t b = i / (64 * 32), r = i % (64 * 32);
            ((f32x4*)(F.out + O_AKS))[b * 128 * 32 + r] = ((const f32x4*)in[2])[b * 128 * 32 + 64 * 32 + r];
            ((f32x4*)(F.out + O_AVS))[b * 128 * 32 + r] = ((const f32x4*)in[3])[b * 128 * 32 + 64 * 32 + r]; }
        for (size_t i = gt; i < (size_t)NB * 448 * 128; i += NT_) { const size_t b = i / (448 * 128), r = i % (448 * 128);
            ((f32x4*)(F.out + O_BKS))[b * 512 * 128 + r] = ((const f32x4*)in[4])[b * 512 * 128 + 64 * 128 + r];
            ((f32x4*)(F.out + O_BVS))[b * 512 * 128 + r] = ((const f32x4*)in[5])[b * 512 * 128 + 64 * 128 + r]; }
        float* biasA = WSP(float, WS_TAB + TAB_BIASA); float* biasB = WSP(float, WS_TAB + TAB_BIASB); float* rope = WSP(float, WS_TAB + TAB_ROPE);
        for (size_t i = gt; i < 8 * 256; i += NT_) { const int h = (int)(i >> 8), k = (int)(i & 255); const int rel = k - 191; biasA[i] = (k < 255) ? in[16][t5_bucket(rel) * 8 + h] * LOG2E : 0.f; }
        for (size_t i = gt; i < 8 * 640; i += NT_) { const int h = (int)(i / 640), k = (int)(i % 640); int rel = k - 575; rel = rel < -128 ? -128 : (rel > 128 ? 128 : rel); biasB[i] = in[24][h * 257 + rel + 128] * LOG2E; }
        for (size_t i = gt; i < (size_t)NPOS * 16; i += NT_) { const int p = (int)(i >> 4), j = (int)(i & 15); const int pos = p < SEQ ? p : PAST + (p - SEQ);
            const float inv = 1.0f / __builtin_powf(10000.0f, (float)j / 16.0f); const float ang = (float)pos * inv;
            const double a = (double)ang; const double k2 = __builtin_rint(a * 0.15915494309189535); const float red = (float)(a - k2 * 6.283185307179586);
            rope[i] = __builtin_cosf(red); rope[(size_t)NPOS * 16 + i] = __builtin_sinf(red); }
    }
}

namespace att {
typedef short bf16x8 __attribute__((ext_vector_type(8)));
typedef short s16x4 __attribute__((ext_vector_type(4)));
typedef float f32x16 __attribute__((ext_vector_type(16)));
typedef unsigned u32x4 __attribute__((ext_vector_type(4)));
typedef unsigned u32x2 __attribute__((ext_vector_type(2)));
typedef float f32x2_t __attribute__((ext_vector_type(2))); typedef __bf16 bf16x2_t __attribute__((ext_vector_type(2)));
__device__ __forceinline__ unsigned cvtpk(float lo, float hi) { f32x2_t v = {lo, hi}; bf16x2_t b = __builtin_convertvector(v, bf16x2_t); return __builtin_bit_cast(unsigned, b); }
__device__ __forceinline__ s16x4 vtr(LAS const unsigned char* p) { typedef short v4i16_t __attribute__((ext_vector_type(4))); return __builtin_bit_cast(s16x4, __builtin_amdgcn_ds_read_tr16_b64_v4i16((LAS v4i16_t*)p)); }

constexpr int KSMAX = 208;
constexpr int L_K = 0, L_KBUF = 64 * KSMAX;
constexpr int L_V = 2 * L_KBUF, L_VBUF = 8192;
constexpr int L_TAB = L_V + 2 * L_VBUF;
constexpr int L_END = L_TAB + 4096;


template <int NKA, int NKB, bool BIAS>
__device__ __forceinline__ void tile_step(const LAS unsigned char* Ka, int kaj, const LAS unsigned char* Kb, int kbj, const bf16x8* qf, const LAS float* tb, const LAS unsigned char* Vb,
                                          float& m, float& l, f32x16& o0, f32x16& o1) {
    f32x16 p0, p1;
#pragma unroll
    for (int r = 0; r < 16; ++r) { p0[r] = 0.f; p1[r] = 0.f; }
#pragma unroll
    for (int ks = 0; ks < NKA; ++ks) {
        const bf16x8 a0 = *(const LAS bf16x8*)(Ka + 32 * ks), a1 = *(const LAS bf16x8*)(Ka + kaj + 32 * ks);
        p0 = __builtin_amdgcn_mfma_f32_32x32x16_bf16(a0, qf[ks], p0, 0, 0, 0);
        p1 = __builtin_amdgcn_mfma_f32_32x32x16_bf16(a1, qf[ks], p1, 0, 0, 0);
    }
#pragma unroll
    for (int ks = 0; ks < NKB; ++ks) {
        const bf16x8 a0 = *(const LAS bf16x8*)(Kb + 32 * ks), a1 = *(const LAS bf16x8*)(Kb + kbj + 32 * ks);
        p0 = __builtin_amdgcn_mfma_f32_32x32x16_bf16(a0, qf[NKA + ks], p0, 0, 0, 0);
        p1 = __builtin_amdgcn_mfma_f32_32x32x16_bf16(a1, qf[NKA + ks], p1, 0, 0, 0);
    }
    if (BIAS) {
#pragma unroll
        for (int r = 0; r < 16; ++r) { p0[r] += tb[(r & 3) + 8 * (r >> 2)]; p1[r] += tb[32 + (r & 3) + 8 * (r >> 2)]; }
    }
    float mx = p0[0];
#pragma unroll
    for (int r = 1; r < 16; ++r) mx = fmaxf(mx, p0[r]);
#pragma unroll
    for (int r = 0; r < 16; ++r) mx = fmaxf(mx, p1[r]);
    mx = fmaxf(mx, __shfl_xor(mx, 32));
    const float mn = fmaxf(m, mx); const float f = __builtin_amdgcn_exp2f(m - mn); m = mn;
    float rs = 0.f;
#pragma unroll
    for (int r = 0; r < 16; ++r) { p0[r] = __builtin_amdgcn_exp2f(p0[r] - mn); p1[r] = __builtin_amdgcn_exp2f(p1[r] - mn); rs += p0[r] + p1[r]; }
    l = l * f + rs;
#pragma unroll
    for (int r = 0; r < 16; ++r) { o0[r] *= f; o1[r] *= f; }
#pragma unroll
    for (int blk = 0; blk < 2; ++blk)
#pragma unroll
        for (int s = 0; s < 2; ++s) {
            const f32x16& pp = blk ? p1 : p0;
            u32x4 pw; pw.x = cvtpk(pp[8 * s + 0], pp[8 * s + 1]); pw.y = cvtpk(pp[8 * s + 2], pp[8 * s + 3]); pw.z = cvtpk(pp[8 * s + 4], pp[8 * s + 5]); pw.w = cvtpk(pp[8 * s + 6], pp[8 * s + 7]);
            const bf16x8 bfrag = __builtin_bit_cast(bf16x8, pw);
            const int ro = (32 * blk + 16 * s) * 64;
            const s16x4 lo0 = vtr(Vb + ro), hi0 = vtr(Vb + ro + 512), lo1 = vtr(Vb + 4096 + ro), hi1 = vtr(Vb + 4096 + ro + 512);
            const bf16x8 a0 = (bf16x8){lo0[0], lo0[1], lo0[2], lo0[3], hi0[0], hi0[1], hi0[2], hi0[3]};
            const bf16x8 a1 = (bf16x8){lo1[0], lo1[1], lo1[2], lo1[3], hi1[0], hi1[1], hi1[2], hi1[3]};
            o0 = __builtin_amdgcn_mfma_f32_32x32x16_bf16(a0, bfrag, o0, 0, 0, 0);
            o1 = __builtin_amdgcn_mfma_f32_32x32x16_bf16(a1, bfrag, o1, 0, 0, 0);
        }
}

struct Tiles {
    int nt, n0;
    const bf16 *k0, *v0, *pe0; int kp0, vp0;
    const bf16 *k1, *v1, *pe1; int kp1, vp1;
};
struct WaveCfg {
    const bf16* q; int qpitch;
    bf16* o; int opitch;
    int active, tlo, thi;
    int tab_off;
    int rel0;
    int qrow0;
    float m0; int has_sink;
};

template <int DQK, bool BIAS>
__device__ __forceinline__ void unit(LAS unsigned char* lds, const Tiles& TL, const WaveCfg& W, int tid) {
    constexpr int KS = DQK * 2 + 16, NKS = DQK / 16;
    const int lane = tid & 63, r32 = lane & 31, h = lane >> 5;
    const int srow = tid >> 3, sch = tid & 7;
    v4u kreg, vreg, pereg;
    auto issue = [&](int j) {
        const bool s0 = j < TL.n0; const int jj = s0 ? j : j - TL.n0;
        const bf16* kb = s0 ? TL.k0 : TL.k1; const bf16* vb = s0 ? TL.v0 : TL.v1; const int kp = s0 ? TL.kp0 : TL.kp1, vp = s0 ? TL.vp0 : TL.vp1;
        kreg = *(const GAS v4u*)(kb + (size_t)(64 * jj + srow) * kp + 8 * sch);
        vreg = *(const GAS v4u*)(vb + (size_t)(64 * jj + srow) * vp + 8 * sch);
        if (DQK == 96) { if (tid < 256) { const bf16* pb = s0 ? TL.pe0 : TL.pe1; pereg = *(const GAS v4u*)(pb + (size_t)(64 * jj + (tid >> 2)) * 32 + 8 * (tid & 3)); } }
    };
    auto commit = [&](int buf) {
        *(LAS v4u*)(lds + L_K + buf * L_KBUF + srow * KS + 16 * sch) = kreg;
        *(LAS v4u*)(lds + L_V + buf * L_VBUF + (sch >> 2) * 4096 + srow * 64 + (sch & 3) * 16) = vreg;
        if (DQK == 96) { if (tid < 256) *(LAS v4u*)(lds + L_K + buf * L_KBUF + (tid >> 2) * KS + 128 + 16 * (tid & 3)) = pereg; }
    };
    bf16x8 qf[NKS];
    if (W.active) {
#pragma unroll
        for (int ks = 0; ks < NKS; ++ks) qf[ks] = *(const GAS bf16x8*)(W.q + (size_t)r32 * W.qpitch + 16 * ks + 8 * h);
    } else {
#pragma unroll
        for (int ks = 0; ks < NKS; ++ks) qf[ks] = (bf16x8){0, 0, 0, 0, 0, 0, 0, 0};
    }
    float m = W.m0, l = (W.has_sink && h == 0) ? 1.0f : 0.0f;
    f32x16 o0, o1;
#pragma unroll
    for (int r = 0; r < 16; ++r) { o0[r] = 0.f; o1[r] = 0.f; }
    const int vb = ((lane >> 4) & 1) * 32 + (lane & 3) * 8 + (4 * h + ((lane & 15) >> 2)) * 64;
    const LAS float* tab = (const LAS float*)(lds + L_TAB) + W.tab_off + W.rel0 - (W.qrow0 + r32) + 4 * h;

    issue(0); commit(0); __syncthreads();
    for (int j = 0; j < TL.nt; ++j) {
        const int buf = j & 1;
        if (j + 1 < TL.nt) issue(j + 1);
        if (W.active && j >= W.tlo && j <= W.thi) {
            tile_step<NKS, 0, BIAS>(lds + L_K + buf * L_KBUF + r32 * KS + 16 * h, 32 * KS, lds, 0, qf, tab + 64 * j, lds + L_V + buf * L_VBUF + vb, m, l, o0, o1);
        }
        if (j + 1 < TL.nt) commit(buf ^ 1);
        __syncthreads();
    }
    if (W.active) {
        const float lt = l + __shfl_xor(l, 32); const float inv = 1.0f / lt;
        bf16* orow = W.o + (size_t)r32 * W.opitch;
#pragma unroll
        for (int g4 = 0; g4 < 4; ++g4) {
            u32x2 w0, w1;
            w0.x = cvtpk(o0[4 * g4] * inv, o0[4 * g4 + 1] * inv); w0.y = cvtpk(o0[4 * g4 + 2] * inv, o0[4 * g4 + 3] * inv);
            w1.x = cvtpk(o1[4 * g4] * inv, o1[4 * g4 + 1] * inv); w1.y = cvtpk(o1[4 * g4 + 2] * inv, o1[4 * g4 + 3] * inv);
            *(GAS u32x2*)(orow + 8 * g4 + 4 * h) = w0; *(GAS u32x2*)(orow + 32 + 8 * g4 + 4 * h) = w1;
        }
    }
}

constexpr int SD_CT = 0, SD_CTS = 272;
constexpr int SD_PE = 17408, SD_PES = 80;
constexpr int SD_K = 22528, SD_KS = 144;
constexpr int SD_V = SD_K + 4 * 64 * SD_KS;
constexpr int SD_END = SD_V + 4 * 8192;
typedef float f32x4v __attribute__((ext_vector_type(4)));
__device__ __forceinline__ void sampled_unit(LAS unsigned char* lds, int b, int hg, int t0, int t1, const float* cckv, const float* cpe, const bf16* ckvs, const bf16* kpes,
                                             const bf16* wt, const float* knn, const bf16* QD, float* part, int split, int wave, int lane, int tid) {
    const int r32 = lane & 31, h = lane >> 5, l15 = lane & 15, l4 = lane >> 4;
    const int hp = wave >> 1, prt = wave & 1, head = hg * 4 + hp;
    bf16x8 wf[4][4];
#pragma unroll
    for (int db = 0; db < 4; ++db)
#pragma unroll
        for (int ks = 0; ks < 4; ++ks) wf[db][ks] = *(const GAS bf16x8*)(wt + (size_t)(head * 128 + prt * 64 + 16 * db + l15) * 128 + 32 * ks + 8 * l4);
    bf16x8 qf[6];
    { const bf16* qp = QD + (size_t)(TP + b * 64 + 32 * (wave & 1) + r32) * 768 + head * 96;
#pragma unroll
      for (int ks = 0; ks < 6; ++ks) qf[ks] = *(const GAS bf16x8*)(qp + 16 * ks + 8 * h); }
    float m = -1e30f, l = 0.f; f32x16 o0, o1;
#pragma unroll
    for (int r = 0; r < 16; ++r) { o0[r] = 0.f; o1[r] = 0.f; }
    const int vb = ((lane >> 4) & 1) * 32 + (lane & 3) * 8 + (4 * h + ((lane & 15) >> 2)) * 64;
    const int srow = tid >> 3, sch = tid & 7;
    for (int t = t0; t < t1; ++t) {
        if (t < 64) {
            const GAS f32x4v* src = (const GAS f32x4v*)(cckv + (size_t)(64 * t + srow) * 128 + 16 * sch);
            const f32x4v a = src[0], c = src[1], d = src[2], e = src[3];
            v4u w0, w1; w0.x = cvtpk(a.x, a.y); w0.y = cvtpk(a.z, a.w); w0.z = cvtpk(c.x, c.y); w0.w = cvtpk(c.z, c.w); w1.x = cvtpk(d.x, d.y); w1.y = cvtpk(d.z, d.w); w1.z = cvtpk(e.x, e.y); w1.w = cvtpk(e.z, e.w);
            *(LAS v4u*)(lds + SD_CT + srow * SD_CTS + 32 * sch) = w0; *(LAS v4u*)(lds + SD_CT + srow * SD_CTS + 32 * sch + 16) = w1;
            const f32x4v p = *(const GAS f32x4v*)(cpe + (size_t)(64 * t + srow) * 32 + 4 * sch);
            u32x2 pw; pw.x = cvtpk(p.x, p.y); pw.y = cvtpk(p.z, p.w); *(LAS u32x2*)(lds + SD_PE + srow * SD_PES + 8 * sch) = pw;
        } else {
            const GAS v4u* src = (const GAS v4u*)(ckvs + (size_t)srow * 128 + 16 * sch);
            const v4u w0 = src[0], w1 = src[1];
            *(LAS v4u*)(lds + SD_CT + srow * SD_CTS + 32 * sch) = w0; *(LAS v4u*)(lds + SD_CT + srow * SD_CTS + 32 * sch + 16) = w1;
            *(LAS u32x2*)(lds + SD_PE + srow * SD_PES + 8 * sch) = *(const GAS u32x2*)(kpes + (size_t)srow * 32 + 4 * sch);
        }
        __syncthreads();
#pragma unroll 1
        for (int kb = 0; kb < 4; ++kb) {
            f32x4v acc[4];
#pragma unroll
            for (int db = 0; db < 4; ++db) acc[db] = (f32x4v){0.f, 0.f, 0.f, 0.f};
#pragma unroll
            for (int ks = 0; ks < 4; ++ks) {
                const bf16x8 bfr = *(const LAS bf16x8*)(lds + SD_CT + (16 * kb + l15) * SD_CTS + 64 * ks + 16 * l4);
#pragma unroll
                for (int db = 0; db < 4; ++db) acc[db] = __builtin_amdgcn_mfma_f32_16x16x32_bf16(wf[db][ks], bfr, acc[db], 0, 0, 0);
            }
            const int key = 16 * kb + l15;
            if (prt == 0) {
                float ss = 0.f;
#pragma unroll
                for (int db = 0; db < 4; ++db) ss += (acc[db][0] * acc[db][0] + acc[db][1] * acc[db][1]) + (acc[db][2] * acc[db][2] + acc[db][3] * acc[db][3]);
                ss += __shfl_xor(ss, 16); ss += __shfl_xor(ss, 32);
                const float r2 = __builtin_amdgcn_rsqf(ss * (1.0f / 64.0f) + EPS);
#pragma unroll
                for (int db = 0; db < 4; ++db) { const f32x4v gn = *(const GAS f32x4v*)(knn + 16 * db + 4 * l4); u32x2 w; w.x = cvtpk(acc[db][0] * r2 * gn[0], acc[db][1] * r2 * gn[1]); w.y = cvtpk(acc[db][2] * r2 * gn[2], acc[db][3] * r2 * gn[3]);
                    *(LAS u32x2*)(lds + SD_K + hp * 64 * SD_KS + key * SD_KS + (16 * db + 4 * l4) * 2) = w; }
            } else {
#pragma unroll
                for (int db = 0; db < 4; ++db) { u32x2 w; w.x = cvtpk(acc[db][0], acc[db][1]); w.y = cvtpk(acc[db][2], acc[db][3]); const int dv = 16 * db + 4 * l4;
                    *(LAS u32x2*)(lds + SD_V + hp * 8192 + (dv >> 5) * 4096 + key * 64 + (dv & 31) * 2) = w; }
            }
        }
        __syncthreads();
        tile_step<4, 2, false>(lds + SD_K + hp * 64 * SD_KS + r32 * SD_KS + 16 * h, 32 * SD_KS, lds + SD_PE + r32 * SD_PES + 16 * h, 32 * SD_PES, qf, nullptr, lds + SD_V + hp * 8192 + vb, m, l, o0, o1);
        __syncthreads();
    }
    float* P = part + ((size_t)((b * 8 + head) * NSPLIT + split)) * (64 * 66);
    const int q = 32 * (wave & 1) + r32;
#pragma unroll
    for (int g4 = 0; g4 < 4; ++g4) {
        *(GAS f32x4v*)(P + q * 64 + 8 * g4 + 4 * h) = (f32x4v){o0[4 * g4], o0[4 * g4 + 1], o0[4 * g4 + 2], o0[4 * g4 + 3]};
        *(GAS f32x4v*)(P + q * 64 + 32 + 8 * g4 + 4 * h) = (f32x4v){o1[4 * g4], o1[4 * g4 + 1], o1[4 * g4 + 2], o1[4 * g4 + 3]};
    }
    const float lt = l + __shfl_xor(l, 32);
    if (h == 0) { P[4096 + q] = m; P[4160 + q] = lt; }
}
}

constexpr int NU_BP = NB * 8 * 8, NU_BS = NB * 8, NU_AP = NB * 32 * 2, NU_AS = NB * 2, NU_L0 = NU_BP + NU_BS + NU_AP + NU_AS;
__device__ __forceinline__ void attn_phase_l0(Frame& F) {
    const bf16* QKV = WSP(bf16, WS_R + R_QKV); bf16* MIX = WSP(bf16, WS_R + R_MIX);
    const bf16* cak = WSP(bf16, WS_R + R_CAK); const bf16* cav = WSP(bf16, WS_R + R_CAV); const bf16* cbk = WSP(bf16, WS_R + R_CBK); const bf16* cbv = WSP(bf16, WS_R + R_CBV);
    const float* biasA = WSP(float, WS_TAB + TAB_BIASA); const float* biasB = WSP(float, WS_TAB + TAB_BIASB);
    const float* sinks = F.in[21];
    LOCAL_IDS(); const int w = wave;
    LAS float* tab = (LAS float*)(F.lds + att::L_TAB);
    for (int ui = (int)blockIdx.x; ui < NU_L0; ui += F.G) {
        att::Tiles TL; att::WaveCfg W;
        TL.pe0 = nullptr; TL.pe1 = nullptr; TL.k1 = nullptr; TL.v1 = nullptr; TL.kp1 = 0; TL.vp1 = 0;
        W.qpitch = EV_IN; W.opitch = DM; W.tab_off = 0; W.has_sink = 0; W.m0 = -1e30f; W.active = 1; W.qrow0 = 32 * (w & 1);
        if (ui < NU_BP + NU_BS) {
            int b, h;
            if (ui < NU_BP) {
                b = ui >> 6; h = (ui >> 3) & 7; const int cg = ui & 7; const int cw = 4 * cg + (w >> 1); const int c0 = (4 * cg - 8) > 0 ? (4 * cg - 8) : 0;
                TL.nt = 4 * cg + 4 - c0; TL.n0 = TL.nt;
                const size_t r0 = (size_t)b * SEQ + (size_t)c0 * 64;
                TL.k0 = QKV + r0 * EV_IN + 1280 + h * 64; TL.v0 = QKV + r0 * EV_IN + 1792 + h * 64; TL.kp0 = EV_IN; TL.vp0 = EV_IN;
                const size_t qr = (size_t)b * SEQ + (size_t)cw * 64 + 32 * (w & 1);
                W.q = QKV + qr * EV_IN + 768 + h * 64; W.o = MIX + qr * DM + 512 + h * 64;
                const int lo = (cw - 8) > 0 ? (cw - 8) : 0; W.tlo = lo - c0; W.thi = cw - c0; W.rel0 = (c0 - cw) * 64 + 575;
            } else {
                const int u2 = ui - NU_BP; b = u2 >> 3; h = u2 & 7;
                TL.nt = 9; TL.n0 = 8;
                TL.k0 = cbk + (size_t)b * 512 * 512 + h * 64; TL.v0 = cbv + (size_t)b * 512 * 512 + h * 64; TL.kp0 = 512; TL.vp0 = 512;
                const size_t r1 = (size_t)TP + (size_t)b * 64;
                TL.k1 = QKV + r1 * EV_IN + 1280 + h * 64; TL.v1 = QKV + r1 * EV_IN + 1792 + h * 64; TL.kp1 = EV_IN; TL.vp1 = EV_IN;
                W.active = w < 2; const size_t qr = r1 + 32 * (w & 1);
                W.q = QKV + qr * EV_IN + 768 + h * 64; W.o = MIX + qr * DM + 512 + h * 64;
                W.tlo = 0; W.thi = 8; W.rel0 = -8 * 64 + 575;
            }
            __syncthreads();
            for (int i = tid; i < 640; i += 512) tab[i] = biasB[h * 640 + i];
            __syncthreads();
        } else {
            int b, kvh; const int g = w >> 1;
            if (ui < NU_BP + NU_BS + NU_AP) {
                const int u2 = ui - NU_BP - NU_BS; b = u2 >> 6; const int c = (u2 >> 1) & 31; kvh = u2 & 1; const int c0 = (c - 2) > 0 ? (c - 2) : 0;
                TL.nt = c - c0 + 1; TL.n0 = TL.nt;
                const size_t r0 = (size_t)b * SEQ + (size_t)c0 * 64;
                TL.k0 = QKV + r0 * EV_IN + 512 + kvh * 64; TL.v0 = QKV + r0 * EV_IN + 640 + kvh * 64; TL.kp0 = EV_IN; TL.vp0 = EV_IN;
                const size_t qr = (size_t)b * SEQ + (size_t)c * 64 + 32 * (w & 1);
                W.q = QKV + qr * EV_IN + (kvh * 4 + g) * 64; W.o = MIX + qr * DM + (kvh * 4 + g) * 64;
                W.tlo = 0; W.thi = TL.nt - 1; W.rel0 = (c0 - c) * 64 + 191;
            } else {
                const int u2 = ui - NU_BP - NU_BS - NU_AP; b = u2 >> 1; kvh = u2 & 1;
                TL.nt = 3; TL.n0 = 2;
                TL.k0 = cak + (size_t)b * 128 * 128 + kvh * 64; TL.v0 = cav + (size_t)b * 128 * 128 + kvh * 64; TL.kp0 = 128; TL.vp0 = 128;
                const size_t r1 = (size_t)TP + (size_t)b * 64;
                TL.k1 = QKV + r1 * EV_IN + 512 + kvh * 64; TL.v1 = QKV + r1 * EV_IN + 640 + kvh * 64; TL.kp1 = EV_IN; TL.vp1 = EV_IN;
                const size_t qr = r1 + 32 * (w & 1);
                W.q = QKV + qr * EV_IN + (kvh * 4 + g) * 64; W.o = MIX + qr * DM + (kvh * 4 + g) * 64;
                W.tlo = 0; W.thi = 2; W.rel0 = -2 * 64 + 191;
            }
            W.tab_off = g * 256; W.has_sink = 1; W.m0 = sinks[kvh * 4 + g] * LOG2E;
            __syncthreads();
            for (int i = tid; i < 1024; i += 512) tab[i] = biasA[(kvh * 4) * 256 + i];
            __syncthreads();
        }
        att::unit<64, true>(F.lds, TL, W, tid);
    }
}

__device__ __forceinline__ void attn_phase_l1(Frame& F) {
    const bf16* QD = WSP(bf16, WS_R + R_QD); const bf16* KD = WSP(bf16, WS_R + R_KD); const bf16* VD = WSP(bf16, WS_R + R_VD); const bf16* KPE = WSP(bf16, WS_R + R_KPE);
    bf16* MIX = WSP(bf16, WS_R + R_MIX);
    LOCAL_IDS(); const int w = wave;
    for (int ui = (int)blockIdx.x; ui < 256; ui += F.G) {
        const int b = ui >> 5, h = (ui >> 2) & 7, p = ui & 3;
#pragma unroll 1
        for (int half = 0; half < 2; ++half) {
            const int cg = half ? 7 - p : p; const int cw = 4 * cg + (w >> 1);
            att::Tiles TL; att::WaveCfg W;
            TL.nt = 4 * cg + 4; TL.n0 = TL.nt; TL.k1 = nullptr; TL.v1 = nullptr; TL.pe1 = nullptr; TL.kp1 = 0; TL.vp1 = 0;
            const size_t r0 = (size_t)b * SEQ;
            TL.k0 = KD + r0 * 512 + h * 64; TL.v0 = VD + r0 * 512 + h * 64; TL.pe0 = KPE + r0 * 32; TL.kp0 = 512; TL.vp0 = 512;
            const size_t qr = r0 + (size_t)cw * 64 + 32 * (w & 1);
            W.q = QD + qr * 768 + h * 96; W.qpitch = 768; W.o = MIX + qr * DM + 512 + h * 64; W.opitch = DM;
            W.active = 1; W.tlo = 0; W.thi = cw; W.tab_off = 0; W.rel0 = 0; W.qrow0 = 0; W.m0 = -1e30f; W.has_sink = 0;
            att::unit<96, false>(F.lds, TL, W, tid);
        }
    }
    for (int ui = (int)blockIdx.x; ui < NB * 2 * NSPLIT; ui += F.G) {
        const int b = ui >> 4, hg = (ui >> 3) & 1, sp = ui & 7;
        att::sampled_unit(F.lds, b, hg, (sp * 65) >> 3, ((sp + 1) * 65) >> 3, F.in[7] + (size_t)b * PAST * 128, F.in[8] + (size_t)b * PAST * 32, WSP(bf16, WS_R + R_CKVS) + (size_t)b * 64 * 128,
                          KPE + (size_t)(TP + b * 64) * 32, WSP(bf16, WS_W + W_KVP), F.in[34], QD, WSP(float, WS_R + R_PART), sp, wave, lane, tid);
    }
}

__device__ __forceinline__ void combine_l1(Frame& F) {
    LOCAL_IDS();
    const int gw = (int)blockIdx.x * NWAVES + wave, NGW = F.G * NWAVES;
    const float* part = WSP(float, WS_R + R_PART); bf16* MIX = WSP(bf16, WS_R + R_MIX);
    for (int it = gw; it < NB * 8 * 64; it += NGW) {
        const int q = it & 63, bh = it >> 6, b = bh >> 3, head = bh & 7;
        const float* P = part + (size_t)bh * NSPLIT * (64 * 66);
        float ms[NSPLIT]; float M = -3e38f;
#pragma unroll
        for (int s = 0; s < NSPLIT; ++s) { ms[s] = P[(size_t)s * (64 * 66) + 4096 + q]; M = fmaxf(M, ms[s]); }
        float L = 0.f, O = 0.f;
#pragma unroll
        for (int s = 0; s < NSPLIT; ++s) { const float f = __builtin_amdgcn_exp2f(ms[s] - M); L += P[(size_t)s * (64 * 66) + 4160 + q] * f; O += P[(size_t)s * (64 * 66) + q * 64 + lane] * f; }
        MIX[(size_t)(TP + b * 64 + q) * DM + 512 + head * 64 + lane] = (bf16)f2bf(O / L);
    }
}

__device__ __forceinline__ void side_l1(Frame& F) {
    LOCAL_IDS();
    const int gw = (int)blockIdx.x * NWAVES + wave, NGW = F.G * NWAVES;
    const bf16* KVA = WSP(bf16, WS_R + R_KVA); const float* rs = WSP(float, WS_ROWSQ + 7 * ROWSQ_STRIDE); const float* g = F.in[30];
    bf16* CKVS = WSP(bf16, WS_R + R_CKVS);
    for (int row = gw; row < T; row += NGW) {
        const float r = __builtin_amdgcn_rsqf(rs[row] * (1.0f / 128.0f) + EPS);
        const unsigned pk = *(const GAS unsigned*)(KVA + (size_t)row * 256 + 2 * lane);
        const float a = __uint_as_float(pk << 16) * r * g[2 * lane], b = __uint_as_float(pk & 0xffff0000u) * r * g[2 * lane + 1];
        float* dst = row < TP ? F.out + O_CKVP + (size_t)row * 128 : F.out + O_CKVS + (size_t)(row - TP) * 128;
        *(GAS f32x2v*)(dst + 2 * lane) = (f32x2v){a, b};
        if (row >= TP) *(GAS unsigned*)(CKVS + (size_t)(row - TP) * 128 + 2 * lane) = pk2(a, b);
    }
    const bf16* U = WSP(bf16, WS_R + R_U); bf16* MIX = WSP(bf16, WS_R + R_MIX); const float* cw = F.in[27]; const float* st = F.in[6];
    float w0[8], w1[8], w2[8];
#pragma unroll
    for (int j = 0; j < 8; ++j) { w0[j] = cw[8 * lane + j]; w1[j] = cw[512 + 8 * lane + j]; w2[j] = cw[1024 + 8 * lane + j]; }
    for (int row = gw; row < T; row += NGW) {
        int t, b; bool samp = row >= TP; if (!samp) { b = row >> 11; t = row & (SEQ - 1); } else { b = (row - TP) >> 6; t = (row - TP) & 63; }
        float u0[8], u1[8], u2[8], cb[8];
        { const v4u x = *(const GAS v4u*)(U + (size_t)row * 512 + 8 * lane);
#pragma unroll
          for (int j = 0; j < 4; ++j) { u2[2 * j] = __uint_as_float(x[j] << 16); u2[2 * j + 1] = __uint_as_float(x[j] & 0xffff0000u); } }
        if (t >= 1) { const v4u x = *(const GAS v4u*)(U + (size_t)(row - 1) * 512 + 8 * lane);
#pragma unroll
          for (int j = 0; j < 4; ++j) { u1[2 * j] = __uint_as_float(x[j] << 16); u1[2 * j + 1] = __uint_as_float(x[j] & 0xffff0000u); } }
        else {
#pragma unroll
          for (int j = 0; j < 8; ++j) u1[j] = samp ? st[(size_t)(b * 2 + 1) * 512 + 8 * lane + j] : 0.f; }
        if (t >= 2) { const v4u x = *(const GAS v4u*)(U + (size_t)(row - 2) * 512 + 8 * lane);
#pragma unroll
          for (int j = 0; j < 4; ++j) { u0[2 * j] = __uint_as_float(x[j] << 16); u0[2 * j + 1] = __uint_as_float(x[j] & 0xffff0000u); } }
        else {
#pragma unroll
          for (int j = 0; j < 8; ++j) u0[j] = samp ? st[(size_t)(b * 2 + t) * 512 + 8 * lane + j] : 0.f; }
        { const v4u x = *(const GAS v4u*)(MIX + (size_t)row * DM + 8 * lane);
#pragma unroll
          for (int j = 0; j < 4; ++j) { cb[2 * j] = __uint_as_float(x[j] << 16); cb[2 * j + 1] = __uint_as_float(x[j] & 0xffff0000u); } }
        v4u o;
#pragma unroll
        for (int j = 0; j < 4; ++j) { const float y0 = cb[2 * j] * (w0[2 * j] * u0[2 * j] + w1[2 * j] * u1[2 * j] + w2[2 * j] * u2[2 * j]);
            const float y1 = cb[2 * j + 1] * (w0[2 * j + 1] * u0[2 * j + 1] + w1[2 * j + 1] * u1[2 * j + 1] + w2[2 * j + 1] * u2[2 * j + 1]); o[j] = pk2(y0, y1); }
        *(GAS v4u*)(MIX + (size_t)row * DM + 8 * lane) = o;
    }
}

struct Args { const float* in[36]; float* out; unsigned char* ws; int ph_lo, ph_hi; };
constexpr int NPHASE = 17;
__global__ void __launch_bounds__(NWAVES * 64, 2) enc_fwd(Args args) {
    extern __shared__ __attribute__((aligned(16))) unsigned char lds[];
    Frame F;
    F.lds = (LAS unsigned char*)lds;
    F.MISC = (volatile LAS unsigned*)(F.lds + MISC_OFF);
    F.wave_s = __builtin_amdgcn_readfirstlane((int)threadIdx.x >> 6);
    F.G = gridDim.x; { const int bx = blockIdx.x; F.vcu = (F.G % 8 == 0) ? (bx % 8) * (F.G / 8) + bx / 8 : bx; }
    F.in = args.in; F.out = args.out; F.ws = args.ws; F.ctl = (gu32*)(args.ws + WS_CTL);
    for (int u = threadIdx.x; u < (LDS_BYTES - LDSCTL_OFF) / 4; u += NWAVES * 64) ((LAS unsigned*)(F.lds + LDSCTL_OFF))[u] = 0u;
    __syncthreads();
    const int lo = args.ph_lo, hi = args.ph_hi;
    const bool use_bar = (hi - lo) > 1;
    XcdBarrier bar; bar.bar = (unsigned*)(F.ctl + CW_BAR); bar.x = 0; bar.st = nullptr;
    if (use_bar) bar = xcd_barrier_post((unsigned*)(F.ctl + CW_BAR), F.MISC + 8);
    bar.w0 = (F.wave_s == 0) ? 1u : 0u;
#pragma unroll 1
    for (int ph = lo; ph < hi; ++ph) {
        int z = 0; asm volatile("" : "+s"(z));
        F.in = args.in + z; F.out = args.out + z; F.ws = args.ws + z;
        bf16* XB = WSP(bf16, WS_XB); bf16* H = WSP(bf16, WS_R + R_H); bf16* MIX = WSP(bf16, WS_R + R_MIX);
        (void)XB;
        int kind, l = 0, f = 0;
        switch (ph) {
            case 0: kind = 0; break;
            case 1: kind = 1; l = 0; f = 0; break;   case 2: kind = 2; l = 0; f = 0; break;
            case 3: kind = 3; break;                 case 4: kind = 4; break;                 case 5: kind = 5; l = 0; break;
            case 6: kind = 1; l = 0; f = 1; break;   case 7: kind = 2; l = 0; f = 1; break;
            case 8: kind = 1; l = 1; f = 0; break;   case 9: kind = 2; l = 1; f = 0; break;
            case 10: kind = 6; break;                case 11: kind = 7; break;                case 12: kind = 8; break;   case 13: kind = 9; break;   case 14: kind = 5; l = 1; break;
            case 15: kind = 1; l = 1; f = 1; break;  default: kind = 2; l = 1; f = 1; break;
        }
        if (kind == 0) { p0_prologue(F); }
        else if (kind == 1) {
            pg8::Gemm g{XB, WSP(bf16, WS_W + W_GU0 + (size_t)(l * 2 + f) * W_GU_BYTES), T, NGU, DM}; pg8::StaticOrder S; S.init(T, NGU, F.G, (int)blockIdx.x);
            ep::EpiGU E{ep::Ctx{F.ws, F.out, F.in}, 3 * l + 2 * f};
            pg8::gemm_phase<ep::EpiGU, pg8::StaticOrder, true, true>(F.lds + RING_OFF, g, S, E, F.wave_s);
        } else if (kind == 2 || kind == 5) {
            const bool isout = kind == 5; const bool first = (!isout && l == 0 && f == 0), last = (!isout && l == 1 && f == 1);
            pg8::Gemm g; g.A = isout ? MIX : H; g.Bt = isout ? WSP(bf16, WS_W + (l ? W_ODOUT : W_EVOUT)) : WSP(bf16, WS_W + W_D0 + (size_t)(l * 2 + f) * W_D_BYTES); g.M = T; g.N = DM; g.K = isout ? DM : FF;
            pg8::StaticOrder S; S.init(T, DM, F.G, (int)blockIdx.x);
            const int rsi = isout ? 3 * l + 2 : (f == 0 ? 3 * l + 1 : 3 * (l + 1));
            ep::EpiResid E; E.C = ep::Ctx{F.ws, F.out, F.in}; E.first = first; E.last = last; E.rsi = rsi; E.alpha = isout ? 1.0f : 0.5f;
            pg8::gemm_phase<ep::EpiResid, pg8::StaticOrder, true, true>(F.lds + RING_OFF, g, S, E, F.wave_s);
        } else if (kind == 3) {
            pg8::Gemm g{XB, WSP(bf16, WS_W + W_EVIN), T, EV_IN, DM}; pg8::StaticOrder S; S.init(T, EV_IN, F.G, (int)blockIdx.x);
            ep::EpiEvIn E{ep::Ctx{F.ws, F.out, F.in}};
            pg8::gemm_phase<ep::EpiEvIn, pg8::StaticOrder, true, true>(F.lds + RING_OFF, g, S, E, F.wave_s);
        } else if (kind == 4) { attn_phase_l0(F); }
        else if (kind == 6) {
            pg8::Gemm g{XB, WSP(bf16, WS_W + W_ODIN), T, OD_INP, DM}; pg8::StaticOrder S; S.init(T, OD_INP, F.G, (int)blockIdx.x);
            ep::EpiOdIn E{ep::Ctx{F.ws, F.out, F.in}};
            pg8::gemm_phase<ep::EpiOdIn, pg8::StaticOrder, true, true>(F.lds + RING_OFF, g, S, E, F.wave_s);
        } else if (kind == 7) {
            side_l1(F);
            { pg8::Gemm g{WSP(bf16, WS_R + R_QA), WSP(bf16, WS_W + W_QB), T, 768, 256}; pg8::StaticOrder S; S.init(T, 768, F.G, (int)blockIdx.x);
              ep::EpiQb E{ep::Ctx{F.ws, F.out, F.in}};
              pg8::gemm_phase<ep::EpiQb, pg8::StaticOrder, true, true>(F.lds + RING_OFF, g, S, E, F.wave_s); }
            { pg8::Gemm g{WSP(bf16, WS_R + R_KVA), WSP(bf16, WS_W + W_KVB), TP, 1024, 256}; pg8::StaticOrder S; S.init(TP, 1024, F.G, (int)blockIdx.x);
              ep::EpiKvb E{ep::Ctx{F.ws, F.out, F.in}};
              pg8::gemm_phase<ep::EpiKvb, pg8::StaticOrder, true, true>(F.lds + RING_OFF, g, S, E, F.wave_s); }
        } else if (kind == 8) { attn_phase_l1(F); }
        else { combine_l1(F); }
        if (ph + 1 < hi) xcd_barrier(bar);
    }
}

#ifndef MK_MULTI
#define MK_MULTI 0
#endif
extern "C" void kernel_launch(void* const* d_in, const int* in_sizes, int n_in, void* d_out, int out_size, void* d_ws, size_t ws_size, hipStream_t stream) {
    static int grid = 0;
    if (grid == 0) {
        if (n_in != 36 || (size_t)out_size != O_END || ws_size < WS_END) { fprintf(stderr, "kernel_launch: unexpected shapes: n_in %d out %d ws %zu (need %zu)\n", n_in, out_size, ws_size, (size_t)WS_END); grid = -1; return; }
        int dev = 0, cus = 0;
        if (hipGetDevice(&dev) != hipSuccess || hipDeviceGetAttribute(&cus, hipDeviceAttributeMultiprocessorCount, dev) != hipSuccess) { grid = -1; return; }
        if (hipFuncSetAttribute((const void*)enc_fwd, hipFuncAttributeMaxDynamicSharedMemorySize, LDS_BYTES) != hipSuccess) { grid = -1; return; }
        grid = cus;
    }
    if (grid < 0) return;
    if (hipMemsetAsync((char*)d_ws + WS_CTL, 0, CTL_ZERO_BYTES, stream) != hipSuccess) return;
    Args a{};
    for (int i = 0; i < 36; ++i) a.in[i] = (const float*)d_in[i];
    a.out = (float*)d_out; a.ws = (unsigned char*)d_ws;
#if MK_MULTI
    for (int p = 0; p < NPHASE; ++p) { a.ph_lo = p; a.ph_hi = p + 1; hipLaunchKernelGGL(enc_fwd, dim3(grid), dim3(NWAVES * 64), LDS_BYTES, stream, a); }
#else
    a.ph_lo = 0; a.ph_hi = NPHASE; hipLaunchKernelGGL(enc_fwd, dim3(grid), dim3(NWAVES * 64), LDS_BYTES, stream, a);
#endif
}
```

```cpp
#include <hip/hip_runtime.h>
#include <cstdio>
#include <cstdint>
#define GAS __attribute__((address_space(1)))
#define LAS __attribute__((address_space(3)))
typedef unsigned short bf16;
typedef unsigned v4u __attribute__((ext_vector_type(4)));
typedef float f32x4 __attribute__((ext_vector_type(4)));
typedef short bf16x8 __attribute__((ext_vector_type(8)));
typedef GAS unsigned gu32;
typedef GAS unsigned long long gu64;
#define RLX_AGENT __ATOMIC_RELAXED, __HIP_MEMORY_SCOPE_AGENT
#define LDS_WAIT() asm volatile("s_waitcnt lgkmcnt(0)" ::: "memory")
#define VM_WAIT() asm volatile("s_waitcnt vmcnt(0)" ::: "memory")
__device__ __forceinline__ unsigned long long rt() { return __builtin_amdgcn_s_memrealtime(); }
__device__ __forceinline__ unsigned f2bf(float f) { unsigned u = __builtin_bit_cast(unsigned, f); return (u + 0x7fffu + ((u >> 16) & 1u)) >> 16; }
__device__ __forceinline__ unsigned pk2(float lo, float hi) { return f2bf(lo) | (f2bf(hi) << 16); }
typedef float f32x2v __attribute__((ext_vector_type(2)));
#define XB_TMO      128
#define XB_XCNT(j)  (256  + 64 * (j))
#define XB_XSUB(j)  (1280 + 64 * (j))
#define XB_XGEN(j)  (2304 + 64 * (j))
#define XB_TOP      3328
#define XB_TOPGEN   3392
#define XCD_BAR_WORDS 3456
#define XB_SPIN_CAP (1u << 18)

__device__ __forceinline__ unsigned xb_ld(unsigned* p)              { return __hip_atomic_load(p, __ATOMIC_RELAXED, __HIP_MEMORY_SCOPE_AGENT); }
__device__ __forceinline__ unsigned xb_add(unsigned* p, unsigned v) { return __hip_atomic_fetch_add(p, v, __ATOMIC_RELAXED, __HIP_MEMORY_SCOPE_AGENT); }
__device__ __forceinline__ unsigned xb_xcc_id() { return (unsigned)__builtin_amdgcn_s_getreg((3 << 11) | 20) & 0xFu; }
#define XB_SPIN(cond, bar) do { unsigned _sp = 0; while (cond) { __builtin_amdgcn_s_sleep(1); \
    if ((++_sp & 255u) == 0u) { if (xb_ld(&(bar)[XB_TMO])) break; if (_sp > XB_SPIN_CAP) { atomicAdd(&(bar)[XB_TMO], 1u); break; } } } } while (0)

struct XcdBarrier {
    unsigned* bar; unsigned x; unsigned w0;
    volatile LAS unsigned* st;
};

__device__ __forceinline__ XcdBarrier xcd_barrier_post(unsigned* bar, volatile LAS unsigned* st) {
    XcdBarrier b; b.bar = bar; b.x = xb_xcc_id(); b.st = st;
    if (threadIdx.x == 0) (void)xb_add(&bar[XB_XCNT(b.x)], 1u);
    return b;
}
__device__ __forceinline__ void xcd_barrier_complete(unsigned* bar, unsigned x, unsigned& nloc, unsigned& nx) {
    const unsigned G = gridDim.x * gridDim.y * gridDim.z;
    unsigned sum, cnt, mine, sp = 0u;
    for (;;) {
        sum = 0u; cnt = 0u; mine = 0u;
#pragma unroll
        for (unsigned j = 0; j < 16; ++j) { const unsigned c = xb_ld(&bar[XB_XCNT(j)]); sum += c; cnt += (c > 0u) ? 1u : 0u; mine = (j == x) ? c : mine; }
        if (sum == G) break;
        __builtin_amdgcn_s_sleep(1);
        if ((++sp & 255u) == 0u) { if (xb_ld(&bar[XB_TMO])) break; if (sp > XB_SPIN_CAP) { atomicAdd(&bar[XB_TMO], 1u); break; } }
    }
    nloc = mine > 0u ? mine : 1u; nx = cnt > 0u ? cnt : 1u;
}

__device__ __forceinline__ void xcd_barrier(const XcdBarrier& b) {
    asm volatile("s_waitcnt vmcnt(0)" ::: "memory");
    __syncthreads();
    if (b.w0 && __builtin_amdgcn_mbcnt_hi(~0u, __builtin_amdgcn_mbcnt_lo(~0u, 0u)) == 0u) {
        unsigned* bar = b.bar;
        __builtin_amdgcn_s_waitcnt(0);
        unsigned nloc = b.st[0], nx = b.st[1];
        if (nloc == 0u) { xcd_barrier_complete(bar, b.x, nloc, nx); b.st[0] = nloc; b.st[1] = nx; }
        const unsigned old = xb_add(&bar[XB_XSUB(b.x)], 1u);
        const unsigned gen = old / nloc;
        if (old + 1u == (gen + 1u) * nloc) {
            __builtin_amdgcn_fence(__ATOMIC_RELEASE, "agent");
            asm volatile("s_waitcnt vmcnt(0)" ::: "memory");
            const unsigned og = xb_add(&bar[XB_TOP], 1u);
            const unsigned tg = og / nx;
            if (og + 1u == (tg + 1u) * nx) xb_add(&bar[XB_TOPGEN], 1u);
            else XB_SPIN(xb_ld(&bar[XB_TOPGEN]) == tg, bar);
            __builtin_amdgcn_fence(__ATOMIC_ACQUIRE, "agent");
            xb_add(&bar[XB_XGEN(b.x)], 1u);
            asm volatile("s_waitcnt vmcnt(0)" ::: "memory");
        } else {
            XB_SPIN(xb_ld(&bar[XB_XGEN(b.x)]) == gen, bar);
            __builtin_amdgcn_fence(__ATOMIC_ACQUIRE, "agent");
            asm volatile("s_waitcnt vmcnt(0)" ::: "memory");
        }
    }
    __syncthreads();
}
namespace pg8 {
#define PG8_LAS __attribute__((address_space(3)))
typedef unsigned short bf16_t;
typedef short bf16x8 __attribute__((ext_vector_type(8)));
typedef float f32x4 __attribute__((ext_vector_type(4)));
typedef unsigned u32x4 __attribute__((ext_vector_type(4)));
constexpr int BM = 256, BK = 64, HALF = 128, HTB = HALF * BK * 2  , STAGE_BYTES = 8 * HTB, NXCD = 8, WGM = 8;

__host__ __device__ __forceinline__ int lds_byte(int r, int c) { const int st = (r >> 4) * 2 + (c >> 5), rr = r & 15, cc = c & 31, ob = rr * 64 + cc * 2; return st * 1024 + (ob ^ (((ob >> 9) & 1) << 5)); }
__host__ __device__ __forceinline__ void stage_rc(int b, int& R, int& C) { const int st = b / 1024, sb = b % 1024, swz = sb ^ (((sb >> 9) & 1) << 5); R = (st >> 1) * 16 + swz / 64; C = (st & 1) * 32 + (swz % 64) / 2; }
__host__ __device__ __forceinline__ int perm32(int rho) { const int n = rho >> 4, i = rho & 15; return 8 * (i >> 2) + 4 * n + (i & 3); }

struct Unit { int pm, pn; };
struct Gemm { const bf16_t* A; const bf16_t* Bt; int M, N, K; };

struct StaticOrder {
    int nM, nN, nwg, G, c;
    __host__ __device__ void init(int M, int N, int G_, int c_) { nM = M / BM; nN = N / BM; nwg = nM * nN; G = G_; c = c_; }
    __host__ __device__ bool next(int i, Unit& u) const {
        const long L = (long)i * G + c; if (L >= nwg) return false;
        int wgid = (int)L; { const int q = nwg / NXCD, r = nwg % NXCD, xcd = wgid % NXCD, off = wgid / NXCD; wgid = (xcd < r ? xcd * (q + 1) : r * (q + 1) + (xcd - r) * q) + off; }
        const int nig = WGM * nN, gid = wgid / nig, fm = gid * WGM, gsz = (nM - fm) < WGM ? (nM - fm) : WGM;
        u.pm = fm + ((wgid % nig) % gsz); u.pn = (wgid % nig) / gsz; return true;
    }
    __device__ __forceinline__ void a_ready(const Unit&) const {}
    __device__ __forceinline__ void done(const Unit&) const {}
};

__device__ __forceinline__ unsigned cvt_pk_bf16(float lo, float hi) { unsigned r; asm volatile("v_cvt_pk_bf16_f32 %0, %1, %2" : "=v"(r) : "v"(lo), "v"(hi)); return r; }
typedef float f32x2 __attribute__((ext_vector_type(2)));
template <class Epi, class Sched, bool ALIGN_EPI = false, bool SP2 = false>
__device__ __forceinline__ void gemm_phase(PG8_LAS unsigned char* lds, const Gemm g, const Sched& S, const Epi& E, const int wid  ) {
    int lane_; asm volatile("v_mbcnt_lo_u32_b32 %0, -1, 0\n\tv_mbcnt_hi_u32_b32 %0, -1, %0" : "=v"(lane_));
    const int lane = lane_, tid = wid * 64 + lane, wr = wid >> 2, wc = wid & 3, fr = lane & 15, fq = lane >> 4;
    int K_ = g.K; asm volatile("" : "+s"(K_));
    const int K = K_, nt = K / BK;
    unsigned voffA[2], voffB[2];
#pragma unroll
    for (int i = 0; i < 2; ++i) { int R, C; stage_rc(tid * 16 + i * 8192, R, C); const int Rb = Epi::PERM ? ((R & ~31) + perm32(R & 31)) : R;
        voffA[i] = (unsigned)(R * K + C) * 2u; voffB[i] = (unsigned)(Rb * K + C) * 2u; }
    const size_t kstep = (size_t)(BK * 2);
    const size_t hstep = (size_t)HALF * K * 2;
    const size_t tstep = 2 * hstep;
    const unsigned ldsw = (unsigned)wid * 1024u;
    const int aoff = lds_byte(wr * 64 + fr, fq * 8), boff = lds_byte(wc * 32 + fr, fq * 8);
#define PG8_SA(b, h) (((b) * 2 + (h)) * HTB)
#define PG8_SB(b, h) ((4 + (b) * 2 + (h)) * HTB)
#define PG8_STAGE(bufoff, gbase, voff) do { _Pragma("unroll") for (int _i = 0; _i < 2; ++_i) \
        __builtin_amdgcn_global_load_lds((const unsigned*)((const char*)(gbase) + (voff)[_i]), (PG8_LAS unsigned*)(lds + (bufoff) + ldsw + _i * 8192), 16, 0, 0); } while (0)
#define PG8_LDA(dst, b, h) do { _Pragma("unroll") for (int m = 0; m < 4; ++m) _Pragma("unroll") for (int k = 0; k < 2; ++k) dst[m][k] = *(const PG8_LAS bf16x8*)(lds + PG8_SA(b, h) + aoff + m * 2048 + k * 1024); } while (0)
#define PG8_LDB(dst, b, h) do { _Pragma("unroll") for (int n = 0; n < 2; ++n) _Pragma("unroll") for (int k = 0; k < 2; ++k) dst[n][k] = *(const PG8_LAS bf16x8*)(lds + PG8_SB(b, h) + boff + n * 2048 + k * 1024); } while (0)
#define PG8_MMA(ai, bj, At, Bt) do { __builtin_amdgcn_s_setprio(1); _Pragma("unroll") for (int m = 0; m < 4; ++m) _Pragma("unroll") for (int n = 0; n < 2; ++n) _Pragma("unroll") for (int k = 0; k < 2; ++k) \
        acc[ai][bj][m][n] = __builtin_amdgcn_mfma_f32_16x16x32_bf16(Bt[n][k], At[m][k], acc[ai][bj][m][n], 0, 0, 0); __builtin_amdgcn_s_setprio(0); } while (0)
#define PG8_WAIT_V(n) asm volatile("s_waitcnt vmcnt(" #n ")" ::: "memory")
#define PG8_WAIT_L(n) asm volatile("s_waitcnt lgkmcnt(" #n ")" ::: "memory")
#define PG8_BAR __builtin_amdgcn_s_barrier()
#define PG8_SCHED __builtin_amdgcn_sched_barrier(0)
    Unit cur, nxt; int ui = 0;
    if (!S.next(0, cur)) return;
    f32x4 acc[2][2][4][2];
#pragma unroll
    for (int a = 0; a < 2; ++a)
#pragma unroll
        for (int b = 0; b < 2; ++b)
#pragma unroll
            for (int m = 0; m < 4; ++m)
#pragma unroll
                for (int n = 0; n < 2; ++n) acc[a][b][m][n] = (f32x4){0.f, 0.f, 0.f, 0.f};
    bf16x8 At[4][2], B0[2][2], B1[2][2];
    float rfpre[8];
#pragma unroll
    for (int g_ = 0; g_ < 8; ++g_) rfpre[g_] = 0.f;
    const char* cA = (const char*)g.A + (size_t)cur.pm * tstep; const char* cB = (const char*)g.Bt + (size_t)cur.pn * tstep;
    S.a_ready(cur);
    if constexpr (SP2) {
        PG8_STAGE(PG8_SB(0, 0), cB, voffB); PG8_STAGE(PG8_SB(0, 1), cB + hstep, voffB); PG8_STAGE(PG8_SA(0, 0), cA, voffA); PG8_STAGE(PG8_SA(0, 1), cA + hstep, voffA);
        if (wr == 1) PG8_BAR;
        PG8_WAIT_V(2); PG8_BAR;
        PG8_STAGE(PG8_SB(1, 0), cB + kstep, voffB); PG8_STAGE(PG8_SA(1, 0), cA + kstep, voffA); PG8_STAGE(PG8_SB(1, 1), cB + hstep + kstep, voffB);
        PG8_WAIT_V(6); PG8_BAR;
    } else {
        PG8_STAGE(PG8_SB(0, 0), cB, voffB); PG8_STAGE(PG8_SA(0, 0), cA, voffA); PG8_STAGE(PG8_SB(0, 1), cB + hstep, voffB); PG8_STAGE(PG8_SA(0, 1), cA + hstep, voffA);
        if (wr == 1) PG8_BAR;
        PG8_WAIT_V(4); PG8_BAR;
        PG8_STAGE(PG8_SB(1, 0), cB + kstep, voffB); PG8_STAGE(PG8_SA(1, 0), cA + kstep, voffA); PG8_STAGE(PG8_SB(1, 1), cB + hstep + kstep, voffB);
        PG8_WAIT_V(6); PG8_BAR;
    }
    for (;;) {
        const bool has_next = S.next(ui + 1, nxt);
        const char* nA = has_next ? (const char*)g.A + (size_t)nxt.pm * tstep : cA; const char* nB = has_next ? (const char*)g.Bt + (size_t)nxt.pn * tstep : cB;
        for (int t = 0; t < nt; t += 2) {
            const bool last = (t == nt - 2);
            if (last) E.prefetch(rfpre, cur, wr);
            const char* a1 = cA + (size_t)(t + 1) * kstep;
            const char* a2 = last ? nA : cA + (size_t)(t + 2) * kstep; const char* b2 = last ? nB : cB + (size_t)(t + 2) * kstep;
            const char* a3 = a2 + kstep; const char* b3 = b2 + kstep;
            if (last && has_next) S.a_ready(nxt);
            if constexpr (SP2) {
            PG8_LDB(B0, 0, 0); PG8_LDB(B1, 0, 1); PG8_SCHED; PG8_LDA(At, 0, 0); PG8_STAGE(PG8_SA(1, 1), a1 + hstep, voffA);
            PG8_WAIT_V(8); PG8_WAIT_L(0); PG8_BAR; PG8_MMA(0, 0, At, B0); PG8_MMA(0, 1, At, B1); PG8_BAR; PG8_SCHED;
            PG8_LDA(At, 0, 1); PG8_STAGE(PG8_SB(0, 0), b2, voffB); PG8_STAGE(PG8_SB(0, 1), b2 + hstep, voffB); PG8_STAGE(PG8_SA(0, 0), a2, voffA);
            PG8_WAIT_V(8); PG8_WAIT_L(0); PG8_BAR; PG8_MMA(1, 0, At, B0); PG8_MMA(1, 1, At, B1); PG8_BAR; PG8_SCHED;
            PG8_LDB(B0, 1, 0); PG8_LDB(B1, 1, 1); PG8_SCHED; PG8_LDA(At, 1, 0); PG8_STAGE(PG8_SA(0, 1), a2 + hstep, voffA);
            PG8_WAIT_V(8); PG8_WAIT_L(0); PG8_BAR; PG8_MMA(0, 0, At, B0); PG8_MMA(0, 1, At, B1); PG8_BAR; PG8_SCHED;
            PG8_LDA(At, 1, 1); PG8_STAGE(PG8_SB(1, 0), b3, voffB); PG8_STAGE(PG8_SB(1, 1), b3 + hstep, voffB); PG8_STAGE(PG8_SA(1, 0), a3, voffA);
            PG8_WAIT_V(8); PG8_WAIT_L(0); PG8_BAR; PG8_MMA(1, 0, At, B0); PG8_MMA(1, 1, At, B1); PG8_BAR; PG8_SCHED;
            } else {
            PG8_LDB(B0, 0, 0); PG8_SCHED; PG8_LDA(At, 0, 0); PG8_STAGE(PG8_SA(1, 1), a1 + hstep, voffA);
            PG8_WAIT_L(8); PG8_BAR; PG8_WAIT_L(0); PG8_MMA(0, 0, At, B0); PG8_BAR; PG8_SCHED;
            PG8_LDB(B1, 0, 1); PG8_STAGE(PG8_SB(0, 0), b2, voffB);
            PG8_BAR; PG8_WAIT_L(0); PG8_MMA(0, 1, At, B1); PG8_BAR;
            PG8_LDA(At, 0, 1); PG8_STAGE(PG8_SA(0, 0), a2, voffA);
            PG8_BAR; PG8_WAIT_L(0); PG8_MMA(1, 0, At, B0); PG8_BAR; PG8_SCHED;
            PG8_STAGE(PG8_SB(0, 1), b2 + hstep, voffB);
            PG8_WAIT_V(6); PG8_BAR; PG8_MMA(1, 1, At, B1); PG8_BAR;
            PG8_LDB(B0, 1, 0); PG8_SCHED; PG8_LDA(At, 1, 0); PG8_STAGE(PG8_SA(0, 1), a2 + hstep, voffA);
            PG8_WAIT_L(8); PG8_BAR; PG8_WAIT_L(0); PG8_MMA(0, 0, At, B0); PG8_BAR; PG8_SCHED;
            PG8_LDB(B1, 1, 1); PG8_STAGE(PG8_SB(1, 0), b3, voffB);
            PG8_BAR; PG8_WAIT_L(0); PG8_MMA(0, 1, At, B1); PG8_BAR;
            PG8_LDA(At, 1, 1); PG8_STAGE(PG8_SA(1, 0), a3, voffA);
            PG8_BAR; PG8_WAIT_L(0); PG8_MMA(1, 0, At, B0); PG8_BAR; PG8_SCHED;
            PG8_STAGE(PG8_SB(1, 1), b3 + hstep, voffB);
            PG8_WAIT_V(6); PG8_BAR; PG8_MMA(1, 1, At, B1); PG8_BAR;
            }
        }
        if constexpr (ALIGN_EPI) { if (wr == 0) PG8_BAR; }
        if constexpr (!Epi::AFTER_DRAIN) { E(acc, cur, wr, wc, fr, fq, rfpre); S.done(cur); }
        if (!has_next) break;
#pragma unroll
        for (int a = 0; a < 2; ++a)
#pragma unroll
            for (int b = 0; b < 2; ++b)
#pragma unroll
                for (int m = 0; m < 4; ++m)
#pragma unroll
                    for (int n = 0; n < 2; ++n) acc[a][b][m][n] = (f32x4){0.f, 0.f, 0.f, 0.f};
        cur = nxt; cA = nA; cB = nB; ++ui;
        if constexpr (ALIGN_EPI) { if (wr == 1) PG8_BAR; }
    }
    PG8_WAIT_V(0);
    if constexpr (!ALIGN_EPI) { if (wr == 0) PG8_BAR; }
    PG8_BAR;
    if constexpr (Epi::AFTER_DRAIN) { E.fused(acc, cur, wr, wc, fr, fq, lds, wid, lane); S.done(cur); }
#undef PG8_SA
#undef PG8_SB
#undef PG8_STAGE
#undef PG8_LDA
#undef PG8_LDB
#undef PG8_MMA
#undef PG8_WAIT_V
#undef PG8_WAIT_L
#undef PG8_BAR
#undef PG8_SCHED
}
}

constexpr int DM = 1024, NB = 8, SEQ = 2048, TP = NB * SEQ, DSEQ = 64, TS = NB * DSEQ, T = TP + TS, PAST = 4096;
constexpr int FF = 2816, NGU = 2 * FF;
constexpr int EV_IN = 2304, OD_IN = 1952, OD_INP = 2048;
constexpr float EPS = 1e-6f;
constexpr float LOG2E = 1.4426950408889634f;
constexpr float QS64 = 0.125f * LOG2E;
constexpr float QS96 = 0.10206207261596575f * LOG2E;

constexpr size_t O_Y = 0;
constexpr size_t O_AKP = (size_t)T * DM;
constexpr size_t O_AVP = O_AKP + 131072;
constexpr size_t O_BKP = O_AVP + 131072;
constexpr size_t O_BVP = O_BKP + 2097152;
constexpr size_t O_CP = O_BVP + 2097152;
constexpr size_t O_CKVP = O_CP + 8192;
constexpr size_t O_KPEP = O_CKVP + 2097152;
constexpr size_t O_AKS = O_KPEP + 524288;
constexpr size_t O_AVS = O_AKS + 131072;
constexpr size_t O_BKS = O_AVS + 131072;
constexpr size_t O_BVS = O_BKS + 2097152;
constexpr size_t O_CS = O_BVS + 2097152;
constexpr size_t O_CKVS = O_CS + 8192;
constexpr size_t O_KPES = O_CKVS + 65536;
constexpr size_t O_END = O_KPES + 16384;

constexpr size_t MiB = 1u << 20;
constexpr size_t WS_CTL = 0, CTL_ZERO_BYTES = 2 * MiB;
constexpr int CW_BAR = 4096;
constexpr size_t WS_ROWSQ = 65536;
constexpr size_t ROWSQ_STRIDE = (size_t)T * 4;
constexpr size_t WS_TAB = 2 * MiB;
constexpr size_t TAB_BIASA = 0, TAB_BIASB = 8192, TAB_ROPE = 32768;
constexpr int NPOS = 2112;
constexpr size_t WS_W = 3 * MiB;
constexpr size_t W_GU_BYTES = (size_t)NGU * DM * 2, W_D_BYTES = (size_t)DM * FF * 2;
constexpr size_t W_GU0 = 0;
constexpr size_t W_D0 = 4 * W_GU_BYTES;
constexpr size_t W_EVIN = W_D0 + 4 * W_D_BYTES;
constexpr size_t W_EVOUT = W_EVIN + (size_t)EV_IN * DM * 2;
constexpr size_t W_ODIN = W_EVOUT + (size_t)DM * DM * 2;
constexpr size_t W_ODOUT = W_ODIN + (size_t)OD_INP * DM * 2;
constexpr size_t W_QB = W_ODOUT + (size_t)DM * DM * 2;
constexpr size_t W_KVB = W_QB + (size_t)768 * 256 * 2;
constexpr size_t W_KVP = W_KVB + (size_t)1024 * 256 * 2;
constexpr size_t W_END = W_KVP + (size_t)1024 * 128 * 2;
static_assert(W_END <= 80 * MiB, "weights");
constexpr size_t WS_XB = 83 * MiB;
constexpr size_t WS_R = 116 * MiB;
constexpr size_t R_H = 0;
constexpr size_t R_QKV = 0;
constexpr size_t R_CAK = 96 * MiB, R_CAV = R_CAK + 262144, R_CBK = R_CAV + 262144, R_CBV = R_CBK + 4194304;
constexpr size_t R_MIX = 105 * MiB;
constexpr size_t R_U = 0;
constexpr size_t R_QA = R_U + (size_t)T * 512 * 2;
constexpr size_t R_KVA = R_QA + (size_t)T * 256 * 2;
constexpr size_t R_KPE = R_KVA + (size_t)T * 256 * 2;
constexpr size_t R_QD = R_KPE + (size_t)T * 32 * 2;
constexpr size_t R_KD = R_QD + (size_t)T * 768 * 2;
constexpr size_t R_VD = R_KD + (size_t)TP * 512 * 2;
constexpr size_t R_CKVS = R_VD + (size_t)TP * 512 * 2;
constexpr size_t R_PART = R_U;
constexpr int NSPLIT = 16;
constexpr size_t PART_BYTES = (size_t)64 * 66 * 4;
constexpr size_t R_PART_END = R_PART + (size_t)NB * 8 * NSPLIT * PART_BYTES;
static_assert(R_CBV + 4194304 <= R_MIX && R_PART_END <= R_QA && R_CKVS + (size_t)TS * 128 * 2 <= R_MIX && (size_t)T * FF * 2 <= R_CAK, "region R map");
constexpr size_t WS_END = WS_R + R_MIX + (size_t)T * DM * 2;
static_assert(WS_END <= 256 * MiB, "workspace");

constexpr int RING_OFF = 0, RING_BYTES = 131072;
constexpr int LDSCTL_OFF = RING_BYTES, MISC_OFF = LDSCTL_OFF + 320;
constexpr int LDS_BYTES = 147456;
constexpr int NWAVES = 8;

namespace ep {
using pg8::f32x4; using pg8::u32x4; using pg8::Unit; using pg8::bf16_t;
typedef unsigned u32x2 __attribute__((ext_vector_type(2)));
__device__ __forceinline__ unsigned pkbf(float lo, float hi) { return pg8::cvt_pk_bf16(lo, hi); }
__device__ __forceinline__ u32x4 pack8(const float* v) { u32x4 w; w.x = pkbf(v[0], v[1]); w.y = pkbf(v[2], v[3]); w.z = pkbf(v[4], v[5]); w.w = pkbf(v[6], v[7]); return w; }
__device__ __forceinline__ float red_fq(float s) { s += __shfl_xor(s, 16); s += __shfl_xor(s, 32); return s; }
struct Ctx { unsigned char* ws; float* out; const float* const* in; };
#define EP_OPEN() int z_ = 0; asm volatile("" : "+s"(z_)); { int le_; asm volatile("v_mbcnt_lo_u32_b32 %0, -1, 0\n\tv_mbcnt_hi_u32_b32 %0, -1, %0" : "=v"(le_)); fr = le_ & 15; fq = le_ >> 4; }     unsigned char* const ws_ = C.ws + z_; float* const out = C.out + z_; const float* const* const in_ = C.in + z_; (void)ws_; (void)out; (void)in_
#define EPW(T_, off) ((T_*)(ws_ + (off)))
#define EP_ROWF(name, ptr, scale) float name[8]; { (void)(ptr); _Pragma("unroll") for (int g_ = 0; g_ < 8; ++g_) name[g_] = __builtin_amdgcn_rsqf(rfpre[g_] * (scale) + EPS); }
#define EP_PREFETCH(off_expr) __device__ __forceinline__ void prefetch(float (&rf)[8], const Unit& u, int wr) const { \
        int le_; asm volatile("v_mbcnt_lo_u32_b32 %0, -1, 0\n\tv_mbcnt_hi_u32_b32 %0, -1, %0" : "=v"(le_)); const int fr_ = le_ & 15; \
        unsigned char* ws_ = C.ws; asm volatile("" : "+s"(ws_)); const float* p_ = (const float*)(ws_ + (off_expr)); \
        _Pragma("unroll") for (int g_ = 0; g_ < 8; ++g_) rf[g_] = p_[u.pm * 256 + (g_ >> 2) * 128 + wr * 64 + (g_ & 3) * 16 + fr_]; }
__device__ __forceinline__ int pos_index(int row) { return row < TP ? (row & (SEQ - 1)) : SEQ + ((row - TP) & (DSEQ - 1)); }

struct EpiGU {
    static constexpr bool PERM = false, AFTER_DRAIN = false;
    Ctx C; int rsi;
    EP_PREFETCH(WS_ROWSQ + (size_t)rsi * ROWSQ_STRIDE)
    __device__ __forceinline__ void operator()(const f32x4 (&acc)[2][2][4][2], const Unit& u, int wr, int wc, int fr, int fq, const float (&rfpre)[8]) const {
        EP_OPEN(); bf16_t* const H = EPW(bf16_t, WS_R + R_H); const float* const rowsq = EPW(float, WS_ROWSQ + (size_t)rsi * ROWSQ_STRIDE);
        EP_ROWF(rf, rowsq, 1.0f / DM);
#pragma unroll
        for (int ai = 0; ai < 2; ++ai)
#pragma unroll
            for (int m = 0; m < 4; ++m) {
                const int row = u.pm * 256 + ai * 128 + wr * 64 + m * 16 + fr;
                const float r = rf[4 * ai + m];
                const pg8::f32x2 nr = {-LOG2E * r, -LOG2E * r}, r2 = {r * r, r * r}, one = {1.0f, 1.0f};
                pg8::f32x2 tt[4], pp[4];
#pragma unroll
                for (int q = 0; q < 4; ++q) { const pg8::f32x2 a = {acc[ai][0][m][q >> 1][2 * (q & 1)], acc[ai][0][m][q >> 1][2 * (q & 1) + 1]}, b = {acc[ai][1][m][q >> 1][2 * (q & 1)], acc[ai][1][m][q >> 1][2 * (q & 1) + 1]};
                    tt[q] = a * nr; pp[q] = (a * b) * r2; }
#pragma unroll
                for (int q = 0; q < 4; ++q) { tt[q].x = __builtin_amdgcn_exp2f(tt[q].x); tt[q].y = __builtin_amdgcn_exp2f(tt[q].y); }
#pragma unroll
                for (int q = 0; q < 4; ++q) tt[q] = tt[q] + one;
#pragma unroll
                for (int q = 0; q < 4; ++q) { tt[q].x = __builtin_amdgcn_rcpf(tt[q].x); tt[q].y = __builtin_amdgcn_rcpf(tt[q].y); }
                float hv[8];
#pragma unroll
                for (int q = 0; q < 4; ++q) { const pg8::f32x2 hq = pp[q] * tt[q]; hv[2 * q] = hq.x; hv[2 * q + 1] = hq.y; }
                *(u32x4*)(H + (size_t)row * FF + u.pn * 128 + wc * 32 + 8 * fq) = pack8(hv);
                asm volatile("" ::: "memory");
            }
    }
};

struct EpiResid {
    static constexpr bool PERM = false, AFTER_DRAIN = false;
    Ctx C; int last, rsi; float alpha;
    __device__ __forceinline__ void prefetch(float (&)[8], const Unit&, int) const {}
    __device__ __forceinline__ void operator()(const f32x4 (&acc)[2][2][4][2], const Unit& u, int wr, int wc, int fr, int fq, const float (&)[8]) const {
        EP_OPEN(); bf16_t* const xb = EPW(bf16_t, WS_XB); float* const rowsq = last ? nullptr : EPW(float, WS_ROWSQ + (size_t)rsi * ROWSQ_STRIDE);
        u32x4 xa[2][2];
        const int colb = u.pn * 256 + wc * 32 + 8 * fq;
#define EPR_LOAD(slot, g) do { const int row_ = u.pm * 256 + ((g) >> 2) * 128 + wr * 64 + ((g) & 3) * 16 + fr; \
            _Pragma("unroll") for (int bj = 0; bj < 2; ++bj) xa[slot][bj] = *(const u32x4*)(xb + (size_t)row_ * DM + colb + bj * 128); } while (0)
        EPR_LOAD(0, 0);
        float ssg[8];
#pragma unroll
        for (int g = 0; g < 8; ++g) {
            const int ai = g >> 2, m = g & 3, sl = g & 1;
            if (g < 7) EPR_LOAD(sl ^ 1, g + 1);
            const int row = u.pm * 256 + ai * 128 + wr * 64 + m * 16 + fr;
            pg8::f32x2 s2 = {0.f, 0.f};
#pragma unroll
            for (int bj = 0; bj < 2; ++bj) {
                const int col = colb + bj * 128; const u32x4 xo = xa[sl][bj];
                const f32x4 x0 = (f32x4){__uint_as_float(xo.x << 16), __uint_as_float(xo.x & 0xffff0000u), __uint_as_float(xo.y << 16), __uint_as_float(xo.y & 0xffff0000u)};
                const f32x4 x1 = (f32x4){__uint_as_float(xo.z << 16), __uint_as_float(xo.z & 0xffff0000u), __uint_as_float(xo.w << 16), __uint_as_float(xo.w & 0xffff0000u)};
                const f32x4 v0 = x0 + acc[ai][bj][m][0] * alpha, v1 = x1 + acc[ai][bj][m][1] * alpha;
                if (last) { *(f32x4*)(out + (size_t)row * DM + col) = v0; *(f32x4*)(out + (size_t)row * DM + col + 4) = v1; }
                else { u32x4 w; w.x = pkbf(v0[0], v0[1]); w.y = pkbf(v0[2], v0[3]); w.z = pkbf(v1[0], v1[1]); w.w = pkbf(v1[2], v1[3]); *(u32x4*)(xb + (size_t)row * DM + col) = w; }
                s2 = s2 + v0.lo * v0.lo; s2 = s2 + v0.hi * v0.hi; s2 = s2 + v1.lo * v1.lo; s2 = s2 + v1.hi * v1.hi;
            }
            ssg[g] = s2.x + s2.y;
            asm volatile("" ::: "memory");
        }
        if (rowsq) {
#pragma unroll
            for (int g = 0; g < 8; ++g) ssg[g] += __shfl_xor(ssg[g], 16);
#pragma unroll
            for (int g = 0; g < 8; ++g) ssg[g] += __shfl_xor(ssg[g], 32);
            if (fq == 0) {
#pragma unroll
                for (int g = 0; g < 8; ++g) atomicAdd(rowsq + (u.pm * 256 + (g >> 2) * 128 + wr * 64 + (g & 3) * 16 + fr), ssg[g]);
            }
        }
#undef EPR_LOAD
    }
};

struct EpiEvIn {
    static constexpr bool PERM = false, AFTER_DRAIN = false;
    Ctx C;
    EP_PREFETCH(WS_ROWSQ + 1 * ROWSQ_STRIDE)
    __device__ __forceinline__ void operator()(const f32x4 (&acc)[2][2][4][2], const Unit& u, int wr, int wc, int fr, int fq, const float (&rfpre)[8]) const {
        EP_OPEN(); bf16_t* const QKV = EPW(bf16_t, WS_R + R_QKV); const float* const rowsq = EPW(float, WS_ROWSQ + 1 * ROWSQ_STRIDE);
        EP_ROWF(rf, rowsq, 1.0f / DM);
        const int hs = 4 * u.pn + wc;
        const float* gp = hs < 8 ? in_[19] : hs < 10 ? in_[20] : hs < 12 ? nullptr : hs < 20 ? in_[22] : hs < 28 ? in_[23] : nullptr;
        const float qs = (hs < 8 || (hs >= 12 && hs < 20)) ? QS64 : 1.0f;
        float gv[2][8];
#pragma unroll
        for (int bj = 0; bj < 2; ++bj)
#pragma unroll
            for (int j = 0; j < 8; ++j) gv[bj][j] = gp ? gp[32 * bj + 8 * fq + j] * qs : 1.0f;
        int kind = 0; int hh = 0;
        if (hs >= 8 && hs < 10) { kind = 1; hh = hs - 8; } else if (hs >= 10 && hs < 12) { kind = 2; hh = hs - 10; } else if (hs >= 20 && hs < 28) { kind = 3; hh = hs - 20; } else if (hs >= 28) { kind = 4; hh = hs - 28; }
#pragma unroll
        for (int ai = 0; ai < 2; ++ai)
#pragma unroll
            for (int m = 0; m < 4; ++m) {
                const int row = u.pm * 256 + ai * 128 + wr * 64 + m * 16 + fr;
                const float r = rf[4 * ai + m];
                float v[2][8]; float ss = 0.f;
#pragma unroll
                for (int bj = 0; bj < 2; ++bj)
#pragma unroll
                    for (int n = 0; n < 2; ++n)
#pragma unroll
                        for (int e = 0; e < 4; ++e) { const float x = acc[ai][bj][m][n][e] * r; v[bj][4 * n + e] = x; ss += x * x; }
                if (gp) { ss = red_fq(ss); const float r2 = __builtin_amdgcn_rsqf(ss * (1.0f / 64.0f) + EPS);
#pragma unroll
                    for (int bj = 0; bj < 2; ++bj)
#pragma unroll
                        for (int j = 0; j < 8; ++j) v[bj][j] = v[bj][j] * r2 * gv[bj][j]; }
#pragma unroll
                for (int bj = 0; bj < 2; ++bj) *(u32x4*)(QKV + (size_t)row * EV_IN + 64 * hs + 32 * bj + 8 * fq) = pack8(v[bj]);
                if (kind) {
                    float* dst = nullptr;
                    if (row < TP) { const int b = row >> 11, t = row & (SEQ - 1);
                        if (kind <= 2) { if (t >= SEQ - 128) dst = out + (kind == 1 ? O_AKP : O_AVP) + ((size_t)(b * 128 + t - (SEQ - 128)) * 2 + hh) * 64; }
                        else { if (t >= SEQ - 512) dst = out + (kind == 3 ? O_BKP : O_BVP) + ((size_t)(b * 512 + t - (SEQ - 512)) * 8 + hh) * 64; }
                    } else { const int b = (row - TP) >> 6, t = (row - TP) & 63;
                        if (kind <= 2) dst = out + (kind == 1 ? O_AKS : O_AVS) + ((size_t)(b * 128 + 64 + t) * 2 + hh) * 64;
                        else dst = out + (kind == 3 ? O_BKS : O_BVS) + ((size_t)(b * 512 + 448 + t) * 8 + hh) * 64;
                    }
                    if (dst) {
#pragma unroll
                        for (int bj = 0; bj < 2; ++bj) { float* d = dst + 32 * bj + 8 * fq;
                            *(f32x4*)d = (f32x4){v[bj][0], v[bj][1], v[bj][2], v[bj][3]}; *(f32x4*)(d + 4) = (f32x4){v[bj][4], v[bj][5], v[bj][6], v[bj][7]}; }
                    }
                }
                asm volatile("" ::: "memory");
            }
    }
};

__device__ __forceinline__ void rope8(float (&v)[8], int fq, const float* ropetab, int pidx) {
    const float* ct = ropetab + (size_t)pidx * 16 + 8 * (fq & 1); const float* st = ct + (size_t)NPOS * 16;
#pragma unroll
    for (int j = 0; j < 8; ++j) { const float other = __shfl_xor(v[j], 32); const float c = ct[j], s = st[j];
        v[j] = fq < 2 ? v[j] * c - other * s : other * s + v[j] * c; }
}

struct EpiOdIn {
    static constexpr bool PERM = false, AFTER_DRAIN = false;
    Ctx C;
    EP_PREFETCH(WS_ROWSQ + 4 * ROWSQ_STRIDE)
    __device__ __forceinline__ void operator()(const f32x4 (&acc)[2][2][4][2], const Unit& u, int wr, int wc, int fr, int fq, const float (&rfpre)[8]) const {
        EP_OPEN(); bf16_t* const MIX = EPW(bf16_t, WS_R + R_MIX); bf16_t* const U = EPW(bf16_t, WS_R + R_U); bf16_t* const QA = EPW(bf16_t, WS_R + R_QA); bf16_t* const KVA = EPW(bf16_t, WS_R + R_KVA); bf16_t* const KPE = EPW(bf16_t, WS_R + R_KPE);
        const float* const rowsq = EPW(float, WS_ROWSQ + 4 * ROWSQ_STRIDE); float* const rsq_qa = EPW(float, WS_ROWSQ + 6 * ROWSQ_STRIDE); float* const rsq_kva = EPW(float, WS_ROWSQ + 7 * ROWSQ_STRIDE);
        const float* const knr = in_[35]; const float* const ropetab = EPW(float, WS_TAB + TAB_ROPE);
        const int pn = u.pn;
        EP_ROWF(rf, rowsq, 1.0f / DM);
#pragma unroll
        for (int ai = 0; ai < 2; ++ai)
#pragma unroll
            for (int m = 0; m < 4; ++m) {
                const int row = u.pm * 256 + ai * 128 + wr * 64 + m * 16 + fr;
                const float r = rf[4 * ai + m];
                float v[2][8];
#pragma unroll
                for (int bj = 0; bj < 2; ++bj)
#pragma unroll
                    for (int n = 0; n < 2; ++n)
#pragma unroll
                        for (int e = 0; e < 4; ++e) v[bj][4 * n + e] = acc[ai][bj][m][n][e] * r;
                if (pn < 2) {
#pragma unroll
                    for (int bj = 0; bj < 2; ++bj) *(u32x4*)(MIX + (size_t)row * DM + 256 * pn + 128 * bj + 32 * wc + 8 * fq) = pack8(v[bj]);
                } else if (pn < 6) {
                    float uu[8];
#pragma unroll
                    for (int j = 0; j < 8; ++j) uu[j] = v[0][j] * v[1][j];
                    const int idx = 128 * (pn - 2) + 32 * wc + 8 * fq;
                    *(u32x4*)(U + (size_t)row * 512 + idx) = pack8(uu);
                    float* dst = nullptr;
                    if (row < TP) { const int b = row >> 11, t = row & (SEQ - 1); if (t >= SEQ - 2) dst = out + O_CP + (size_t)(b * 2 + t - (SEQ - 2)) * 512 + idx; }
                    else { const int b = (row - TP) >> 6, t = (row - TP) & 63; if (t >= 62) dst = out + O_CS + (size_t)(b * 2 + t - 62) * 512 + idx; }
                    if (dst) { *(f32x4*)dst = (f32x4){uu[0], uu[1], uu[2], uu[3]}; *(f32x4*)(dst + 4) = (f32x4){uu[4], uu[5], uu[6], uu[7]}; }
                } else if (pn == 6) {
                    float ss = 0.f;
#pragma unroll
                    for (int bj = 0; bj < 2; ++bj) { *(u32x4*)(QA + (size_t)row * 256 + 128 * bj + 32 * wc + 8 * fq) = pack8(v[bj]);
#pragma unroll
                        for (int j = 0; j < 8; ++j) ss += v[bj][j] * v[bj][j]; }
                    ss = red_fq(ss); if (fq == 0) atomicAdd(rsq_qa + row, ss);
                } else {
                    float ss = 0.f;
#pragma unroll
                    for (int j = 0; j < 8; ++j) ss += v[0][j] * v[0][j];
                    *(u32x4*)(KVA + (size_t)row * 256 + 32 * wc + 8 * fq) = pack8(v[0]);
                    *(u32x4*)(KVA + (size_t)row * 256 + 128 + 32 * wc + 8 * fq) = (u32x4){0u, 0u, 0u, 0u};
                    ss = red_fq(ss); if (fq == 0) atomicAdd(rsq_kva + row, ss);
                    if (wc == 0) {
                        float s2 = 0.f;
#pragma unroll
                        for (int j = 0; j < 8; ++j) s2 += v[1][j] * v[1][j];
                        s2 = red_fq(s2); const float r2 = __builtin_amdgcn_rsqf(s2 * (1.0f / 32.0f) + EPS);
                        float k[8];
#pragma unroll
                        for (int j = 0; j < 8; ++j) k[j] = v[1][j] * r2 * knr[8 * fq + j];
                        rope8(k, fq, ropetab, pos_index(row));
                        float* dst = row < TP ? out + O_KPEP + (size_t)row * 32 + 8 * fq : out + O_KPES + (size_t)(row - TP) * 32 + 8 * fq;
                        *(f32x4*)dst = (f32x4){k[0], k[1], k[2], k[3]}; *(f32x4*)(dst + 4) = (f32x4){k[4], k[5], k[6], k[7]};
                        *(u32x4*)(KPE + (size_t)row * 32 + 8 * fq) = pack8(k);
                    }
                }
                asm volatile("" ::: "memory");
            }
    }
};

struct EpiQb {
    static constexpr bool PERM = false, AFTER_DRAIN = false;
    Ctx C;
    EP_PREFETCH(WS_ROWSQ + 6 * ROWSQ_STRIDE)
    __device__ __forceinline__ void operator()(const f32x4 (&acc)[2][2][4][2], const Unit& u, int wr, int wc, int fr, int fq, const float (&rfpre)[8]) const {
        EP_OPEN(); bf16_t* const QD = EPW(bf16_t, WS_R + R_QD); const float* const rsq_qa = EPW(float, WS_ROWSQ + 6 * ROWSQ_STRIDE); const float* const qnn = in_[32]; const float* const qnr = in_[33]; const float* const ropetab = EPW(float, WS_TAB + TAB_ROPE);
        const int pn = u.pn;
        EP_ROWF(rf, rsq_qa, 1.0f / 256.0f);
        float gv[2][8];
#pragma unroll
        for (int bj = 0; bj < 2; ++bj)
#pragma unroll
            for (int j = 0; j < 8; ++j) gv[bj][j] = (pn < 2 ? qnn[32 * bj + 8 * fq + j] : qnr[8 * fq + j]) * QS96;
#pragma unroll
        for (int ai = 0; ai < 2; ++ai)
#pragma unroll
            for (int m = 0; m < 4; ++m) {
                const int row = u.pm * 256 + ai * 128 + wr * 64 + m * 16 + fr;
                const float r = rf[4 * ai + m];
                float v[2][8]; float ss[2] = {0.f, 0.f};
#pragma unroll
                for (int bj = 0; bj < 2; ++bj)
#pragma unroll
                    for (int n = 0; n < 2; ++n)
#pragma unroll
                        for (int e = 0; e < 4; ++e) { const float x = acc[ai][bj][m][n][e] * r; v[bj][4 * n + e] = x; ss[bj] += x * x; }
                if (pn < 2) {
                    const float s = red_fq(ss[0] + ss[1]); const float r2 = __builtin_amdgcn_rsqf(s * (1.0f / 64.0f) + EPS);
                    const int head = 4 * pn + wc;
#pragma unroll
                    for (int bj = 0; bj < 2; ++bj) {
#pragma unroll
                        for (int j = 0; j < 8; ++j) v[bj][j] = v[bj][j] * r2 * gv[bj][j];
                        *(u32x4*)(QD + (size_t)row * 768 + head * 96 + 32 * bj + 8 * fq) = pack8(v[bj]); }
                } else {
                    const int pidx = pos_index(row);
#pragma unroll
                    for (int bj = 0; bj < 2; ++bj) {
                        const float s = red_fq(ss[bj]); const float r2 = __builtin_amdgcn_rsqf(s * (1.0f / 32.0f) + EPS);
#pragma unroll
                        for (int j = 0; j < 8; ++j) v[bj][j] = v[bj][j] * r2 * gv[bj][j];
                        rope8(v[bj], fq, ropetab, pidx);
                        const int head = 2 * wc + bj;
                        *(u32x4*)(QD + (size_t)row * 768 + head * 96 + 64 + 8 * fq) = pack8(v[bj]); }
                }
                asm volatile("" ::: "memory");
            }
    }
};

struct EpiKvb {
    static constexpr bool PERM = false, AFTER_DRAIN = false;
    Ctx C;
    EP_PREFETCH(WS_ROWSQ + 7 * ROWSQ_STRIDE)
    __device__ __forceinline__ void operator()(const f32x4 (&acc)[2][2][4][2], const Unit& u, int wr, int wc, int fr, int fq, const float (&rfpre)[8]) const {
        EP_OPEN(); bf16_t* const KD = EPW(bf16_t, WS_R + R_KD); bf16_t* const VD = EPW(bf16_t, WS_R + R_VD); const float* const rsq_kva = EPW(float, WS_ROWSQ + 7 * ROWSQ_STRIDE); const float* const knn = in_[34];
        const int head = 2 * u.pn + (wc >> 1), part = wc & 1;
        EP_ROWF(rf, rsq_kva, 1.0f / 128.0f);
        float gv[2][8];
#pragma unroll
        for (int bj = 0; bj < 2; ++bj)
#pragma unroll
            for (int j = 0; j < 8; ++j) gv[bj][j] = knn[32 * bj + 8 * fq + j];
#pragma unroll
        for (int ai = 0; ai < 2; ++ai)
#pragma unroll
            for (int m = 0; m < 4; ++m) {
                const int row = u.pm * 256 + ai * 128 + wr * 64 + m * 16 + fr;
                const float r = rf[4 * ai + m];
                float v[2][8]; float ss = 0.f;
#pragma unroll
                for (int bj = 0; bj < 2; ++bj)
#pragma unroll
                    for (int n = 0; n < 2; ++n)
#pragma unroll
                        for (int e = 0; e < 4; ++e) { const float x = acc[ai][bj][m][n][e] * r; v[bj][4 * n + e] = x; ss += x * x; }
                if (part == 0) { ss = red_fq(ss); const float r2 = __builtin_amdgcn_rsqf(ss * (1.0f / 64.0f) + EPS);
#pragma unroll
                    for (int bj = 0; bj < 2; ++bj)
#pragma unroll
                        for (int j = 0; j < 8; ++j) v[bj][j] = v[bj][j] * r2 * gv[bj][j]; }
                bf16_t* dst = (part == 0 ? KD : VD) + (size_t)row * 512 + head * 64 + 8 * fq;
#pragma unroll
                for (int bj = 0; bj < 2; ++bj) *(u32x4*)(dst + 32 * bj) = pack8(v[bj]);
                asm volatile("" ::: "memory");
            }
    }
};

struct EpiNull {
    static constexpr bool PERM = false, AFTER_DRAIN = false;
    __device__ __forceinline__ void prefetch(float (&)[8], const Unit&, int) const {}
    __device__ __forceinline__ void operator()(const f32x4 (&acc)[2][2][4][2], const Unit& u, int wr, int wc, int fr, int fq, const float (&)[8]) const {
#pragma unroll
        for (int ai = 0; ai < 2; ++ai)
#pragma unroll
            for (int bj = 0; bj < 2; ++bj)
#pragma unroll
                for (int m = 0; m < 4; ++m)
#pragma unroll
                    for (int n = 0; n < 2; ++n) asm volatile("" :: "v"(acc[ai][bj][m][n]));
    }
};
}

typedef unsigned u32x2t __attribute__((ext_vector_type(2)));
struct Frame {
    LAS unsigned char* lds;
    volatile LAS unsigned* MISC;
    gu32* ctl;
    int vcu, G, wave_s;
    const float* const* in;
    float* out; unsigned char* ws;
};
#define WSP(T_, off) ((T_*)(F.ws + (off)))
#define LOCAL_IDS() int lane_; asm volatile("v_mbcnt_lo_u32_b32 %0, -1, 0\n\tv_mbcnt_hi_u32_b32 %0, -1, %0" : "=v"(lane_)); const int lane = lane_; const int wave = F.wave_s; const int tid = wave * 64 + lane; (void)tid
__device__ __forceinline__ float wave_sum(float v) {
#pragma unroll
    for (int o = 1; o < 64; o <<= 1) v += __shfl_xor(v, o);
    return v;
}

struct WMat { const float* W; int K, Nsrc; bf16* dst; int Kdst, ngroups; const float* gain; int kind; int natural; };
__device__ __forceinline__ int wsrc_base(int kind, int G) {
    const int pn = G >> 3, bj = (G >> 2) & 1, wc = G & 3;
    switch (kind) {
    case 0: return 32 * G;
    case 1: return bj * FF + 128 * pn + 32 * wc;
    case 2: return 256 * pn + 64 * wc + 32 * bj;
    case 3: if (pn < 2) return 32 * G; if (pn < 6) return (bj ? 1024 : 512) + 128 * (pn - 2) + 32 * wc; if (pn == 6) return 1536 + 128 * bj + 32 * wc;
            return bj == 0 ? 1792 + 32 * wc : (wc == 0 ? 1920 : -1);
    case 4: if (pn < 2) return 96 * (4 * pn + wc) + 32 * bj; return 96 * (2 * wc + bj) + 64;
    default: return 128 * (2 * pn + (wc >> 1)) + 64 * (wc & 1) + 32 * bj;
    }
}
__device__ __forceinline__ void wconv_item(const WMat& M, int item, LAS float* scr, int lane) {
    const int nkb = M.Kdst / 64, G = item / nkb, kb = item % nkb, k0 = 64 * kb;
    const int sb = wsrc_base(M.kind, G);
    const bool zero = (sb < 0) || (k0 >= M.K);
    const int c = lane & 7;
    float gk[8];
#pragma unroll
    for (int i = 0; i < 8; ++i) gk[i] = 1.0f;
    if (!zero) {
        float wv[32];
        const float* wp = M.W + (size_t)(k0 + (lane >> 5)) * M.Nsrc + sb + (lane & 31);
#pragma unroll
        for (int i = 0; i < 32; ++i) wv[i] = wp[(size_t)(2 * i) * M.Nsrc];
        if (M.gain) {
#pragma unroll
            for (int i = 0; i < 8; ++i) gk[i] = M.gain[k0 + 8 * c + i]; }
#pragma unroll
        for (int i = 0; i < 32; ++i) scr[(2 * i + (lane >> 5)) * 33 + (lane & 31)] = wv[i];
    }
    LDS_WAIT(); asm volatile("" ::: "memory");
#pragma unroll
    for (int j = 0; j < 4; ++j) { const int rho = (lane >> 3) + 8 * j; const int n = M.natural ? rho : pg8::perm32(rho); const LAS float* s = scr + (8 * c) * 33 + n;
        v4u o; if (zero) o = (v4u){0u, 0u, 0u, 0u}; else { o.x = pk2(s[0 * 33] * gk[0], s[1 * 33] * gk[1]); o.y = pk2(s[2 * 33] * gk[2], s[3 * 33] * gk[3]); o.z = pk2(s[4 * 33] * gk[4], s[5 * 33] * gk[5]); o.w = pk2(s[6 * 33] * gk[6], s[7 * 33] * gk[7]); }
        *(GAS v4u*)(M.dst + (size_t)(32 * G + rho) * M.Kdst + k0 + 8 * c) = o; }
    LDS_WAIT(); asm volatile("" ::: "memory");
}

__device__ __forceinline__ int t5_bucket(int rel) {
    int n = -rel; int ret = n < 0 ? 16 : 0; n = n < 0 ? -n : n;
    if (n < 8) return ret + n;
    const int q = (n * n) >> 6; int lg = 31 - __builtin_clz(q); int large = 8 + lg; if (large > 15) large = 15;
    return ret + large;
}

__device__ __forceinline__ WMat get_mat(const Frame& F, int mi) {
    const float* const* in = F.in; WMat M;
    if (mi < 8) { const int l = mi >> 2, f = (mi >> 1) & 1;
        if ((mi & 1) == 0) { M.W = (f ? in[14] : in[10]) + (size_t)l * DM * NGU; M.K = DM; M.Nsrc = NGU; M.dst = (bf16*)(F.ws + WS_W + W_GU0 + (size_t)(l * 2 + f) * W_GU_BYTES); M.Kdst = DM; M.ngroups = NGU / 32; M.gain = (f ? in[13] : in[9]) + l * DM; M.kind = 1; M.natural = 0; }
        else { M.W = (f ? in[15] : in[11]) + (size_t)l * FF * DM; M.K = FF; M.Nsrc = DM; M.dst = (bf16*)(F.ws + WS_W + W_D0 + (size_t)(l * 2 + f) * W_D_BYTES); M.Kdst = FF; M.ngroups = DM / 32; M.gain = nullptr; M.kind = 0; M.natural = 0; }
    } else if (mi == 8) { M.W = in[17]; M.K = DM; M.Nsrc = EV_IN; M.dst = (bf16*)(F.ws + WS_W + W_EVIN); M.Kdst = DM; M.ngroups = EV_IN / 32; M.gain = in[12]; M.kind = 2; M.natural = 0; }
    else if (mi == 9) { M.W = in[18]; M.K = DM; M.Nsrc = DM; M.dst = (bf16*)(F.ws + WS_W + W_EVOUT); M.Kdst = DM; M.ngroups = DM / 32; M.gain = nullptr; M.kind = 0; M.natural = 0; }
    else if (mi == 10) { M.W = in[25]; M.K = DM; M.Nsrc = OD_IN; M.dst = (bf16*)(F.ws + WS_W + W_ODIN); M.Kdst = DM; M.ngroups = OD_INP / 32; M.gain = in[12] + DM; M.kind = 3; M.natural = 0; }
    else if (mi == 11) { M.W = in[26]; M.K = DM; M.Nsrc = DM; M.dst = (bf16*)(F.ws + WS_W + W_ODOUT); M.Kdst = DM; M.ngroups = DM / 32; M.gain = nullptr; M.kind = 0; M.natural = 0; }
    else if (mi == 12) { M.W = in[29]; M.K = 256; M.Nsrc = 768; M.dst = (bf16*)(F.ws + WS_W + W_QB); M.Kdst = 256; M.ngroups = 768 / 32; M.gain = in[28]; M.kind = 4; M.natural = 0; }
    else if (mi == 13) { M.W = in[31]; M.K = 128; M.Nsrc = 1024; M.dst = (bf16*)(F.ws + WS_W + W_KVB); M.Kdst = 256; M.ngroups = 1024 / 32; M.gain = in[30]; M.kind = 5; M.natural = 0; }
    else { M.W = in[31]; M.K = 128; M.Nsrc = 1024; M.dst = (bf16*)(F.ws + WS_W + W_KVP); M.Kdst = 128; M.ngroups = 1024 / 32; M.gain = nullptr; M.kind = 0; M.natural = 1; }
    return M;
}

__device__ __forceinline__ void wconv_set(Frame& F, unsigned mask, int cu0, int ncu) {
    const int cu = (int)blockIdx.x - cu0; if (cu < 0 || cu >= ncu) return;
    LOCAL_IDS();
    LAS float* scr = (LAS float*)(F.lds + RING_OFF + wave * 16384);
    const int gw = cu * NWAVES + wave, NGW = ncu * NWAVES;
    int base = 0;
#pragma unroll 1
    for (int mi = 0; mi < 15; ++mi) {
        if (!((mask >> mi) & 1u)) continue;
        const WMat M = get_mat(F, mi);
        const int nitems = M.ngroups * (M.Kdst / 64);
        for (int it = (gw + NGW - (base % NGW)) % NGW; it < nitems; it += NGW) wconv_item(M, it, scr, lane);
        base += nitems;
    }
}
constexpr unsigned WSET_PROLOGUE = 0x001u;
constexpr unsigned WSET_PH1 = 0x306u;
constexpr unsigned WSET_PH3 = 0x7c38u;
constexpr unsigned WSET_PH6 = 0x0c0u;
static_assert((WSET_PROLOGUE | WSET_PH1 | WSET_PH3 | WSET_PH6) == 0x7fffu && (WSET_PROLOGUE & WSET_PH1) == 0 && (WSET_PH1 & WSET_PH3) == 0 && (WSET_PH3 & WSET_PH6) == 0, "every matrix converted once");

__device__ __forceinline__ void p0_prologue(Frame& F) {
    LOCAL_IDS();
    LAS float* scr = (LAS float*)(F.lds + RING_OFF + wave * 16384);
    const int gw = F.vcu * NWAVES + wave, NGW = F.G * NWAVES;
    const float* const* in = F.in;
    wconv_set(F, WSET_PROLOGUE, 0, F.G);
    {
        bf16* XB = WSP(bf16, WS_XB); float* rs0 = WSP(float, WS_ROWSQ);
        for (int m = gw; m < T; m += NGW) {
            const float* xr = m < TP ? in[0] + (size_t)m * DM : in[1] + (size_t)(m - TP) * DM;
            const GAS f32x4* xv = (const GAS f32x4*)xr + lane; float s = 0.f;
            GAS unsigned long long* o8 = (GAS unsigned long long*)(XB + (size_t)m * DM) + lane;
#pragma unroll
            for (int j = 0; j < 4; ++j) { const f32x4 v = xv[64 * j]; s += (v.x * v.x + v.y * v.y) + (v.z * v.z + v.w * v.w);
                o8[64 * j] = (unsigned long long)pk2(v.x, v.y) | ((unsigned long long)pk2(v.z, v.w) << 32); }
            s = wave_sum(s); if (lane == 0) rs0[m] = s;
        }
    }
}
__device__ __forceinline__ void p0_aux(Frame& F, int cu0, int ncu) {
    const int cu = (int)blockIdx.x - cu0; if (cu < 0 || cu >= ncu) return;
    LOCAL_IDS();
    const int gw = cu * NWAVES + wave, NGW = ncu * NWAVES;
    const float* const* in = F.in;
    {
        const size_t gt = (size_t)gw * 64 + lane, NT_ = (size_t)NGW * 64;
        bf16* cak = WSP(bf16, WS_R + R_CAK); bf16* cav = WSP(bf16, WS_R + R_CAV); bf16* cbk = WSP(bf16, WS_R + R_CBK); bf16* cbv = WSP(bf16, WS_R + R_CBV);
        for (size_t i = gt; i < 131072 / 4; i += NT_) { const f32x4 a = ((const f32x4*)in[2])[i], b = ((const f32x4*)in[3])[i];
            ((u32x2t*)cak)[i] = (u32x2t){pk2(a.x, a.y), pk2(a.z, a.w)}; ((u32x2t*)cav)[i] = (u32x2t){pk2(b.x, b.y), pk2(b.z, b.w)}; }
        for (size_t i = gt; i < 2097152 / 4; i += NT_) { const f32x4 a = ((const f32x4*)in[4])[i], b = ((const f32x4*)in[5])[i];
            ((u32x2t*)cbk)[i] = (u32x2t){pk2(a.x, a.y), pk2(a.z, a.w)}; ((u32x2t*)cbv)[i] = (u32x2t){pk2(b.x, b.y), pk2(b.z, b.w)}; }
        for (size_t i = gt; i < (size_t)NB * 64 * 32; i += NT_) { const size_t b = i / (64 * 32), r = i % (64 * 32);
            ((f32x4*)(F.out + O_AKS))[b * 128 * 32 + r] = ((const f32x4*)in[2])[b * 128 * 32 + 64 * 32 + r];
            ((f32x4*)(F.out + O_AVS))[b * 128 * 32 + r] = ((const f32x4*)in[3])[b * 128 * 32 + 64 * 32 + r]; }
        for (size_t i = gt; i < (size_t)NB * 448 * 128; i += NT_) { const size_t b = i / (448 * 128), r = i % (448 * 128);
            ((f32x4*)(F.out + O_BKS))[b * 512 * 128 + r] = ((const f32x4*)in[4])[b * 512 * 128 + 64 * 128 + r];
            ((f32x4*)(F.out + O_BVS))[b * 512 * 128 + r] = ((const f32x4*)in[5])[b * 512 * 128 + 64 * 128 + r]; }
        float* biasA = WSP(float, WS_TAB + TAB_BIASA); float* biasB = WSP(float, WS_TAB + TAB_BIASB); float* rope = WSP(float, WS_TAB + TAB_ROPE);
        for (size_t i = gt; i < 8 * 256; i += NT_) { const int h = (int)(i >> 8), k = (int)(i & 255); const int rel = k - 191; biasA[i] = (k < 255) ? in[16][t5_bucket(rel) * 8 + h] * LOG2E : 0.f; }
        for (size_t i = gt; i < 8 * 640; i += NT_) { const int h = (int)(i / 640), k = (int)(i % 640); int rel = k - 575; rel = rel < -128 ? -128 : (rel > 128 ? 128 : rel); biasB[i] = in[24][h * 257 + rel + 128] * LOG2E; }
        for (size_t i = gt; i < (size_t)NPOS * 16; i += NT_) { const int p = (int)(i >> 4), j = (int)(i & 15); const int pos = p < SEQ ? p : PAST + (p - SEQ);
            const float inv = 1.0f / __builtin_powf(10000.0f, (float)j / 16.0f); const float ang = (float)pos * inv;
            const double a = (double)ang; const double k2 = __builtin_rint(a * 0.15915494309189535); const float red = (float)(a - k2 * 6.283185307179586);
            rope[i] = __builtin_cosf(red); rope[(size_t)NPOS * 16 + i] = __builtin_sinf(red); }
    }
}

namespace att {
#define GLD(T_, base_, boff_) (*(const GAS T_*)((const GAS unsigned char*)(base_) + (unsigned)(boff_)))
#define GST(T_, base_, boff_) (*(GAS T_*)((GAS unsigned char*)(base_) + (unsigned)(boff_)))
typedef short bf16x8 __attribute__((ext_vector_type(8)));
typedef short s16x4 __attribute__((ext_vector_type(4)));
typedef float f32x16 __attribute__((ext_vector_type(16)));
typedef unsigned u32x4 __attribute__((ext_vector_type(4)));
typedef unsigned u32x2 __attribute__((ext_vector_type(2)));
typedef float f32x2_t __attribute__((ext_vector_type(2))); typedef __bf16 bf16x2_t __attribute__((ext_vector_type(2)));
__device__ __forceinline__ unsigned cvtpk(float lo, float hi) { f32x2_t v = {lo, hi}; bf16x2_t b = __builtin_convertvector(v, bf16x2_t); return __builtin_bit_cast(unsigned, b); }
__device__ __forceinline__ s16x4 vtr(LAS const unsigned char* p) { typedef short v4i16_t __attribute__((ext_vector_type(4))); return __builtin_bit_cast(s16x4, __builtin_amdgcn_ds_read_tr16_b64_v4i16((LAS v4i16_t*)p)); }

constexpr int KSMAX = 208;
constexpr int L_K = 0, L_KBUF = 64 * KSMAX;
constexpr int L_V = 2 * L_KBUF, L_VBUF = 8192;
constexpr int L_TAB = L_V + 2 * L_VBUF;
constexpr int L_END = L_TAB + 28672 + 64;


template <int NKA, int NKB, bool BIAS, int VS = 64>
__device__ __forceinline__ void tile_step(const LAS unsigned char* Ka, int kaj, const LAS unsigned char* Kb, int kbj, const bf16x8* qf, const LAS float* tb, const LAS unsigned char* Vb,
                                          float& m, float& l, f32x16& o0, f32x16& o1) {
    constexpr int NK = NKA + NKB;
    bf16x8 ka[NK], kc[NK];
#pragma unroll
    for (int ks = 0; ks < NKA; ++ks) { ka[ks] = *(const LAS bf16x8*)(Ka + 32 * ks); kc[ks] = *(const LAS bf16x8*)(Ka + kaj + 32 * ks); }
#pragma unroll
    for (int ks = 0; ks < NKB; ++ks) { ka[NKA + ks] = *(const LAS bf16x8*)(Kb + 32 * ks); kc[NKA + ks] = *(const LAS bf16x8*)(Kb + kbj + 32 * ks); }
    float bv0[16], bv1[16];
    if (BIAS) {
#pragma unroll
        for (int r = 0; r < 16; ++r) { bv0[r] = tb[(r & 3) + 8 * (r >> 2)]; bv1[r] = tb[32 + (r & 3) + 8 * (r >> 2)]; }
    }
    __builtin_amdgcn_sched_barrier(0);
    f32x16 p0, p1;
#pragma unroll
    for (int r = 0; r < 16; ++r) { p0[r] = BIAS ? bv0[r] : 0.f; p1[r] = BIAS ? bv1[r] : 0.f; }
#pragma unroll
    for (int ks = 0; ks < NK; ++ks) {
        p0 = __builtin_amdgcn_mfma_f32_32x32x16_bf16(ka[ks], qf[ks], p0, 0, 0, 0);
        p1 = __builtin_amdgcn_mfma_f32_32x32x16_bf16(kc[ks], qf[ks], p1, 0, 0, 0);
    }
    s16x4 vlo0[4], vhi0[4], vlo1[4], vhi1[4];
#pragma unroll
    for (int i = 0; i < 4; ++i) { const int ro = 16 * i * VS; vlo0[i] = vtr(Vb + ro); vhi0[i] = vtr(Vb + ro + 8 * VS); vlo1[i] = vtr(Vb + 64 * VS + ro); vhi1[i] = vtr(Vb + 64 * VS + ro + 8 * VS); }
    __builtin_amdgcn_sched_barrier(0);
    float mx = p0[0];
#pragma unroll
    for (int r = 1; r < 16; ++r) mx = fmaxf(mx, p0[r]);
#pragma unroll
    for (int r = 0; r < 16; ++r) mx = fmaxf(mx, p1[r]);
    mx = fmaxf(mx, __shfl_xor(mx, 32));
    const float mn = fmaxf(m, mx); const float f = __builtin_amdgcn_exp2f(m - mn); m = mn;
    const f32x2_t mn2 = {mn, mn}; f32x2_t rs2 = {0.f, 0.f};
#pragma unroll
    for (int r = 0; r < 16; r += 2) {
        f32x2_t a = {p0[r], p0[r + 1]}, b = {p1[r], p1[r + 1]}; a = a - mn2; b = b - mn2;
        a.x = __builtin_amdgcn_exp2f(a.x); a.y = __builtin_amdgcn_exp2f(a.y); b.x = __builtin_amdgcn_exp2f(b.x); b.y = __builtin_amdgcn_exp2f(b.y);
        p0[r] = a.x; p0[r + 1] = a.y; p1[r] = b.x; p1[r + 1] = b.y; rs2 = rs2 + (a + b);
    }
    const float rs = rs2.x + rs2.y;
    l = l * f + rs;
#pragma unroll
    for (int r = 0; r < 16; ++r) { o0[r] *= f; o1[r] *= f; }
#pragma unroll
    for (int i = 0; i < 4; ++i) {
        const f32x16& pp = (i >> 1) ? p1 : p0; const int s = i & 1;
        u32x4 pw; pw.x = cvtpk(pp[8 * s + 0], pp[8 * s + 1]); pw.y = cvtpk(pp[8 * s + 2], pp[8 * s + 3]); pw.z = cvtpk(pp[8 * s + 4], pp[8 * s + 5]); pw.w = cvtpk(pp[8 * s + 6], pp[8 * s + 7]);
        const bf16x8 bfrag = __builtin_bit_cast(bf16x8, pw);
        const bf16x8 a0 = (bf16x8){vlo0[i][0], vlo0[i][1], vlo0[i][2], vlo0[i][3], vhi0[i][0], vhi0[i][1], vhi0[i][2], vhi0[i][3]};
        const bf16x8 a1 = (bf16x8){vlo1[i][0], vlo1[i][1], vlo1[i][2], vlo1[i][3], vhi1[i][0], vhi1[i][1], vhi1[i][2], vhi1[i][3]};
        o0 = __builtin_amdgcn_mfma_f32_32x32x16_bf16(a0, bfrag, o0, 0, 0, 0);
        o1 = __builtin_amdgcn_mfma_f32_32x32x16_bf16(a1, bfrag, o1, 0, 0, 0);
    }
}

struct Tiles {
    int nt, n0;
    const bf16 *k0, *v0, *pe0; int kp0, vp0;
    const bf16 *k1, *v1, *pe1; int kp1, vp1;
};
struct WaveCfg {
    const bf16* q; int qpitch;
    bf16* o; int opitch;
    int active, tlo, thi;
    int tab_off;
    int rel0;
    int qrow0;
    float m0; int has_sink;
};

template <int DQK, bool BIAS>
__device__ __forceinline__ void unit(LAS unsigned char* lds, const Tiles& TL, const WaveCfg& W, int tid) {
    constexpr int KS = DQK * 2 + 16, NKS = DQK / 16;
    const int lane = tid & 63, r32 = lane & 31, h = lane >> 5;
    const int srow = tid >> 3, sch = tid & 7;
    v4u kregA, vregA, peregA, kregB, vregB, peregB;
#define ATT_ISSUE(j_, KR, VR, PR) do { const int j__ = (j_); const bool s0 = j__ < TL.n0; const int jj = s0 ? j__ : j__ - TL.n0; \
        const bf16* kb_ = s0 ? TL.k0 : TL.k1; const bf16* vb_ = s0 ? TL.v0 : TL.v1; const int kp = s0 ? TL.kp0 : TL.kp1, vp = s0 ? TL.vp0 : TL.vp1; \
        KR = *(const GAS v4u*)(kb_ + (size_t)(64 * jj + srow) * kp + 8 * sch); VR = *(const GAS v4u*)(vb_ + (size_t)(64 * jj + srow) * vp + 8 * sch); \
        if (DQK == 96) { if (tid < 256) { const bf16* pb = s0 ? TL.pe0 : TL.pe1; PR = *(const GAS v4u*)(pb + (size_t)(64 * jj + (tid >> 2)) * 32 + 8 * (tid & 3)); } } } while (0)
#define ATT_COMMIT(buf_, KR, VR, PR) do { const int b__ = (buf_); *(LAS v4u*)(lds + L_K + b__ * L_KBUF + srow * KS + 16 * sch) = KR; \
        *(LAS v4u*)(lds + L_V + b__ * L_VBUF + (sch >> 2) * 4096 + srow * 64 + (sch & 3) * 16) = VR; \
        if (DQK == 96) { *(LAS v4u*)(lds + L_K + b__ * L_KBUF + ((tid & 255) >> 2) * KS + 128 + 16 * (tid & 3)) = PR; } } while (0)
    bf16x8 qf[NKS];
    if (W.active) {
#pragma unroll
        for (int ks = 0; ks < NKS; ++ks) qf[ks] = *(const GAS bf16x8*)(W.q + (size_t)r32 * W.qpitch + 16 * ks + 8 * h);
    } else {
#pragma unroll
        for (int ks = 0; ks < NKS; ++ks) qf[ks] = (bf16x8){0, 0, 0, 0, 0, 0, 0, 0};
    }
    float m = W.m0, l = (W.has_sink && h == 0) ? 1.0f : 0.0f;
    f32x16 o0, o1;
#pragma unroll
    for (int r = 0; r < 16; ++r) { o0[r] = 0.f; o1[r] = 0.f; }
    const int vb = ((lane >> 4) & 1) * 32 + (lane & 3) * 8 + (4 * h + ((lane & 15) >> 2)) * 64;
    const LAS float* tab = (const LAS float*)(lds + L_TAB) + W.tab_off + W.rel0 - (W.qrow0 + r32) + 4 * h;

    peregA = (v4u){0u, 0u, 0u, 0u}; peregB = peregA;
    ATT_ISSUE(0, kregA, vregA, peregA);
    if (TL.nt > 1) ATT_ISSUE(1, kregB, vregB, peregB);
    ATT_COMMIT(0, kregA, vregA, peregA); __syncthreads();
#define ATT_STEP(j_, KI, VI, PI, KC, VC, PC) do { const int j = (j_); \
        if (j + 2 < TL.nt) ATT_ISSUE(j + 2, KI, VI, PI); \
        if (W.active && j >= W.tlo && j <= W.thi) \
            tile_step<NKS, 0, BIAS>(lds + L_K + (j & 1) * L_KBUF + r32 * KS + 16 * h, 32 * KS, lds, 0, qf, tab + 64 * j, lds + L_V + (j & 1) * L_VBUF + vb, m, l, o0, o1); \
        if (j + 1 < TL.nt) ATT_COMMIT((j + 1) & 1, KC, VC, PC); \
        __syncthreads(); } while (0)
    for (int j0 = 0; j0 < TL.nt; j0 += 2) {
        ATT_STEP(j0, kregA, vregA, peregA, kregB, vregB, peregB);
        if (j0 + 1 < TL.nt) ATT_STEP(j0 + 1, kregB, vregB, peregB, kregA, vregA, peregA);
    }
#undef ATT_STEP
#undef ATT_ISSUE
#undef ATT_COMMIT
    if (W.active) {
        const float lt = l + __shfl_xor(l, 32); const float inv = 1.0f / lt;
        bf16* orow = W.o + (size_t)r32 * W.opitch;
#pragma unroll
        for (int g4 = 0; g4 < 4; ++g4) {
            u32x2 w0, w1;
            w0.x = cvtpk(o0[4 * g4] * inv, o0[4 * g4 + 1] * inv); w0.y = cvtpk(o0[4 * g4 + 2] * inv, o0[4 * g4 + 3] * inv);
            w1.x = cvtpk(o1[4 * g4] * inv, o1[4 * g4 + 1] * inv); w1.y = cvtpk(o1[4 * g4 + 2] * inv, o1[4 * g4 + 3] * inv);
            *(GAS u32x2*)(orow + 8 * g4 + 4 * h) = w0; *(GAS u32x2*)(orow + 32 + 8 * g4 + 4 * h) = w1;
        }
    }
}

template <int DQK, bool BIAS, class Src>
__device__ __forceinline__ void run(LAS unsigned char* lds, const Src& S, int tid) {
    constexpr int KS = DQK * 2 + 16, NKS = DQK / 16;
    const int lane = tid & 63, r32 = lane & 31, h = lane >> 5;
    const int srow = tid >> 3, sch = tid & 7;
    Tiles Ti; WaveCfg Wc;
    int ui = 0, ji = 0, uc = 0, jc = 0, n_issued = 0, ntc = 0;
    bool more_i, more_c;
    { WaveCfg wt_; more_i = S.get(0, Ti, wt_); } if (!more_i) return;
    { Tiles tt_; more_c = S.get(0, tt_, Wc); ntc = tt_.nt; }
    v4u kregA, vregA, peregA, kregB, vregB, peregB;
    peregA = (v4u){0u, 0u, 0u, 0u}; peregB = peregA;
#define RUN_ISSUE(KR, VR, PR) do { { const bool s0 = ji < Ti.n0; const int jj = s0 ? ji : ji - Ti.n0; \
        const bf16* kb_ = s0 ? Ti.k0 : Ti.k1; const bf16* vb_ = s0 ? Ti.v0 : Ti.v1; const int kp = s0 ? Ti.kp0 : Ti.kp1, vp = s0 ? Ti.vp0 : Ti.vp1; \
        KR = *(const GAS v4u*)(kb_ + (size_t)(64 * jj + srow) * kp + 8 * sch); VR = *(const GAS v4u*)(vb_ + (size_t)(64 * jj + srow) * vp + 8 * sch); \
        if (DQK == 96) { const bf16* pb = s0 ? Ti.pe0 : Ti.pe1; PR = *(const GAS v4u*)(pb + (size_t)(64 * jj + ((tid & 255) >> 2)) * 32 + 8 * (tid & 3)); } } \
        if (more_i) { ++n_issued; if (++ji >= Ti.nt) { ji = 0; ++ui; WaveCfg wt_; more_i = S.get(ui, Ti, wt_); } } } while (0)
#define RUN_COMMIT(buf_, KR, VR, PR) do { const int b__ = (buf_); *(LAS v4u*)(lds + L_K + b__ * L_KBUF + srow * KS + 16 * sch) = KR; \
        *(LAS v4u*)(lds + L_V + b__ * L_VBUF + (sch >> 2) * 4096 + srow * 64 + (sch & 3) * 16) = VR; \
        if (DQK == 96) { *(LAS v4u*)(lds + L_K + b__ * L_KBUF + ((tid & 255) >> 2) * KS + 128 + 16 * (tid & 3)) = PR; } } while (0)
    bf16x8 qf[NKS], qn[NKS]; float m, l; f32x16 o0, o1; const LAS float* tab;
    WaveCfg Wn; bool more_n = false; int ntn = 0;
#define RUN_QLOAD(W_, Q_) do { if ((W_).active) { _Pragma("unroll") for (int ks = 0; ks < NKS; ++ks) Q_[ks] = *(const GAS bf16x8*)((W_).q + (size_t)r32 * (W_).qpitch + 16 * ks + 8 * h); } \
        else { _Pragma("unroll") for (int ks = 0; ks < NKS; ++ks) Q_[ks] = (bf16x8){0, 0, 0, 0, 0, 0, 0, 0}; } } while (0)
#define RUN_OPEN() do { \
        m = Wc.m0; l = (Wc.has_sink && h == 0) ? 1.0f : 0.0f; _Pragma("unroll") for (int r = 0; r < 16; ++r) { o0[r] = 0.f; o1[r] = 0.f; } \
        tab = (const LAS float*)(lds + L_TAB) + Wc.tab_off + Wc.rel0 - (Wc.qrow0 + r32) + 4 * h; } while (0)
#define RUN_CLOSE() do { if (Wc.active) { const float lt = l + __shfl_xor(l, 32); const float inv = 1.0f / lt; bf16* orow = Wc.o + (size_t)r32 * Wc.opitch; \
        _Pragma("unroll") for (int g4 = 0; g4 < 4; ++g4) { u32x2 w0, w1; \
            w0.x = cvtpk(o0[4 * g4] * inv, o0[4 * g4 + 1] * inv); w0.y = cvtpk(o0[4 * g4 + 2] * inv, o0[4 * g4 + 3] * inv); \
            w1.x = cvtpk(o1[4 * g4] * inv, o1[4 * g4 + 1] * inv); w1.y = cvtpk(o1[4 * g4 + 2] * inv, o1[4 * g4 + 3] * inv); \
            *(GAS u32x2*)(orow + 8 * g4 + 4 * h) = w0; *(GAS u32x2*)(orow + 32 + 8 * g4 + 4 * h) = w1; } } } while (0)
    const int vb = ((lane >> 4) & 1) * 32 + (lane & 3) * 8 + (4 * h + ((lane & 15) >> 2)) * 64;
    RUN_ISSUE(kregA, vregA, peregA);
    RUN_ISSUE(kregB, vregB, peregB);
    RUN_COMMIT(0, kregA, vregA, peregA); __syncthreads();
    RUN_QLOAD(Wc, qf);
    RUN_OPEN();
#define RUN_STEP(s_, KI, VI, PI, KC, VC, PC) do { const int s__ = (s_); \
        if (jc == ntc - 1) { Tiles tt_; more_n = S.get(uc + 1, tt_, Wn); ntn = tt_.nt; if (more_n) RUN_QLOAD(Wn, qn); }     \
        RUN_ISSUE(KI, VI, PI); \
        if (Wc.active && jc >= Wc.tlo && jc <= Wc.thi) \
            tile_step<NKS, 0, BIAS>(lds + L_K + (s__ & 1) * L_KBUF + r32 * KS + 16 * h, 32 * KS, lds, 0, qf, tab + 64 * jc, lds + L_V + (s__ & 1) * L_VBUF + vb, m, l, o0, o1); \
        if (s__ + 1 < n_issued) RUN_COMMIT((s__ + 1) & 1, KC, VC, PC); \
        __syncthreads(); \
        if (++jc >= ntc) { RUN_CLOSE(); jc = 0; ++uc; Wc = Wn; ntc = ntn; more_c = more_n; if (more_c) { _Pragma("unroll") for (int ks = 0; ks < NKS; ++ks) qf[ks] = qn[ks]; RUN_OPEN(); } } } while (0)
    for (int s = 0; more_c; s += 2) {
        RUN_STEP(s, kregA, vregA, peregA, kregB, vregB, peregB);
        if (!more_c) break;
        RUN_STEP(s + 1, kregB, vregB, peregB, kregA, vregA, peregA);
    }
#undef RUN_STEP
#undef RUN_OPEN
#undef RUN_QLOAD
#undef RUN_CLOSE
#undef RUN_ISSUE
#undef RUN_COMMIT
}

constexpr int SD_CT = 0, SD_CTS = 272;
constexpr int SD_PE = 17408, SD_PES = 80;
constexpr int SD_K = 17408 + 2 * 5120, SD_KS = 144;
constexpr int SD_VS = 72, SD_VH = 2 * 64 * SD_VS;
constexpr int SD_V = SD_K + 4 * 64 * SD_KS;
constexpr int SD_GN = SD_V + 4 * SD_VH;
constexpr int SD_END = SD_GN + 256;
typedef float f32x4v __attribute__((ext_vector_type(4)));
__device__ __forceinline__ void sampled_unit(LAS unsigned char* lds, int b, int hg, int t0, int t1, const float* cckv, const float* cpe, const bf16* ckvs, const bf16* kpes,
                                             const bf16* wt, const float* knn, const bf16* QD, float* part, int split, int wave, int lane, int tid, int sdx = 0) {
    const int r32 = lane & 31, h = lane >> 5, l15_ = lane & 15, l4_ = lane >> 4;
    const int hp = wave >> 1, prt = wave & 1, head = hg * 4 + hp;
    bf16x8 qf[6];
    { const bf16* qp = QD + (size_t)(TP + b * 64 + 32 * (wave & 1) + r32) * 768 + head * 96;
#pragma unroll
      for (int ks = 0; ks < 6; ++ks) qf[ks] = *(const GAS bf16x8*)(qp + 16 * ks + 8 * h); }
    float m = -1e30f, l = 0.f; f32x16 o0, o1;
#pragma unroll
    for (int r = 0; r < 16; ++r) { o0[r] = 0.f; o1[r] = 0.f; }
    const int vb = ((lane >> 4) & 1) * 32 + (lane & 3) * 8 + (4 * h + ((lane & 15) >> 2)) * SD_VS;
    int srow = tid >> 3, sch = tid & 7;
    f32x4v ra, rb, rc, rd, rp;
#define SD_ISSUE(t_) do { const int tt_ = (t_); const bool c_ = tt_ < 64; \
        const GAS f32x4v* src = c_ ? (const GAS f32x4v*)(cckv + (size_t)(64 * tt_ + srow) * 128 + 16 * sch) : (const GAS f32x4v*)(ckvs + (size_t)srow * 128 + 16 * sch); \
        const GAS f32x4v* ps_ = c_ ? (const GAS f32x4v*)(cpe + (size_t)(64 * tt_ + srow) * 32 + 4 * sch) : (const GAS f32x4v*)(kpes + (size_t)srow * 32 + 4 * sch); \
        ra = src[0]; rb = src[1]; rc = src[c_ ? 2 : 0]; rd = src[c_ ? 3 : 1]; rp = *ps_; } while (0)
#define SD_COMMIT(t_, pebuf) do { v4u w0, w1; u32x2 pw; \
        if ((t_) < 64) { w0.x = cvtpk(ra.x, ra.y); w0.y = cvtpk(ra.z, ra.w); w0.z = cvtpk(rb.x, rb.y); w0.w = cvtpk(rb.z, rb.w); w1.x = cvtpk(rc.x, rc.y); w1.y = cvtpk(rc.z, rc.w); w1.z = cvtpk(rd.x, rd.y); w1.w = cvtpk(rd.z, rd.w); \
            pw.x = cvtpk(rp.x, rp.y); pw.y = cvtpk(rp.z, rp.w); } else { w0 = __builtin_bit_cast(v4u, ra); w1 = __builtin_bit_cast(v4u, rb); pw.x = __float_as_uint(rp.x); pw.y = __float_as_uint(rp.y); } \
        *(LAS v4u*)(lds + SD_CT + srow * SD_CTS + 32 * sch) = w0; *(LAS v4u*)(lds + SD_CT + srow * SD_CTS + 32 * sch + 16) = w1; \
        *(LAS u32x2*)(lds + SD_PE + (pebuf) * 64 * SD_PES + srow * SD_PES + 8 * sch) = pw; } while (0)
    ra = rb = rc = rd = rp = (f32x4v){0.f, 0.f, 0.f, 0.f};
    if (tid < 64) *(LAS float*)(lds + SD_GN + 4 * tid) = knn[tid];
    SD_ISSUE(t0);
    for (int t = t0; t < t1; ++t) {
        const int pb = (t - t0) & 1;
        asm volatile("" : "+v"(srow), "+v"(sch));
        int l15w = l15_, l4w = l4_; asm volatile("" : "+v"(l15w), "+v"(l4w));
        bf16x8 wf[4][4];
#pragma unroll
        for (int db = 0; db < 4; ++db)
#pragma unroll
            for (int ks = 0; ks < 4; ++ks) wf[db][ks] = *(const GAS bf16x8*)(wt + (size_t)(head * 128 + prt * 64 + 16 * db + l15w) * 128 + 32 * ks + 8 * l4w);
        SD_COMMIT(t, pb);
        SD_ISSUE(t + 1 < t1 ? t + 1 : t);
        __syncthreads();
#pragma unroll 1
        for (int kb = 0; kb < ((sdx & 1) ? 0 : 4); ++kb) {
            int l15 = l15_, l4 = l4_; asm volatile("" : "+v"(l15), "+v"(l4));
            f32x4v acc[4];
#pragma unroll
            for (int db = 0; db < 4; ++db) acc[db] = (f32x4v){0.f, 0.f, 0.f, 0.f};
#pragma unroll
            for (int ks = 0; ks < 4; ++ks) {
                const bf16x8 bfr = *(const LAS bf16x8*)(lds + SD_CT + (16 * kb + l15) * SD_CTS + 64 * ks + 16 * l4);
#pragma unroll
                for (int db = 0; db < 4; ++db) acc[db] = __builtin_amdgcn_mfma_f32_16x16x32_bf16(wf[db][ks], bfr, acc[db], 0, 0, 0);
            }
            const int key = 16 * kb + l15;
            if (prt == 0) {
                float ss = 0.f;
#pragma unroll
                for (int db = 0; db < 4; ++db) ss += (acc[db][0] * acc[db][0] + acc[db][1] * acc[db][1]) + (acc[db][2] * acc[db][2] + acc[db][3] * acc[db][3]);
                ss += __shfl_xor(ss, 16); ss += __shfl_xor(ss, 32);
                const float r2 = __builtin_amdgcn_rsqf(ss * (1.0f / 64.0f) + EPS);
#pragma unroll
                for (int db = 0; db < 4; ++db) { const f32x4v gn = *(const LAS f32x4v*)(lds + SD_GN + (16 * db + 4 * l4) * 4); u32x2 w; w.x = cvtpk(acc[db][0] * r2 * gn[0], acc[db][1] * r2 * gn[1]); w.y = cvtpk(acc[db][2] * r2 * gn[2], acc[db][3] * r2 * gn[3]);
                    *(LAS u32x2*)(lds + SD_K + hp * 64 * SD_KS + key * SD_KS + (16 * db + 4 * l4) * 2) = w; }
            } else {
#pragma unroll
                for (int db = 0; db < 4; ++db) { u32x2 w; w.x = cvtpk(acc[db][0], acc[db][1]); w.y = cvtpk(acc[db][2], acc[db][3]); const int dv = 16 * db + 4 * l4;
                    *(LAS u32x2*)(lds + SD_V + hp * SD_VH + (dv >> 5) * 64 * SD_VS + key * SD_VS + (dv & 31) * 2) = w; }
            }
        }
        __syncthreads();
        if (!(sdx & 2)) tile_step<4, 2, false, SD_VS>(lds + SD_K + hp * 64 * SD_KS + r32 * SD_KS + 16 * h, 32 * SD_KS, lds + SD_PE + pb * 64 * SD_PES + r32 * SD_PES + 16 * h, 32 * SD_PES, qf, nullptr, lds + SD_V + hp * SD_VH + vb, m, l, o0, o1);
    }
    __syncthreads();
#undef SD_ISSUE
#undef SD_COMMIT
    if (sdx & 8) return;
    float* P = part + ((size_t)((b * 8 + head) * NSPLIT + split)) * (64 * 66);
    const int q = 32 * (wave & 1) + r32;
#pragma unroll
    for (int g4 = 0; g4 < 4; ++g4) {
        *(GAS f32x4v*)(P + (((wave & 1) * 8 + g4) * 64 + lane) * 4) = (f32x4v){o0[4 * g4], o0[4 * g4 + 1], o0[4 * g4 + 2], o0[4 * g4 + 3]};
        *(GAS f32x4v*)(P + (((wave & 1) * 8 + 4 + g4) * 64 + lane) * 4) = (f32x4v){o1[4 * g4], o1[4 * g4 + 1], o1[4 * g4 + 2], o1[4 * g4 + 3]};
    }
    const float lt = l + __shfl_xor(l, 32);
    if (h == 0) { P[4096 + q] = m; P[4160 + q] = lt; }
}
}

constexpr int NU_BP = NB * 8 * 8, NU_BS = NB * 8, NU_AP = NB * 32 * 2, NU_AS = NB * 2, NU_L0 = NU_BP + NU_BS + NU_AP + NU_AS;
__device__ __forceinline__ int att0_unit(int c, int slot) {
    if (slot == 0 || (slot == 1 && c < 128)) { const int i = slot == 0 ? c : 256 + c; const int b = i / 48, r = i - 48 * b; return b * 64 + (r / 6) * 8 + 2 + (r % 6); }
    if (slot == 1) { if (c < 192) return NU_BP + (c - 128); const int j = c - 192; return (j >> 3) * 64 + (j & 7) * 8 + 1; }
    int a;
    if (slot == 2) { if (c >= 192) { const int j = c - 192; return (j >> 3) * 64 + (j & 7) * 8; } a = c >= 128 ? c - 128 : 64 + c; }
    else if (slot == 3) { if (c < 128) return -1; a = 192 + (c - 128); }
    else { if (c >= 208) return -1; a = 320 + c; }
    return NU_BP + NU_BS + a;
}
struct SrcL0 {
    const bf16 *QKV, *cak, *cav, *cbk, *cbv; bf16* MIX; const LAS float* sinks; int c, G, w; int cls;
    __device__ __forceinline__ int unit_of(int it) const {
        if (G == 256) { const int nu = (c < 128 || c >= 208) ? 4 : 5; if (it >= nu) return -1; return att0_unit(c, (c < 128 && it >= 3) ? it + 1 : it); }
        const int ui = c + it * G; return ui >= NU_L0 ? -1 : ui; }
    __device__ __forceinline__ bool get(int it, att::Tiles& TL, att::WaveCfg& W) const {
        const int ui = unit_of(it);
        if (ui < 0) return false;
        TL.pe0 = nullptr; TL.pe1 = nullptr; TL.k1 = nullptr; TL.v1 = nullptr; TL.kp1 = 0; TL.vp1 = 0;
        W.qpitch = EV_IN; W.opitch = DM; W.tab_off = 0; W.has_sink = 0; W.m0 = -1e30f; W.active = 1; W.qrow0 = 32 * (w & 1);
        if (ui < NU_BP + NU_BS) {
            int b, h;
            if (ui < NU_BP) {
                b = ui >> 6; h = (ui >> 3) & 7; const int cg = ui & 7; const int cw = 4 * cg + (w >> 1); const int c0 = (4 * cg - 8) > 0 ? (4 * cg - 8) : 0;
                TL.nt = 4 * cg + 4 - c0; TL.n0 = TL.nt;
                const size_t r0 = (size_t)b * SEQ + (size_t)c0 * 64;
                TL.k0 = QKV + r0 * EV_IN + 1280 + h * 64; TL.v0 = QKV + r0 * EV_IN + 1792 + h * 64; TL.kp0 = EV_IN; TL.vp0 = EV_IN;
                const size_t qr = (size_t)b * SEQ + (size_t)cw * 64 + 32 * (w & 1);
                W.q = QKV + qr * EV_IN + 768 + h * 64; W.o = MIX + qr * DM + 512 + h * 64;
                const int lo = (cw - 8) > 0 ? (cw - 8) : 0; W.tlo = lo - c0; W.thi = cw - c0; W.rel0 = (c0 - cw) * 64 + 575;
            } else {
                const int u2 = ui - NU_BP; b = u2 >> 3; h = u2 & 7;
                TL.nt = 9; TL.n0 = 8;
                TL.k0 = cbk + (size_t)b * 512 * 512 + h * 64; TL.v0 = cbv + (size_t)b * 512 * 512 + h * 64; TL.kp0 = 512; TL.vp0 = 512;
                const size_t r1 = (size_t)TP + (size_t)b * 64;
                TL.k1 = QKV + r1 * EV_IN + 1280 + h * 64; TL.v1 = QKV + r1 * EV_IN + 1792 + h * 64; TL.kp1 = EV_IN; TL.vp1 = EV_IN;
                W.active = w < 2; const size_t qr = r1 + 32 * (w & 1);
                W.q = QKV + qr * EV_IN + 768 + h * 64; W.o = MIX + qr * DM + 512 + h * 64;
                W.tlo = 0; W.thi = 8; W.rel0 = -8 * 64 + 575;
            }
            W.tab_off = 2048 + h * 640;
        } else {
            int b, kvh; const int g = w >> 1;
            if (ui < NU_BP + NU_BS + NU_AP) {
                const int u2 = ui - NU_BP - NU_BS; b = u2 >> 6; const int c_ = (u2 >> 1) & 31; kvh = u2 & 1; const int c0 = (c_ - 2) > 0 ? (c_ - 2) : 0;
                TL.nt = c_ - c0 + 1; TL.n0 = TL.nt;
                const size_t r0 = (size_t)b * SEQ + (size_t)c0 * 64;
                TL.k0 = QKV + r0 * EV_IN + 512 + kvh * 64; TL.v0 = QKV + r0 * EV_IN + 640 + kvh * 64; TL.kp0 = EV_IN; TL.vp0 = EV_IN;
                const size_t qr = (size_t)b * SEQ + (size_t)c_ * 64 + 32 * (w & 1);
                W.q = QKV + qr * EV_IN + (kvh * 4 + g) * 64; W.o = MIX + qr * DM + (kvh * 4 + g) * 64;
                W.tlo = 0; W.thi = TL.nt - 1; W.rel0 = (c0 - c_) * 64 + 191;
            } else {
                const int u2 = ui - NU_BP - NU_BS - NU_AP; b = u2 >> 1; kvh = u2 & 1;
                TL.nt = 3; TL.n0 = 2;
                TL.k0 = cak + (size_t)b * 128 * 128 + kvh * 64; TL.v0 = cav + (size_t)b * 128 * 128 + kvh * 64; TL.kp0 = 128; TL.vp0 = 128;
                const size_t r1 = (size_t)TP + (size_t)b * 64;
                TL.k1 = QKV + r1 * EV_IN + 512 + kvh * 64; TL.v1 = QKV + r1 * EV_IN + 640 + kvh * 64; TL.kp1 = EV_IN; TL.vp1 = EV_IN;
                const size_t qr = r1 + 32 * (w & 1);
                W.q = QKV + qr * EV_IN + (kvh * 4 + g) * 64; W.o = MIX + qr * DM + (kvh * 4 + g) * 64;
                W.tlo = 0; W.thi = 2; W.rel0 = -2 * 64 + 191;
            }
            W.tab_off = (kvh * 4 + g) * 256; W.has_sink = 1; W.m0 = sinks[kvh * 4 + g];
        }
        return true;
    }
};
__device__ __forceinline__ void attn_phase_l0(Frame& F, int att0_rep = 0) {
    LOCAL_IDS();
    const float* biasA = WSP(float, WS_TAB + TAB_BIASA); const float* biasB = WSP(float, WS_TAB + TAB_BIASB);
    LAS float* tab = (LAS float*)(F.lds + att::L_TAB);
    for (int i = tid; i < 2048; i += 512) tab[i] = biasA[i];
    for (int i = tid; i < 5120; i += 512) tab[2048 + i] = biasB[i];
    if (tid < 8) tab[7168 + tid] = F.in[21][tid] * LOG2E;
    __syncthreads();
    int c_ = (int)blockIdx.x, w_ = wave; asm volatile("" : "+s"(c_), "+s"(w_));
    SrcL0 S{WSP(bf16, WS_R + R_QKV), WSP(bf16, WS_R + R_CAK), WSP(bf16, WS_R + R_CAV), WSP(bf16, WS_R + R_CBK), WSP(bf16, WS_R + R_CBV), WSP(bf16, WS_R + R_MIX), (const LAS float*)tab + 7168, c_, F.G, w_, 15};
#if defined(ATT0_CLS)
    if (att0_rep) S.cls = ATT0_CLS;
#endif
    att::run<64, true, SrcL0>(F.lds, S, tid);
}

struct SrcL1 {
    const bf16 *QD, *KD, *VD, *KPE; bf16* MIX; int c, G, w;
    __device__ __forceinline__ bool get(int it, att::Tiles& TL, att::WaveCfg& W) const {
        const int upc = it >> 1, ui = c + upc * G; if (ui >= 256) return false;
        const int b = ui >> 5, h = (ui >> 2) & 7, p = ui & 3;
        const int cg = (it & 1) ? 7 - p : p; const int cw = 4 * cg + (w >> 1);
        TL.nt = 4 * cg + 4; TL.n0 = TL.nt; TL.k1 = nullptr; TL.v1 = nullptr; TL.pe1 = nullptr; TL.kp1 = 0; TL.vp1 = 0;
        const size_t r0 = (size_t)b * SEQ;
        TL.k0 = KD + r0 * 512 + h * 64; TL.v0 = VD + r0 * 512 + h * 64; TL.pe0 = KPE + r0 * 32; TL.kp0 = 512; TL.vp0 = 512;
        const size_t qr = r0 + (size_t)cw * 64 + 32 * (w & 1);
        W.q = QD + qr * 768 + h * 96; W.qpitch = 768; W.o = MIX + qr * DM + 512 + h * 64; W.opitch = DM;
        W.active = 1; W.tlo = 0; W.thi = cw; W.tab_off = 0; W.rel0 = 0; W.qrow0 = 0; W.m0 = -1e30f; W.has_sink = 0;
        return true;
    }
};
__device__ __forceinline__ void attn_phase_l1(Frame& F) {
    const bf16* QD = WSP(bf16, WS_R + R_QD); const bf16* KD = WSP(bf16, WS_R + R_KD); const bf16* VD = WSP(bf16, WS_R + R_VD); const bf16* KPE = WSP(bf16, WS_R + R_KPE);
    bf16* MIX = WSP(bf16, WS_R + R_MIX);
    LOCAL_IDS(); const int w = wave;
#if defined(REP_DP)
    for (int rep_ = 0; rep_ < REP_DP; ++rep_)
#endif
    { int c_ = (int)blockIdx.x, w_ = w; asm volatile("" : "+s"(c_), "+s"(w_));
      SrcL1 S{QD, KD, VD, KPE, MIX, c_, F.G, w_}; att::run<96, false, SrcL1>(F.lds, S, tid); }
#if defined(REP_SD)
    for (int rep_ = 0; rep_ < REP_SD; ++rep_)
#endif
    for (int ui = (int)blockIdx.x; ui < NB * 2 * NSPLIT; ui += F.G) {
        const int b = ui >> 5, hg = (ui >> 4) & 1, sp = ui & 15;
        att::sampled_unit(F.lds, b, hg, (sp * 65) >> 4, ((sp + 1) * 65) >> 4, F.in[7] + (size_t)b * PAST * 128, F.in[8] + (size_t)b * PAST * 32, WSP(bf16, WS_R + R_CKVS) + (size_t)b * 64 * 128,
#if defined(REP_SD) && defined(SDX)
                          KPE + (size_t)(TP + b * 64) * 32, WSP(bf16, WS_W + W_KVP), F.in[34], QD, rep_ == 0 ? WSP(float, WS_R + R_QA) : WSP(float, WS_R + R_PART), sp, wave, lane, tid, rep_ == 0 ? SDX : 0);
#else
                          KPE + (size_t)(TP + b * 64) * 32, WSP(bf16, WS_W + W_KVP), F.in[34], QD, WSP(float, WS_R + R_PART), sp, wave, lane, tid);
#endif
    }
}

__device__ __forceinline__ void combine_l1(Frame& F) {
    LOCAL_IDS();
    const int gw = (int)blockIdx.x * NWAVES + wave, NGW = F.G * NWAVES;
    const float* part = WSP(float, WS_R + R_PART); bf16* MIX = WSP(bf16, WS_R + R_MIX);
    for (int it = gw; it < NB * 8 * 64; it += NGW) {
        const int q = it & 63, bh = it >> 6, b = bh >> 3, head = bh & 7;
        const float* P = part + (size_t)bh * NSPLIT * (64 * 66);
        float ms[NSPLIT]; float M = -3e38f;
#pragma unroll
        for (int s = 0; s < NSPLIT; ++s) { ms[s] = P[(size_t)s * (64 * 66) + 4096 + q]; M = fmaxf(M, ms[s]); }
        float L = 0.f, O = 0.f;
#pragma unroll
        for (int s = 0; s < NSPLIT; ++s) { const float f = __builtin_amdgcn_exp2f(ms[s] - M); L += P[(size_t)s * (64 * 66) + 4160 + q] * f; O += P[(size_t)s * (64 * 66) + ((((q >> 5) * 8 + (lane >> 5) * 4 + ((lane >> 3) & 3)) * 64 + ((lane >> 2) & 1) * 32 + (q & 31)) * 4) + (lane & 3)] * f; }
        MIX[(size_t)(TP + b * 64 + q) * DM + 512 + head * 64 + lane] = (bf16)f2bf(O / L);
    }
}

__device__ __forceinline__ void side_l1(Frame& F) {
    LOCAL_IDS();
    const int gw = (int)blockIdx.x * NWAVES + wave, NGW = F.G * NWAVES;
    const bf16* KVA = WSP(bf16, WS_R + R_KVA); const float* rs = WSP(float, WS_ROWSQ + 7 * ROWSQ_STRIDE); const float* g = F.in[30];
    bf16* CKVS = WSP(bf16, WS_R + R_CKVS);
    const float g0_ = g[2 * lane], g1_ = g[2 * lane + 1];
    for (int c = gw; c < T / 8; c += NGW) {
        const int r0 = 8 * c;
        float rr[8]; unsigned pk[8];
#pragma unroll
        for (int i = 0; i < 8; ++i) { rr[i] = rs[r0 + i]; pk[i] = *(const GAS unsigned*)(KVA + (size_t)(r0 + i) * 256 + 2 * lane); }
#pragma unroll
        for (int i = 0; i < 8; ++i) {
            const int row = r0 + i;
            const float r = __builtin_amdgcn_rsqf(rr[i] * (1.0f / 128.0f) + EPS);
            const float a = __uint_as_float(pk[i] << 16) * r * g0_, b = __uint_as_float(pk[i] & 0xffff0000u) * r * g1_;
            float* dst = row < TP ? F.out + O_CKVP + (size_t)row * 128 : F.out + O_CKVS + (size_t)(row - TP) * 128;
            *(GAS f32x2v*)(dst + 2 * lane) = (f32x2v){a, b};
            if (row >= TP) *(GAS unsigned*)(CKVS + (size_t)(row - TP) * 128 + 2 * lane) = pk2(a, b);
        }
    }
    const bf16* U = WSP(bf16, WS_R + R_U); bf16* MIX = WSP(bf16, WS_R + R_MIX); const float* cw = F.in[27]; const float* st = F.in[6];
    float w0[8], w1[8], w2[8];
#pragma unroll
    for (int j = 0; j < 8; ++j) { w0[j] = cw[8 * lane + j]; w1[j] = cw[512 + 8 * lane + j]; w2[j] = cw[1024 + 8 * lane + j]; }
    for (int c = gw; c < T / 8; c += NGW) {
        const int r0 = 8 * c;
        int t0, b; const bool samp = r0 >= TP; if (!samp) { b = r0 >> 11; t0 = r0 & (SEQ - 1); } else { b = (r0 - TP) >> 6; t0 = (r0 - TP) & 63; }
        v4u ux[10], cbx[8];
#pragma unroll
        for (int i = 0; i < 8; ++i) { ux[2 + i] = *(const GAS v4u*)(U + (size_t)(r0 + i) * 512 + 8 * lane); cbx[i] = *(const GAS v4u*)(MIX + (size_t)(r0 + i) * DM + 8 * lane); }
        float h0[8], h1[8];
        if (t0 > 0) {
            ux[0] = *(const GAS v4u*)(U + (size_t)(r0 - 2) * 512 + 8 * lane); ux[1] = *(const GAS v4u*)(U + (size_t)(r0 - 1) * 512 + 8 * lane);
#pragma unroll
            for (int j = 0; j < 4; ++j) { h0[2 * j] = __uint_as_float(ux[0][j] << 16); h0[2 * j + 1] = __uint_as_float(ux[0][j] & 0xffff0000u); h1[2 * j] = __uint_as_float(ux[1][j] << 16); h1[2 * j + 1] = __uint_as_float(ux[1][j] & 0xffff0000u); }
        } else {
#pragma unroll
            for (int j = 0; j < 8; ++j) { h0[j] = samp ? st[(size_t)(b * 2 + 0) * 512 + 8 * lane + j] : 0.f; h1[j] = samp ? st[(size_t)(b * 2 + 1) * 512 + 8 * lane + j] : 0.f; }
        }
#pragma unroll
        for (int i = 0; i < 8; ++i) {
            float u2[8], cb[8];
#pragma unroll
            for (int j = 0; j < 4; ++j) { u2[2 * j] = __uint_as_float(ux[2 + i][j] << 16); u2[2 * j + 1] = __uint_as_float(ux[2 + i][j] & 0xffff0000u);
                                          cb[2 * j] = __uint_as_float(cbx[i][j] << 16); cb[2 * j + 1] = __uint_as_float(cbx[i][j] & 0xffff0000u); }
            v4u o;
#pragma unroll
            for (int j = 0; j < 4; ++j) { const float y0 = cb[2 * j] * (w0[2 * j] * h0[2 * j] + w1[2 * j] * h1[2 * j] + w2[2 * j] * u2[2 * j]);
                const float y1 = cb[2 * j + 1] * (w0[2 * j + 1] * h0[2 * j + 1] + w1[2 * j + 1] * h1[2 * j + 1] + w2[2 * j + 1] * u2[2 * j + 1]); o[j] = pk2(y0, y1); }
            *(GAS v4u*)(MIX + (size_t)(r0 + i) * DM + 8 * lane) = o;
#pragma unroll
            for (int j = 0; j < 8; ++j) { h0[j] = h1[j]; h1[j] = u2[j]; }
        }
    }
}


__device__ __forceinline__ void mini_resid(Frame& F, const bf16* A, const bf16* Bt, int K, float alpha, bool first, bool last, int rsi) {
    LOCAL_IDS();
    typedef float f32x16 __attribute__((ext_vector_type(16)));
    const int r32 = lane & 31, h = lane >> 5;
    float* const X = F.out; bf16* const XB = WSP(bf16, WS_XB); float* const rowsq = WSP(float, WS_ROWSQ + (size_t)rsi * ROWSQ_STRIDE);
    (void)first;
    LAS float* red = (LAS float*)(F.lds + RING_OFF);
    for (int mt = (int)blockIdx.x; mt < 256; mt += F.G) {
        const int rt = mt >> 4, ct = mt & 15;
        LAS unsigned char* const sA = F.lds + RING_OFF + wave * 13824; LAS unsigned char* const sB = sA + 32 * 144;
        const int crow = lane >> 3, cseg = lane & 7;
        const bf16* ag = A + (size_t)(32 * rt + crow) * K + 8 * cseg;
        const bf16* bg = Bt + (size_t)(64 * ct + crow) * K + 8 * cseg;
        const int ng = K >> 6, g0 = (ng * wave) >> 3, g1 = (ng * (wave + 1)) >> 3;
        f32x16 c0, c1;
#pragma unroll
        for (int r = 0; r < 16; ++r) { c0[r] = 0.f; c1[r] = 0.f; }
        v4u ra[4], rb[8];
#define MINI_LOAD(g_) do { _Pragma("unroll") for (int i = 0; i < 4; ++i) ra[i] = *(const GAS v4u*)(ag + (size_t)(8 * i) * K + 64 * (g_)); \
                           _Pragma("unroll") for (int i = 0; i < 8; ++i) rb[i] = *(const GAS v4u*)(bg + (size_t)(8 * i) * K + 64 * (g_)); } while (0)
#if defined(REP_MINI)
        for (int rep_ = 0; rep_ < REP_MINI; ++rep_) {
        if (rep_ > 0) { asm volatile("" : "+v"(c0), "+v"(c1));
#pragma unroll
            for (int r = 0; r < 16; ++r) { c0[r] = 0.f; c1[r] = 0.f; } }
#endif
        if (g0 < g1) MINI_LOAD(g0);
        for (int g = g0; g < g1; ++g) {
#pragma unroll
            for (int i = 0; i < 4; ++i) *(LAS v4u*)(sA + (crow + 8 * i) * 144 + 16 * cseg) = ra[i];
#pragma unroll
            for (int i = 0; i < 8; ++i) *(LAS v4u*)(sB + (crow + 8 * i) * 144 + 16 * cseg) = rb[i];
            if (g + 1 < g1) MINI_LOAD(g + 1);
            bf16x8 a[4], x[4], y[4];
#pragma unroll
            for (int ks = 0; ks < 4; ++ks) { a[ks] = *(const LAS bf16x8*)(sA + r32 * 144 + 32 * ks + 16 * h); x[ks] = *(const LAS bf16x8*)(sB + r32 * 144 + 32 * ks + 16 * h); y[ks] = *(const LAS bf16x8*)(sB + (32 + r32) * 144 + 32 * ks + 16 * h); }
#pragma unroll
            for (int ks = 0; ks < 4; ++ks) { c0 = __builtin_amdgcn_mfma_f32_32x32x16_bf16(a[ks], x[ks], c0, 0, 0, 0); c1 = __builtin_amdgcn_mfma_f32_32x32x16_bf16(a[ks], y[ks], c1, 0, 0, 0); }
        }
#if defined(REP_MINI)
        }
#endif
#undef MINI_LOAD
        __syncthreads();
#pragma unroll
        for (int r = 0; r < 16; ++r) { const int i = (r & 3) + 8 * (r >> 2) + 4 * h; red[wave * 2048 + i * 64 + r32] = c0[r]; red[wave * 2048 + i * 64 + 32 + r32] = c1[r]; }
        __syncthreads();
        {
            const int i = tid >> 4, j4 = 4 * (tid & 15);
            f32x4 v = (f32x4){0.f, 0.f, 0.f, 0.f};
#pragma unroll
            for (int w = 0; w < 8; ++w) v += *(const LAS f32x4*)(red + w * 2048 + i * 64 + j4);
            const int a8 = (j4 & 31) >> 2; const int col = 64 * ct + (j4 & 32) + 8 * (a8 & 3) + 4 * (a8 >> 2);
            const int srow = 32 * rt + i; const size_t row = (size_t)TP + srow;
            const u32x2t xo2 = *(const GAS u32x2t*)(XB + row * DM + col);
            const f32x4 xo = (f32x4){__uint_as_float(xo2.x << 16), __uint_as_float(xo2.x & 0xffff0000u), __uint_as_float(xo2.y << 16), __uint_as_float(xo2.y & 0xffff0000u)};
            const f32x4 xn = xo + v * alpha;
            if (last) *(GAS f32x4*)(X + row * DM + col) = xn;
            else {
                *(GAS u32x2t*)(XB + row * DM + col) = (u32x2t){pk2(xn.x, xn.y), pk2(xn.z, xn.w)};
                float ss = (xn.x * xn.x + xn.y * xn.y) + (xn.z * xn.z + xn.w * xn.w);
                ss += __shfl_xor(ss, 1); ss += __shfl_xor(ss, 2); ss += __shfl_xor(ss, 4); ss += __shfl_xor(ss, 8);
                if ((tid & 15) == 0) atomicAdd(rowsq + row, ss);
            }
        }
        __syncthreads();
    }
}

struct Args { const float* in[36]; float* out; unsigned char* ws; int ph_lo, ph_hi; };
constexpr int NPHASE = 17;
__global__ void __launch_bounds__(NWAVES * 64, 2) enc_fwd(Args args) {
    extern __shared__ __attribute__((aligned(16))) unsigned char lds[];
    Frame F;
    F.lds = (LAS unsigned char*)lds;
    F.MISC = (volatile LAS unsigned*)(F.lds + MISC_OFF);
    F.wave_s = __builtin_amdgcn_readfirstlane((int)threadIdx.x >> 6);
    F.G = gridDim.x; { const int bx = blockIdx.x; F.vcu = (F.G % 8 == 0) ? (bx % 8) * (F.G / 8) + bx / 8 : bx; }
    F.in = args.in; F.out = args.out; F.ws = args.ws; F.ctl = (gu32*)(args.ws + WS_CTL);
    for (int u = threadIdx.x; u < (LDS_BYTES - LDSCTL_OFF) / 4; u += NWAVES * 64) ((LAS unsigned*)(F.lds + LDSCTL_OFF))[u] = 0u;
    __syncthreads();
    const int lo = args.ph_lo, hi = args.ph_hi;
    const bool use_bar = (hi - lo) > 1;
    XcdBarrier bar; bar.bar = (unsigned*)(F.ctl + CW_BAR); bar.x = 0; bar.st = nullptr;
    if (use_bar) bar = xcd_barrier_post((unsigned*)(F.ctl + CW_BAR), F.MISC + 8);
    bar.w0 = (F.wave_s == 0) ? 1u : 0u;
#if defined(REPEAT_MASK)
    int rep_done = 0;
#endif
#pragma unroll 1
    for (int ph = lo; ph < hi; ++ph) {
        int z = 0; asm volatile("" : "+s"(z));
        F.in = args.in + z; F.out = args.out + z; F.ws = args.ws + z;
        bf16* XB = WSP(bf16, WS_XB); bf16* H = WSP(bf16, WS_R + R_H); bf16* MIX = WSP(bf16, WS_R + R_MIX);
        (void)XB;
        int kind, l = 0, f = 0;
        switch (ph) {
            case 0: kind = 0; break;
            case 1: kind = 1; l = 0; f = 0; break;   case 2: kind = 2; l = 0; f = 0; break;
            case 3: kind = 3; break;                 case 4: kind = 4; break;                 case 5: kind = 5; l = 0; break;
            case 6: kind = 1; l = 0; f = 1; break;   case 7: kind = 2; l = 0; f = 1; break;
            case 8: kind = 1; l = 1; f = 0; break;   case 9: kind = 2; l = 1; f = 0; break;
            case 10: kind = 6; break;                case 11: kind = 7; break;                case 12: kind = 8; break;   case 13: kind = 9; break;   case 14: kind = 5; l = 1; break;
            case 15: kind = 1; l = 1; f = 1; break;  default: kind = 2; l = 1; f = 1; break;
        }
        if (kind == 0) { p0_prologue(F); }
        else if (kind == 1) {
            pg8::Gemm g{XB, WSP(bf16, WS_W + W_GU0 + (size_t)(l * 2 + f) * W_GU_BYTES), T, NGU, DM}; pg8::StaticOrder S; S.init(T, NGU, F.G, (int)blockIdx.x);
#if defined(REPEAT_NULL)
            if (rep_done) { ep::EpiNull E0; pg8::gemm_phase<ep::EpiNull, pg8::StaticOrder, true, true>(F.lds + RING_OFF, g, S, E0, F.wave_s); } else
#endif
            { ep::EpiGU E{ep::Ctx{F.ws, F.out, F.in}, 3 * l + 2 * f};
            pg8::gemm_phase<ep::EpiGU, pg8::StaticOrder, true, true>(F.lds + RING_OFF, g, S, E, F.wave_s); }
            if (F.G == 256) { if (ph == 1) wconv_set(F, WSET_PH1, 172, 84); else if (ph == 6) wconv_set(F, WSET_PH6, 172, 84); }
            else { if (ph == 1) wconv_set(F, WSET_PH1, 0, F.G); else if (ph == 6) wconv_set(F, WSET_PH6, 0, F.G); }
        } else if (kind == 2 || kind == 5) {
            const bool isout = kind == 5; const bool first = (!isout && l == 0 && f == 0), last = (!isout && l == 1 && f == 1);
            pg8::Gemm g; g.A = isout ? MIX : H; g.Bt = isout ? WSP(bf16, WS_W + (l ? W_ODOUT : W_EVOUT)) : WSP(bf16, WS_W + W_D0 + (size_t)(l * 2 + f) * W_D_BYTES); g.M = TP; g.N = DM; g.K = isout ? DM : FF;
            pg8::StaticOrder S; S.init(TP, DM, F.G, (int)blockIdx.x);
            int rsi = isout ? 3 * l + 2 : (f == 0 ? 3 * l + 1 : 3 * (l + 1));
#if defined(REPEAT_MASK)
            if (rep_done) rsi = 8;
#endif
            ep::EpiResid E; E.C = ep::Ctx{F.ws, F.out, F.in}; E.last = last; E.rsi = rsi; E.alpha = isout ? 1.0f : 0.5f; (void)first;
            pg8::gemm_phase<ep::EpiResid, pg8::StaticOrder, true, true>(F.lds + RING_OFF, g, S, E, F.wave_s);
            mini_resid(F, g.A + (size_t)TP * g.K, g.Bt, g.K, E.alpha, first, last, rsi);
        } else if (kind == 3) {
            pg8::Gemm g{XB, WSP(bf16, WS_W + W_EVIN), T, EV_IN, DM}; pg8::StaticOrder S; S.init(T, EV_IN, F.G, (int)blockIdx.x);
            ep::EpiEvIn E{ep::Ctx{F.ws, F.out, F.in}};
            pg8::gemm_phase<ep::EpiEvIn, pg8::StaticOrder, true, true>(F.lds + RING_OFF, g, S, E, F.wave_s);
            if (F.G == 256) { wconv_set(F, WSET_PH3, 82, 174); p0_aux(F, 82, 174); } else { wconv_set(F, WSET_PH3, 0, F.G); p0_aux(F, 0, F.G); }
#if defined(REPEAT_MASK)
        } else if (kind == 4) { attn_phase_l0(F, rep_done); }
#else
        } else if (kind == 4) { attn_phase_l0(F); }
#endif
        else if (kind == 6) {
            pg8::Gemm g{XB, WSP(bf16, WS_W + W_ODIN), T, OD_INP, DM}; pg8::StaticOrder S; S.init(T, OD_INP, F.G, (int)blockIdx.x);
            ep::EpiOdIn E{ep::Ctx{F.ws, F.out, F.in}};
            pg8::gemm_phase<ep::EpiOdIn, pg8::StaticOrder, true, true>(F.lds + RING_OFF, g, S, E, F.wave_s);
        } else if (kind == 7) {
            side_l1(F);
            { pg8::Gemm g{WSP(bf16, WS_R + R_QA), WSP(bf16, WS_W + W_QB), T, 768, 256}; pg8::StaticOrder S; S.init(T, 768, F.G, (int)blockIdx.x);
              ep::EpiQb E{ep::Ctx{F.ws, F.out, F.in}};
              pg8::gemm_phase<ep::EpiQb, pg8::StaticOrder, true, true>(F.lds + RING_OFF, g, S, E, F.wave_s); }
            { pg8::Gemm g{WSP(bf16, WS_R + R_KVA), WSP(bf16, WS_W + W_KVB), TP, 1024, 256}; pg8::StaticOrder S; S.init(TP, 1024, F.G, (int)blockIdx.x);
              ep::EpiKvb E{ep::Ctx{F.ws, F.out, F.in}};
              pg8::gemm_phase<ep::EpiKvb, pg8::StaticOrder, true, true>(F.lds + RING_OFF, g, S, E, F.wave_s); }
        } else if (kind == 8) { attn_phase_l1(F); }
        else { combine_l1(F); }
#if defined(REPEAT_MASK)
        if (((REPEAT_MASK >> ph) & 1) && !rep_done) { rep_done = 1; xcd_barrier(bar); --ph; continue; }
        rep_done = 0;
#endif
        if (ph + 1 < hi) xcd_barrier(bar);
    }
}

#ifndef MK_MULTI
#define MK_MULTI 0
#endif
extern "C" void kernel_launch(void* const* d_in, const int* in_sizes, int n_in, void* d_out, int out_size, void* d_ws, size_t ws_size, hipStream_t stream) {
    static int grid = 0;
    if (grid == 0) {
        if (n_in != 36 || (size_t)out_size != O_END || ws_size < WS_END) { fprintf(stderr, "kernel_launch: unexpected shapes: n_in %d out %d ws %zu (need %zu)\n", n_in, out_size, ws_size, (size_t)WS_END); grid = -1; return; }
        int dev = 0, cus = 0;
        if (hipGetDevice(&dev) != hipSuccess || hipDeviceGetAttribute(&cus, hipDeviceAttributeMultiprocessorCount, dev) != hipSuccess) { grid = -1; return; }
        if (hipFuncSetAttribute((const void*)enc_fwd, hipFuncAttributeMaxDynamicSharedMemorySize, LDS_BYTES) != hipSuccess) { grid = -1; return; }
        grid = cus;
    }
    if (grid < 0) return;
    if (hipMemsetAsync((char*)d_ws + WS_CTL, 0, CTL_ZERO_BYTES, stream) != hipSuccess) return;
    Args a{};
    for (int i = 0; i < 36; ++i) a.in[i] = (const float*)d_in[i];
    a.out = (float*)d_out; a.ws = (unsigned char*)d_ws;
#if MK_MULTI
    for (int p = 0; p < NPHASE; ++p) { a.ph_lo = p; a.ph_hi = p + 1; hipLaunchKernelGGL(enc_fwd, dim3(grid), dim3(NWAVES * 64), LDS_BYTES, stream, a); }
#else
    a.ph_lo = 0; a.ph_hi = NPHASE;
    { void* kargs[] = {(void*)&a};
      if (hipLaunchCooperativeKernel((const void*)enc_fwd, dim3(grid), dim3(NWAVES * 64), kargs, LDS_BYTES, stream) != hipSuccess) fprintf(stderr, "kernel_launch: cooperative launch failed (grid %d)\n", grid); }
#endif
}
```

```cpp
#include <hip/hip_runtime.h>
#include <cstdio>
#include <cstdint>
#define GAS __attribute__((address_space(1)))
#define LAS __attribute__((address_space(3)))
typedef unsigned short bf16;
typedef unsigned v4u __attribute__((ext_vector_type(4)));
typedef float f32x4 __attribute__((ext_vector_type(4)));
typedef short bf16x8 __attribute__((ext_vector_type(8)));
typedef GAS unsigned gu32;
typedef GAS unsigned long long gu64;
#define RLX_AGENT __ATOMIC_RELAXED, __HIP_MEMORY_SCOPE_AGENT
#define LDS_WAIT() asm volatile("s_waitcnt lgkmcnt(0)" ::: "memory")
#define VM_WAIT() asm volatile("s_waitcnt vmcnt(0)" ::: "memory")
__device__ __forceinline__ unsigned long long rt() { return __builtin_amdgcn_s_memrealtime(); }
__device__ __forceinline__ unsigned f2bf(float f) { unsigned u = __builtin_bit_cast(unsigned, f); return (u + 0x7fffu + ((u >> 16) & 1u)) >> 16; }
__device__ __forceinline__ unsigned pk2(float lo, float hi) { return f2bf(lo) | (f2bf(hi) << 16); }
typedef float f32x2v __attribute__((ext_vector_type(2)));
#define XB_TMO      128
#define XB_XCNT(j)  (256  + 64 * (j))
#define XB_XSUB(j)  (1280 + 64 * (j))
#define XB_XGEN(j)  (2304 + 64 * (j))
#define XB_TOP      3328
#define XB_TOPGEN   3392
#define XCD_BAR_WORDS 3456
#define XB_SPIN_CAP (1u << 18)

__device__ __forceinline__ unsigned xb_ld(unsigned* p)              { return __hip_atomic_load(p, __ATOMIC_RELAXED, __HIP_MEMORY_SCOPE_AGENT); }
__device__ __forceinline__ unsigned xb_add(unsigned* p, unsigned v) { return __hip_atomic_fetch_add(p, v, __ATOMIC_RELAXED, __HIP_MEMORY_SCOPE_AGENT); }
__device__ __forceinline__ unsigned xb_xcc_id() { return (unsigned)__builtin_amdgcn_s_getreg((3 << 11) | 20) & 0xFu; }
#define XB_SPIN(cond, bar) do { unsigned _sp = 0; while (cond) { __builtin_amdgcn_s_sleep(1); \
    if ((++_sp & 255u) == 0u) { if (xb_ld(&(bar)[XB_TMO])) break; if (_sp > XB_SPIN_CAP) { atomicAdd(&(bar)[XB_TMO], 1u); break; } } } } while (0)

struct XcdBarrier {
    unsigned* bar; unsigned x; unsigned w0;
    volatile LAS unsigned* st;
};

__device__ __forceinline__ XcdBarrier xcd_barrier_post(unsigned* bar, volatile LAS unsigned* st) {
    XcdBarrier b; b.bar = bar; b.x = xb_xcc_id(); b.st = st;
    if (threadIdx.x == 0) (void)xb_add(&bar[XB_XCNT(b.x)], 1u);
    return b;
}
__device__ __forceinline__ void xcd_barrier_complete(unsigned* bar, unsigned x, unsigned& nloc, unsigned& nx) {
    const unsigned G = gridDim.x * gridDim.y * gridDim.z;
    unsigned sum, cnt, mine, sp = 0u;
    for (;;) {
        sum = 0u; cnt = 0u; mine = 0u;
#pragma unroll
        for (unsigned j = 0; j < 16; ++j) { const unsigned c = xb_ld(&bar[XB_XCNT(j)]); sum += c; cnt += (c > 0u) ? 1u : 0u; mine = (j == x) ? c : mine; }
        if (sum == G) break;
        __builtin_amdgcn_s_sleep(1);
        if ((++sp & 255u) == 0u) { if (xb_ld(&bar[XB_TMO])) break; if (sp > XB_SPIN_CAP) { atomicAdd(&bar[XB_TMO], 1u); break; } }
    }
    nloc = mine > 0u ? mine : 1u; nx = cnt > 0u ? cnt : 1u;
}

__device__ __forceinline__ void xcd_barrier(const XcdBarrier& b) {
    asm volatile("s_waitcnt vmcnt(0)" ::: "memory");
    __syncthreads();
    if (b.w0 && __builtin_amdgcn_mbcnt_hi(~0u, __builtin_amdgcn_mbcnt_lo(~0u, 0u)) == 0u) {
        unsigned* bar = b.bar;
        __builtin_amdgcn_s_waitcnt(0);
        unsigned nloc = b.st[0], nx = b.st[1];
        if (nloc == 0u) { xcd_barrier_complete(bar, b.x, nloc, nx); b.st[0] = nloc; b.st[1] = nx; }
        const unsigned old = xb_add(&bar[XB_XSUB(b.x)], 1u);
        const unsigned gen = old / nloc;
        if (old + 1u == (gen + 1u) * nloc) {
            __builtin_amdgcn_fence(__ATOMIC_RELEASE, "agent");
            asm volatile("s_waitcnt vmcnt(0)" ::: "memory");
            const unsigned og = xb_add(&bar[XB_TOP], 1u);
            const unsigned tg = og / nx;
            if (og + 1u == (tg + 1u) * nx) xb_add(&bar[XB_TOPGEN], 1u);
            else XB_SPIN(xb_ld(&bar[XB_TOPGEN]) == tg, bar);
            __builtin_amdgcn_fence(__ATOMIC_ACQUIRE, "agent");
            xb_add(&bar[XB_XGEN(b.x)], 1u);
            asm volatile("s_waitcnt vmcnt(0)" ::: "memory");
        } else {
            XB_SPIN(xb_ld(&bar[XB_XGEN(b.x)]) == gen, bar);
            __builtin_amdgcn_fence(__ATOMIC_ACQUIRE, "agent");
            asm volatile("s_waitcnt vmcnt(0)" ::: "memory");
        }
    }
    __syncthreads();
}
namespace pg8 {
#define PG8_LAS __attribute__((address_space(3)))
typedef unsigned short bf16_t;
typedef short bf16x8 __attribute__((ext_vector_type(8)));
typedef float f32x4 __attribute__((ext_vector_type(4)));
typedef unsigned u32x4 __attribute__((ext_vector_type(4)));
constexpr int BM = 256, BK = 64, HALF = 128, HTB = HALF * BK * 2  , STAGE_BYTES = 8 * HTB, NXCD = 8, WGM = 8;

__host__ __device__ __forceinline__ int lds_byte(int r, int c) { const int st = (r >> 4) * 2 + (c >> 5), rr = r & 15, cc = c & 31, ob = rr * 64 + cc * 2; return st * 1024 + (ob ^ (((ob >> 9) & 1) << 5)); }
__host__ __device__ __forceinline__ void stage_rc(int b, int& R, int& C) { const int st = b / 1024, sb = b % 1024, swz = sb ^ (((sb >> 9) & 1) << 5); R = (st >> 1) * 16 + swz / 64; C = (st & 1) * 32 + (swz % 64) / 2; }
__host__ __device__ __forceinline__ int perm32(int rho) { const int n = rho >> 4, i = rho & 15; return 8 * (i >> 2) + 4 * n + (i & 3); }

struct Unit { int pm, pn; };
struct Gemm { const bf16_t* A; const bf16_t* Bt; int M, N, K; };

struct StaticOrder {
    int nM, nN, nwg, G, c;
    __host__ __device__ void init(int M, int N, int G_, int c_) { nM = M / BM; nN = N / BM; nwg = nM * nN; G = G_; c = c_; }
    __host__ __device__ bool next(int i, Unit& u) const {
        const long L = (long)i * G + c; if (L >= nwg) return false;
        int wgid = (int)L; { const int q = nwg / NXCD, r = nwg % NXCD, xcd = wgid % NXCD, off = wgid / NXCD; wgid = (xcd < r ? xcd * (q + 1) : r * (q + 1) + (xcd - r) * q) + off; }
        const int nig = WGM * nN, gid = wgid / nig, fm = gid * WGM, gsz = (nM - fm) < WGM ? (nM - fm) : WGM;
        u.pm = fm + ((wgid % nig) % gsz); u.pn = (wgid % nig) / gsz; return true;
    }
    __device__ __forceinline__ void a_ready(const Unit&) const {}
    __device__ __forceinline__ void done(const Unit&) const {}
};

__device__ __forceinline__ unsigned cvt_pk_bf16(float lo, float hi) { unsigned r; asm volatile("v_cvt_pk_bf16_f32 %0, %1, %2" : "=v"(r) : "v"(lo), "v"(hi)); return r; }
typedef float f32x2 __attribute__((ext_vector_type(2)));
template <class Epi, class Sched, bool ALIGN_EPI = false, bool SP2 = false>
__device__ __forceinline__ void gemm_phase(PG8_LAS unsigned char* lds, const Gemm g, const Sched& S, const Epi& E, const int wid  ) {
    int lane_; asm volatile("v_mbcnt_lo_u32_b32 %0, -1, 0\n\tv_mbcnt_hi_u32_b32 %0, -1, %0" : "=v"(lane_));
    const int lane = lane_, tid = wid * 64 + lane, wr = wid >> 2, wc = wid & 3, fr = lane & 15, fq = lane >> 4;
    int K_ = g.K; asm volatile("" : "+s"(K_));
    const int K = K_, nt = K / BK;
    unsigned voffA[2], voffB[2];
#pragma unroll
    for (int i = 0; i < 2; ++i) { int R, C; stage_rc(tid * 16 + i * 8192, R, C); const int Rb = Epi::PERM ? ((R & ~31) + perm32(R & 31)) : R;
        voffA[i] = (unsigned)(R * K + C) * 2u; voffB[i] = (unsigned)(Rb * K + C) * 2u; }
    const size_t kstep = (size_t)(BK * 2);
    const size_t hstep = (size_t)HALF * K * 2;
    const size_t tstep = 2 * hstep;
    const unsigned ldsw = (unsigned)wid * 1024u;
    const int aoff = lds_byte(wr * 64 + fr, fq * 8), boff = lds_byte(wc * 32 + fr, fq * 8);
#define PG8_SA(b, h) (((b) * 2 + (h)) * HTB)
#define PG8_SB(b, h) ((4 + (b) * 2 + (h)) * HTB)
#define PG8_STAGE(bufoff, gbase, voff) do { _Pragma("unroll") for (int _i = 0; _i < 2; ++_i) \
        __builtin_amdgcn_global_load_lds((const unsigned*)((const char*)(gbase) + (voff)[_i]), (PG8_LAS unsigned*)(lds + (bufoff) + ldsw + _i * 8192), 16, 0, 0); } while (0)
#define PG8_LDA(dst, b, h) do { _Pragma("unroll") for (int m = 0; m < 4; ++m) _Pragma("unroll") for (int k = 0; k < 2; ++k) dst[m][k] = *(const PG8_LAS bf16x8*)(lds + PG8_SA(b, h) + aoff + m * 2048 + k * 1024); } while (0)
#define PG8_LDB(dst, b, h) do { _Pragma("unroll") for (int n = 0; n < 2; ++n) _Pragma("unroll") for (int k = 0; k < 2; ++k) dst[n][k] = *(const PG8_LAS bf16x8*)(lds + PG8_SB(b, h) + boff + n * 2048 + k * 1024); } while (0)
#define PG8_MMA(ai, bj, At, Bt) do { __builtin_amdgcn_s_setprio(1); _Pragma("unroll") for (int m = 0; m < 4; ++m) _Pragma("unroll") for (int n = 0; n < 2; ++n) _Pragma("unroll") for (int k = 0; k < 2; ++k) \
        acc[ai][bj][m][n] = __builtin_amdgcn_mfma_f32_16x16x32_bf16(Bt[n][k], At[m][k], acc[ai][bj][m][n], 0, 0, 0); __builtin_amdgcn_s_setprio(0); } while (0)
#define PG8_WAIT_V(n) asm volatile("s_waitcnt vmcnt(" #n ")" ::: "memory")
#define PG8_WAIT_L(n) asm volatile("s_waitcnt lgkmcnt(" #n ")" ::: "memory")
#define PG8_BAR __builtin_amdgcn_s_barrier()
#define PG8_SCHED __builtin_amdgcn_sched_barrier(0)
    Unit cur, nxt; int ui = 0;
    if (!S.next(0, cur)) return;
    f32x4 acc[2][2][4][2];
#pragma unroll
    for (int a = 0; a < 2; ++a)
#pragma unroll
        for (int b = 0; b < 2; ++b)
#pragma unroll
            for (int m = 0; m < 4; ++m)
#pragma unroll
                for (int n = 0; n < 2; ++n) acc[a][b][m][n] = (f32x4){0.f, 0.f, 0.f, 0.f};
    bf16x8 At[4][2], B0[2][2], B1[2][2];
    float rfpre[8];
#pragma unroll
    for (int g_ = 0; g_ < 8; ++g_) rfpre[g_] = 0.f;
    const char* cA = (const char*)g.A + (size_t)cur.pm * tstep; const char* cB = (const char*)g.Bt + (size_t)cur.pn * tstep;
    S.a_ready(cur);
    if constexpr (SP2) {
        PG8_STAGE(PG8_SB(0, 0), cB, voffB); PG8_STAGE(PG8_SB(0, 1), cB + hstep, voffB); PG8_STAGE(PG8_SA(0, 0), cA, voffA); PG8_STAGE(PG8_SA(0, 1), cA + hstep, voffA);
        if (wr == 1) PG8_BAR;
        PG8_WAIT_V(2); PG8_BAR;
        PG8_STAGE(PG8_SB(1, 0), cB + kstep, voffB); PG8_STAGE(PG8_SA(1, 0), cA + kstep, voffA); PG8_STAGE(PG8_SB(1, 1), cB + hstep + kstep, voffB);
        PG8_WAIT_V(6); PG8_BAR;
    } else {
        PG8_STAGE(PG8_SB(0, 0), cB, voffB); PG8_STAGE(PG8_SA(0, 0), cA, voffA); PG8_STAGE(PG8_SB(0, 1), cB + hstep, voffB); PG8_STAGE(PG8_SA(0, 1), cA + hstep, voffA);
        if (wr == 1) PG8_BAR;
        PG8_WAIT_V(4); PG8_BAR;
        PG8_STAGE(PG8_SB(1, 0), cB + kstep, voffB); PG8_STAGE(PG8_SA(1, 0), cA + kstep, voffA); PG8_STAGE(PG8_SB(1, 1), cB + hstep + kstep, voffB);
        PG8_WAIT_V(6); PG8_BAR;
    }
    for (;;) {
        const bool has_next = S.next(ui + 1, nxt);
        const char* nA = has_next ? (const char*)g.A + (size_t)nxt.pm * tstep : cA; const char* nB = has_next ? (const char*)g.Bt + (size_t)nxt.pn * tstep : cB;
        for (int t = 0; t < nt; t += 2) {
            const bool last = (t == nt - 2);
            if (last) E.prefetch(rfpre, cur, wr);
            const char* a1 = cA + (size_t)(t + 1) * kstep;
            const char* a2 = last ? nA : cA + (size_t)(t + 2) * kstep; const char* b2 = last ? nB : cB + (size_t)(t + 2) * kstep;
            const char* a3 = a2 + kstep; const char* b3 = b2 + kstep;
            if (last && has_next) S.a_ready(nxt);
            if constexpr (SP2) {
            PG8_LDB(B0, 0, 0); PG8_LDB(B1, 0, 1); PG8_SCHED; PG8_LDA(At, 0, 0); PG8_STAGE(PG8_SA(1, 1), a1 + hstep, voffA);
            if (Epi::NPRE && last) PG8_WAIT_V(16); else PG8_WAIT_V(8);
            PG8_WAIT_L(0); PG8_BAR; PG8_MMA(0, 0, At, B0); PG8_MMA(0, 1, At, B1); PG8_BAR; PG8_SCHED;
            PG8_LDA(At, 0, 1); PG8_STAGE(PG8_SB(0, 0), b2, voffB); PG8_STAGE(PG8_SB(0, 1), b2 + hstep, voffB); PG8_STAGE(PG8_SA(0, 0), a2, voffA);
            if (Epi::NPRE && last) PG8_WAIT_V(16); else PG8_WAIT_V(8);
            PG8_WAIT_L(0); PG8_BAR; PG8_MMA(1, 0, At, B0); PG8_MMA(1, 1, At, B1); PG8_BAR; PG8_SCHED;
            PG8_LDB(B0, 1, 0); PG8_LDB(B1, 1, 1); PG8_SCHED; PG8_LDA(At, 1, 0); PG8_STAGE(PG8_SA(0, 1), a2 + hstep, voffA);
            PG8_WAIT_V(8); PG8_WAIT_L(0); PG8_BAR; PG8_MMA(0, 0, At, B0); PG8_MMA(0, 1, At, B1); PG8_BAR; PG8_SCHED;
            PG8_LDA(At, 1, 1); PG8_STAGE(PG8_SB(1, 0), b3, voffB); PG8_STAGE(PG8_SB(1, 1), b3 + hstep, voffB); PG8_STAGE(PG8_SA(1, 0), a3, voffA);
            PG8_WAIT_V(8); PG8_WAIT_L(0); PG8_BAR; PG8_MMA(1, 0, At, B0); PG8_MMA(1, 1, At, B1); PG8_BAR; PG8_SCHED;
            } else {
            PG8_LDB(B0, 0, 0); PG8_SCHED; PG8_LDA(At, 0, 0); PG8_STAGE(PG8_SA(1, 1), a1 + hstep, voffA);
            PG8_WAIT_L(8); PG8_BAR; PG8_WAIT_L(0); PG8_MMA(0, 0, At, B0); PG8_BAR; PG8_SCHED;
            PG8_LDB(B1, 0, 1); PG8_STAGE(PG8_SB(0, 0), b2, voffB);
            PG8_BAR; PG8_WAIT_L(0); PG8_MMA(0, 1, At, B1); PG8_BAR;
            PG8_LDA(At, 0, 1); PG8_STAGE(PG8_SA(0, 0), a2, voffA);
            PG8_BAR; PG8_WAIT_L(0); PG8_MMA(1, 0, At, B0); PG8_BAR; PG8_SCHED;
            PG8_STAGE(PG8_SB(0, 1), b2 + hstep, voffB);
            PG8_WAIT_V(6); PG8_BAR; PG8_MMA(1, 1, At, B1); PG8_BAR;
            PG8_LDB(B0, 1, 0); PG8_SCHED; PG8_LDA(At, 1, 0); PG8_STAGE(PG8_SA(0, 1), a2 + hstep, voffA);
            PG8_WAIT_L(8); PG8_BAR; PG8_WAIT_L(0); PG8_MMA(0, 0, At, B0); PG8_BAR; PG8_SCHED;
            PG8_LDB(B1, 1, 1); PG8_STAGE(PG8_SB(1, 0), b3, voffB);
            PG8_BAR; PG8_WAIT_L(0); PG8_MMA(0, 1, At, B1); PG8_BAR;
            PG8_LDA(At, 1, 1); PG8_STAGE(PG8_SA(1, 0), a3, voffA);
            PG8_BAR; PG8_WAIT_L(0); PG8_MMA(1, 0, At, B0); PG8_BAR; PG8_SCHED;
            PG8_STAGE(PG8_SB(1, 1), b3 + hstep, voffB);
            PG8_WAIT_V(6); PG8_BAR; PG8_MMA(1, 1, At, B1); PG8_BAR;
            }
        }
        if constexpr (ALIGN_EPI) { if (wr == 0) PG8_BAR; }
        if constexpr (!Epi::AFTER_DRAIN) { E(acc, cur, wr, wc, fr, fq, rfpre); S.done(cur); }
        if (!has_next) break;
#pragma unroll
        for (int a = 0; a < 2; ++a)
#pragma unroll
            for (int b = 0; b < 2; ++b)
#pragma unroll
                for (int m = 0; m < 4; ++m)
#pragma unroll
                    for (int n = 0; n < 2; ++n) acc[a][b][m][n] = (f32x4){0.f, 0.f, 0.f, 0.f};
        cur = nxt; cA = nA; cB = nB; ++ui;
        if constexpr (ALIGN_EPI) { if (wr == 1) PG8_BAR; }
    }
    PG8_WAIT_V(0);
    if constexpr (!ALIGN_EPI) { if (wr == 0) PG8_BAR; }
    PG8_BAR;
    if constexpr (Epi::AFTER_DRAIN) { E.fused(acc, cur, wr, wc, fr, fq, lds, wid, lane); S.done(cur); }
#undef PG8_SA
#undef PG8_SB
#undef PG8_STAGE
#undef PG8_LDA
#undef PG8_LDB
#undef PG8_MMA
#undef PG8_WAIT_V
#undef PG8_WAIT_L
#undef PG8_BAR
#undef PG8_SCHED
}
}

constexpr int DM = 1024, NB = 8, SEQ = 2048, TP = NB * SEQ, DSEQ = 64, TS = NB * DSEQ, T = TP + TS, PAST = 4096;
constexpr int FF = 2816, NGU = 2 * FF;
constexpr int EV_IN = 2304, OD_IN = 1952, OD_INP = 2048;
constexpr float EPS = 1e-6f;
constexpr float LOG2E = 1.4426950408889634f;
constexpr float QS64 = 0.125f * LOG2E;
constexpr float QS96 = 0.10206207261596575f * LOG2E;

constexpr size_t O_Y = 0;
constexpr size_t O_AKP = (size_t)T * DM;
constexpr size_t O_AVP = O_AKP + 131072;
constexpr size_t O_BKP = O_AVP + 131072;
constexpr size_t O_BVP = O_BKP + 2097152;
constexpr size_t O_CP = O_BVP + 2097152;
constexpr size_t O_CKVP = O_CP + 8192;
constexpr size_t O_KPEP = O_CKVP + 2097152;
constexpr size_t O_AKS = O_KPEP + 524288;
constexpr size_t O_AVS = O_AKS + 131072;
constexpr size_t O_BKS = O_AVS + 131072;
constexpr size_t O_BVS = O_BKS + 2097152;
constexpr size_t O_CS = O_BVS + 2097152;
constexpr size_t O_CKVS = O_CS + 8192;
constexpr size_t O_KPES = O_CKVS + 65536;
constexpr size_t O_END = O_KPES + 16384;

constexpr size_t MiB = 1u << 20;
constexpr size_t WS_CTL = 0, CTL_ZERO_BYTES = 2 * MiB;
constexpr int CW_BAR = 4096;
constexpr size_t WS_ROWSQ = 65536;
constexpr size_t ROWSQ_STRIDE = (size_t)T * 4;
constexpr size_t WS_TAB = 2 * MiB;
constexpr size_t TAB_BIASA = 0, TAB_BIASB = 8192, TAB_ROPE = 32768;
constexpr int NPOS = 2112;
constexpr size_t WS_W = 3 * MiB;
constexpr size_t W_GU_BYTES = (size_t)NGU * DM * 2, W_D_BYTES = (size_t)DM * FF * 2;
constexpr size_t W_GU0 = 0;
constexpr size_t W_D0 = 4 * W_GU_BYTES;
constexpr size_t W_EVIN = W_D0 + 4 * W_D_BYTES;
constexpr size_t W_EVOUT = W_EVIN + (size_t)EV_IN * DM * 2;
constexpr size_t W_ODIN = W_EVOUT + (size_t)DM * DM * 2;
constexpr size_t W_ODOUT = W_ODIN + (size_t)OD_INP * DM * 2;
constexpr size_t W_QB = W_ODOUT + (size_t)DM * DM * 2;
constexpr size_t W_KVB = W_QB + (size_t)768 * 256 * 2;
constexpr size_t W_KVP = W_KVB + (size_t)1024 * 256 * 2;
constexpr size_t W_END = W_KVP + (size_t)1024 * 128 * 2;
static_assert(W_END <= 80 * MiB, "weights");
constexpr size_t WS_XB = 83 * MiB;
constexpr size_t WS_R = 116 * MiB;
constexpr size_t R_H = 0;
constexpr size_t R_QKV = 0;
constexpr size_t R_CAK = 96 * MiB, R_CAV = R_CAK + 262144, R_CBK = R_CAV + 262144, R_CBV = R_CBK + 4194304;
constexpr size_t R_MIX = 105 * MiB;
constexpr size_t R_U = 0;
constexpr size_t R_QA = R_U + (size_t)T * 512 * 2;
constexpr size_t R_KVA = R_QA + (size_t)T * 256 * 2;
constexpr size_t R_KPE = R_KVA + (size_t)T * 256 * 2;
constexpr size_t R_QD = R_KPE + (size_t)T * 32 * 2;
constexpr size_t R_KD = R_QD + (size_t)T * 768 * 2;
constexpr size_t R_VD = R_KD + (size_t)TP * 512 * 2;
constexpr size_t R_CKVS = R_VD + (size_t)TP * 512 * 2;
constexpr size_t R_PART = R_U;
constexpr int NSPLIT = 16;
constexpr size_t PART_BYTES = (size_t)64 * 66 * 4;
constexpr size_t R_PART_END = R_PART + (size_t)NB * 8 * NSPLIT * PART_BYTES;
static_assert(R_CBV + 4194304 <= R_MIX && R_PART_END <= R_QA && R_CKVS + (size_t)TS * 128 * 2 <= R_MIX && (size_t)T * FF * 2 <= R_CAK, "region R map");
constexpr size_t WS_END = WS_R + R_MIX + (size_t)T * DM * 2;
static_assert(WS_END <= 256 * MiB, "workspace");

constexpr int RING_OFF = 0, RING_BYTES = 131072;
constexpr int LDSCTL_OFF = RING_BYTES, MISC_OFF = LDSCTL_OFF + 320;
constexpr int LDS_BYTES = 147456;
constexpr int NWAVES = 8;

namespace ep {
using pg8::f32x4; using pg8::u32x4; using pg8::Unit; using pg8::bf16_t;
typedef unsigned u32x2 __attribute__((ext_vector_type(2)));
__device__ __forceinline__ unsigned pkbf(float lo, float hi) { return pg8::cvt_pk_bf16(lo, hi); }
__device__ __forceinline__ u32x4 pack8(const float* v) { u32x4 w; w.x = pkbf(v[0], v[1]); w.y = pkbf(v[2], v[3]); w.z = pkbf(v[4], v[5]); w.w = pkbf(v[6], v[7]); return w; }
__device__ __forceinline__ float red_fq(float s) { s += __shfl_xor(s, 16); s += __shfl_xor(s, 32); return s; }
struct Ctx { unsigned char* ws; float* out; const float* const* in; };
#define EP_OPEN() int z_ = 0; asm volatile("" : "+s"(z_)); { int le_; asm volatile("v_mbcnt_lo_u32_b32 %0, -1, 0\n\tv_mbcnt_hi_u32_b32 %0, -1, %0" : "=v"(le_)); fr = le_ & 15; fq = le_ >> 4; }     unsigned char* const ws_ = C.ws + z_; float* const out = C.out + z_; const float* const* const in_ = C.in + z_; (void)ws_; (void)out; (void)in_
#define EPW(T_, off) ((T_*)(ws_ + (off)))
#define EP_ROWF(name, ptr, scale) float name[8]; { (void)(ptr); \
        asm volatile("s_waitcnt vmcnt(16)" : "+v"(rfpre[0]), "+v"(rfpre[1]), "+v"(rfpre[2]), "+v"(rfpre[3]), "+v"(rfpre[4]), "+v"(rfpre[5]), "+v"(rfpre[6]), "+v"(rfpre[7]));     \
        _Pragma("unroll") for (int g_ = 0; g_ < 8; ++g_) name[g_] = __builtin_amdgcn_rsqf(rfpre[g_] * (scale) + EPS); }
#define EP_PREFETCH(off_expr) static constexpr int NPRE = 8; __device__ __forceinline__ void prefetch(float (&rf)[8], const Unit& u, int wr) const { \
        int le_; asm volatile("v_mbcnt_lo_u32_b32 %0, -1, 0\n\tv_mbcnt_hi_u32_b32 %0, -1, %0" : "=v"(le_)); const int fr_ = le_ & 15; \
        unsigned char* ws_ = C.ws; asm volatile("" : "+s"(ws_)); const float* p_ = (const float*)(ws_ + (off_expr)); \
        const unsigned vo_ = (unsigned)(u.pm * 256 + wr * 64 + fr_) * 4u; \
          \
          \
        asm volatile("global_load_dword %0, %8, %9\n\tglobal_load_dword %1, %8, %9 offset:64\n\tglobal_load_dword %2, %8, %9 offset:128\n\tglobal_load_dword %3, %8, %9 offset:192\n\t" \
                     "global_load_dword %4, %8, %9 offset:512\n\tglobal_load_dword %5, %8, %9 offset:576\n\tglobal_load_dword %6, %8, %9 offset:640\n\tglobal_load_dword %7, %8, %9 offset:704" \
                     : "=&v"(rf[0]), "=&v"(rf[1]), "=&v"(rf[2]), "=&v"(rf[3]), "=&v"(rf[4]), "=&v"(rf[5]), "=&v"(rf[6]), "=&v"(rf[7]) : "v"(vo_), "s"(p_)); }
__device__ __forceinline__ int pos_index(int row) { return row < TP ? (row & (SEQ - 1)) : SEQ + ((row - TP) & (DSEQ - 1)); }

struct EpiGU {
    static constexpr bool PERM = false, AFTER_DRAIN = false;
    Ctx C; int rsi;
    EP_PREFETCH(WS_ROWSQ + (size_t)rsi * ROWSQ_STRIDE)
    __device__ __forceinline__ void operator()(const f32x4 (&acc)[2][2][4][2], const Unit& u, int wr, int wc, int fr, int fq, float (&rfpre)[8]) const {
        EP_OPEN(); bf16_t* const H = EPW(bf16_t, WS_R + R_H); const float* const rowsq = EPW(float, WS_ROWSQ + (size_t)rsi * ROWSQ_STRIDE);
        EP_ROWF(rf, rowsq, 1.0f / DM);
#pragma unroll
        for (int ai = 0; ai < 2; ++ai)
#pragma unroll
            for (int m = 0; m < 4; ++m) {
                const int row = u.pm * 256 + ai * 128 + wr * 64 + m * 16 + fr;
                const float r = rf[4 * ai + m];
                const pg8::f32x2 nr = {-LOG2E * r, -LOG2E * r}, r2 = {r * r, r * r}, one = {1.0f, 1.0f};
                pg8::f32x2 tt[4], pp[4];
#pragma unroll
                for (int q = 0; q < 4; ++q) { const pg8::f32x2 a = {acc[ai][0][m][q >> 1][2 * (q & 1)], acc[ai][0][m][q >> 1][2 * (q & 1) + 1]}, b = {acc[ai][1][m][q >> 1][2 * (q & 1)], acc[ai][1][m][q >> 1][2 * (q & 1) + 1]};
                    tt[q] = a * nr; pp[q] = (a * b) * r2; }
#pragma unroll
                for (int q = 0; q < 4; ++q) { tt[q].x = __builtin_amdgcn_exp2f(tt[q].x); tt[q].y = __builtin_amdgcn_exp2f(tt[q].y); }
#pragma unroll
                for (int q = 0; q < 4; ++q) tt[q] = tt[q] + one;
#pragma unroll
                for (int q = 0; q < 4; ++q) { tt[q].x = __builtin_amdgcn_rcpf(tt[q].x); tt[q].y = __builtin_amdgcn_rcpf(tt[q].y); }
                float hv[8];
#pragma unroll
                for (int q = 0; q < 4; ++q) { const pg8::f32x2 hq = pp[q] * tt[q]; hv[2 * q] = hq.x; hv[2 * q + 1] = hq.y; }
                *(u32x4*)(H + (size_t)row * FF + u.pn * 128 + wc * 32 + 8 * fq) = pack8(hv);
                asm volatile("" ::: "memory");
            }
    }
};

struct EpiResid {
    static constexpr bool PERM = false, AFTER_DRAIN = false;
    Ctx C; int last, rsi; float alpha;
    static constexpr int NPRE = 0; __device__ __forceinline__ void prefetch(float (&)[8], const Unit&, int) const {}
    __device__ __forceinline__ void operator()(const f32x4 (&acc)[2][2][4][2], const Unit& u, int wr, int wc, int fr, int fq, const float (&)[8]) const {
        EP_OPEN(); bf16_t* const xb = EPW(bf16_t, WS_XB); float* const rowsq = last ? nullptr : EPW(float, WS_ROWSQ + (size_t)rsi * ROWSQ_STRIDE);
        u32x4 xa[2][2];
        const int colb = u.pn * 256 + wc * 32 + 8 * fq;
#define EPR_LOAD(slot, g) do { const int row_ = u.pm * 256 + ((g) >> 2) * 128 + wr * 64 + ((g) & 3) * 16 + fr; \
            _Pragma("unroll") for (int bj = 0; bj < 2; ++bj) xa[slot][bj] = *(const u32x4*)(xb + (size_t)row_ * DM + colb + bj * 128); } while (0)
        EPR_LOAD(0, 0);
        float ssg[8];
#pragma unroll
        for (int g = 0; g < 8; ++g) {
            const int ai = g >> 2, m = g & 3, sl = g & 1;
            if (g < 7) EPR_LOAD(sl ^ 1, g + 1);
            const int row = u.pm * 256 + ai * 128 + wr * 64 + m * 16 + fr;
            pg8::f32x2 s2 = {0.f, 0.f};
#pragma unroll
            for (int bj = 0; bj < 2; ++bj) {
                const int col = colb + bj * 128; const u32x4 xo = xa[sl][bj];
                const f32x4 x0 = (f32x4){__uint_as_float(xo.x << 16), __uint_as_float(xo.x & 0xffff0000u), __uint_as_float(xo.y << 16), __uint_as_float(xo.y & 0xffff0000u)};
                const f32x4 x1 = (f32x4){__uint_as_float(xo.z << 16), __uint_as_float(xo.z & 0xffff0000u), __uint_as_float(xo.w << 16), __uint_as_float(xo.w & 0xffff0000u)};
                const f32x4 v0 = x0 + acc[ai][bj][m][0] * alpha, v1 = x1 + acc[ai][bj][m][1] * alpha;
                if (last) { *(f32x4*)(out + (size_t)row * DM + col) = v0; *(f32x4*)(out + (size_t)row * DM + col + 4) = v1; }
                else { u32x4 w; w.x = pkbf(v0[0], v0[1]); w.y = pkbf(v0[2], v0[3]); w.z = pkbf(v1[0], v1[1]); w.w = pkbf(v1[2], v1[3]); *(u32x4*)(xb + (size_t)row * DM + col) = w; }
                s2 = s2 + v0.lo * v0.lo; s2 = s2 + v0.hi * v0.hi; s2 = s2 + v1.lo * v1.lo; s2 = s2 + v1.hi * v1.hi;
            }
            ssg[g] = s2.x + s2.y;
            asm volatile("" ::: "memory");
        }
        if (rowsq) {
#pragma unroll
            for (int g = 0; g < 8; ++g) ssg[g] += __shfl_xor(ssg[g], 16);
#pragma unroll
            for (int g = 0; g < 8; ++g) ssg[g] += __shfl_xor(ssg[g], 32);
            if (fq == 0) {
#pragma unroll
                for (int g = 0; g < 8; ++g) atomicAdd(rowsq + (u.pm * 256 + (g >> 2) * 128 + wr * 64 + (g & 3) * 16 + fr), ssg[g]);
            }
        }
#undef EPR_LOAD
    }
};

struct EpiEvIn {
    static constexpr bool PERM = false, AFTER_DRAIN = false;
    Ctx C;
    EP_PREFETCH(WS_ROWSQ + 1 * ROWSQ_STRIDE)
    __device__ __forceinline__ void operator()(const f32x4 (&acc)[2][2][4][2], const Unit& u, int wr, int wc, int fr, int fq, float (&rfpre)[8]) const {
        EP_OPEN(); bf16_t* const QKV = EPW(bf16_t, WS_R + R_QKV); const float* const rowsq = EPW(float, WS_ROWSQ + 1 * ROWSQ_STRIDE);
        EP_ROWF(rf, rowsq, 1.0f / DM);
        const int hs = 4 * u.pn + wc;
        const float* gp = hs < 8 ? in_[19] : hs < 10 ? in_[20] : hs < 12 ? nullptr : hs < 20 ? in_[22] : hs < 28 ? in_[23] : nullptr;
        const float qs = (hs < 8 || (hs >= 12 && hs < 20)) ? QS64 : 1.0f;
        float gv[2][8];
#pragma unroll
        for (int bj = 0; bj < 2; ++bj)
#pragma unroll
            for (int j = 0; j < 8; ++j) gv[bj][j] = gp ? gp[32 * bj + 8 * fq + j] * qs : 1.0f;
        int kind = 0; int hh = 0;
        if (hs >= 8 && hs < 10) { kind = 1; hh = hs - 8; } else if (hs >= 10 && hs < 12) { kind = 2; hh = hs - 10; } else if (hs >= 20 && hs < 28) { kind = 3; hh = hs - 20; } else if (hs >= 28) { kind = 4; hh = hs - 28; }
#pragma unroll
        for (int ai = 0; ai < 2; ++ai)
#pragma unroll
            for (int m = 0; m < 4; ++m) {
                const int row = u.pm * 256 + ai * 128 + wr * 64 + m * 16 + fr;
                const float r = rf[4 * ai + m];
                float v[2][8]; float ss = 0.f;
#pragma unroll
                for (int bj = 0; bj < 2; ++bj)
#pragma unroll
                    for (int n = 0; n < 2; ++n)
#pragma unroll
                        for (int e = 0; e < 4; ++e) { const float x = acc[ai][bj][m][n][e] * r; v[bj][4 * n + e] = x; ss += x * x; }
                if (gp) { ss = red_fq(ss); const float r2 = __builtin_amdgcn_rsqf(ss * (1.0f / 64.0f) + EPS);
#pragma unroll
                    for (int bj = 0; bj < 2; ++bj)
#pragma unroll
                        for (int j = 0; j < 8; ++j) v[bj][j] = v[bj][j] * r2 * gv[bj][j]; }
#pragma unroll
                for (int bj = 0; bj < 2; ++bj) *(u32x4*)(QKV + (size_t)row * EV_IN + 64 * hs + 32 * bj + 8 * fq) = pack8(v[bj]);
                if (kind) {
                    float* dst = nullptr;
                    if (row < TP) { const int b = row >> 11, t = row & (SEQ - 1);
                        if (kind <= 2) { if (t >= SEQ - 128) dst = out + (kind == 1 ? O_AKP : O_AVP) + ((size_t)(b * 128 + t - (SEQ - 128)) * 2 + hh) * 64; }
                        else { if (t >= SEQ - 512) dst = out + (kind == 3 ? O_BKP : O_BVP) + ((size_t)(b * 512 + t - (SEQ - 512)) * 8 + hh) * 64; }
                    } else { const int b = (row - TP) >> 6, t = (row - TP) & 63;
                        if (kind <= 2) dst = out + (kind == 1 ? O_AKS : O_AVS) + ((size_t)(b * 128 + 64 + t) * 2 + hh) * 64;
                        else dst = out + (kind == 3 ? O_BKS : O_BVS) + ((size_t)(b * 512 + 448 + t) * 8 + hh) * 64;
                    }
                    if (dst) {
#pragma unroll
                        for (int bj = 0; bj < 2; ++bj) { float* d = dst + 32 * bj + 8 * fq;
                            *(f32x4*)d = (f32x4){v[bj][0], v[bj][1], v[bj][2], v[bj][3]}; *(f32x4*)(d + 4) = (f32x4){v[bj][4], v[bj][5], v[bj][6], v[bj][7]}; }
                    }
                }
                asm volatile("" ::: "memory");
            }
    }
};

__device__ __forceinline__ void rope8(float (&v)[8], int fq, const float* ropetab, int pidx) {
    const float* ct = ropetab + (size_t)pidx * 16 + 8 * (fq & 1); const float* st = ct + (size_t)NPOS * 16;
#pragma unroll
    for (int j = 0; j < 8; ++j) { const float other = __shfl_xor(v[j], 32); const float c = ct[j], s = st[j];
        v[j] = fq < 2 ? v[j] * c - other * s : other * s + v[j] * c; }
}

struct EpiOdIn {
    static constexpr bool PERM = false, AFTER_DRAIN = false;
    Ctx C;
    EP_PREFETCH(WS_ROWSQ + 4 * ROWSQ_STRIDE)
    __device__ __forceinline__ void operator()(const f32x4 (&acc)[2][2][4][2], const Unit& u, int wr, int wc, int fr, int fq, float (&rfpre)[8]) const {
        EP_OPEN(); bf16_t* const MIX = EPW(bf16_t, WS_R + R_MIX); bf16_t* const U = EPW(bf16_t, WS_R + R_U); bf16_t* const QA = EPW(bf16_t, WS_R + R_QA); bf16_t* const KVA = EPW(bf16_t, WS_R + R_KVA); bf16_t* const KPE = EPW(bf16_t, WS_R + R_KPE);
        const float* const rowsq = EPW(float, WS_ROWSQ + 4 * ROWSQ_STRIDE); float* const rsq_qa = EPW(float, WS_ROWSQ + 6 * ROWSQ_STRIDE); float* const rsq_kva = EPW(float, WS_ROWSQ + 7 * ROWSQ_STRIDE);
        const float* const knr = in_[35]; const float* const ropetab = EPW(float, WS_TAB + TAB_ROPE);
        const int pn = u.pn;
        EP_ROWF(rf, rowsq, 1.0f / DM);
#pragma unroll
        for (int ai = 0; ai < 2; ++ai)
#pragma unroll
            for (int m = 0; m < 4; ++m) {
                const int row = u.pm * 256 + ai * 128 + wr * 64 + m * 16 + fr;
                const float r = rf[4 * ai + m];
                float v[2][8];
#pragma unroll
                for (int bj = 0; bj < 2; ++bj)
#pragma unroll
                    for (int n = 0; n < 2; ++n)
#pragma unroll
                        for (int e = 0; e < 4; ++e) v[bj][4 * n + e] = acc[ai][bj][m][n][e] * r;
                if (pn < 2) {
#pragma unroll
                    for (int bj = 0; bj < 2; ++bj) *(u32x4*)(MIX + (size_t)row * DM + 256 * pn + 128 * bj + 32 * wc + 8 * fq) = pack8(v[bj]);
                } else if (pn < 6) {
                    float uu[8];
#pragma unroll
                    for (int j = 0; j < 8; ++j) uu[j] = v[0][j] * v[1][j];
                    const int idx = 128 * (pn - 2) + 32 * wc + 8 * fq;
                    *(u32x4*)(U + (size_t)row * 512 + idx) = pack8(uu);
                    float* dst = nullptr;
                    if (row < TP) { const int b = row >> 11, t = row & (SEQ - 1); if (t >= SEQ - 2) dst = out + O_CP + (size_t)(b * 2 + t - (SEQ - 2)) * 512 + idx; }
                    else { const int b = (row - TP) >> 6, t = (row - TP) & 63; if (t >= 62) dst = out + O_CS + (size_t)(b * 2 + t - 62) * 512 + idx; }
                    if (dst) { *(f32x4*)dst = (f32x4){uu[0], uu[1], uu[2], uu[3]}; *(f32x4*)(dst + 4) = (f32x4){uu[4], uu[5], uu[6], uu[7]}; }
                } else if (pn == 6) {
                    float ss = 0.f;
#pragma unroll
                    for (int bj = 0; bj < 2; ++bj) { *(u32x4*)(QA + (size_t)row * 256 + 128 * bj + 32 * wc + 8 * fq) = pack8(v[bj]);
#pragma unroll
                        for (int j = 0; j < 8; ++j) ss += v[bj][j] * v[bj][j]; }
                    ss = red_fq(ss); if (fq == 0) atomicAdd(rsq_qa + row, ss);
                } else {
                    float ss = 0.f;
#pragma unroll
                    for (int j = 0; j < 8; ++j) ss += v[0][j] * v[0][j];
                    *(u32x4*)(KVA + (size_t)row * 256 + 32 * wc + 8 * fq) = pack8(v[0]);
                    *(u32x4*)(KVA + (size_t)row * 256 + 128 + 32 * wc + 8 * fq) = (u32x4){0u, 0u, 0u, 0u};
                    ss = red_fq(ss); if (fq == 0) atomicAdd(rsq_kva + row, ss);
                    if (wc == 0) {
                        float s2 = 0.f;
#pragma unroll
                        for (int j = 0; j < 8; ++j) s2 += v[1][j] * v[1][j];
                        s2 = red_fq(s2); const float r2 = __builtin_amdgcn_rsqf(s2 * (1.0f / 32.0f) + EPS);
                        float k[8];
#pragma unroll
                        for (int j = 0; j < 8; ++j) k[j] = v[1][j] * r2 * knr[8 * fq + j];
                        rope8(k, fq, ropetab, pos_index(row));
                        float* dst = row < TP ? out + O_KPEP + (size_t)row * 32 + 8 * fq : out + O_KPES + (size_t)(row - TP) * 32 + 8 * fq;
                        *(f32x4*)dst = (f32x4){k[0], k[1], k[2], k[3]}; *(f32x4*)(dst + 4) = (f32x4){k[4], k[5], k[6], k[7]};
                        *(u32x4*)(KPE + (size_t)row * 32 + 8 * fq) = pack8(k);
                    }
                }
                asm volatile("" ::: "memory");
            }
    }
};

struct EpiQb {
    static constexpr bool PERM = false, AFTER_DRAIN = false;
    Ctx C;
    EP_PREFETCH(WS_ROWSQ + 6 * ROWSQ_STRIDE)
    __device__ __forceinline__ void operator()(const f32x4 (&acc)[2][2][4][2], const Unit& u, int wr, int wc, int fr, int fq, float (&rfpre)[8]) const {
        EP_OPEN(); bf16_t* const QD = EPW(bf16_t, WS_R + R_QD); const float* const rsq_qa = EPW(float, WS_ROWSQ + 6 * ROWSQ_STRIDE); const float* const qnn = in_[32]; const float* const qnr = in_[33]; const float* const ropetab = EPW(float, WS_TAB + TAB_ROPE);
        const int pn = u.pn;
        EP_ROWF(rf, rsq_qa, 1.0f / 256.0f);
        float gv[2][8];
#pragma unroll
        for (int bj = 0; bj < 2; ++bj)
#pragma unroll
            for (int j = 0; j < 8; ++j) gv[bj][j] = (pn < 2 ? qnn[32 * bj + 8 * fq + j] : qnr[8 * fq + j]) * QS96;
#pragma unroll
        for (int ai = 0; ai < 2; ++ai)
#pragma unroll
            for (int m = 0; m < 4; ++m) {
                const int row = u.pm * 256 + ai * 128 + wr * 64 + m * 16 + fr;
                const float r = rf[4 * ai + m];
                float v[2][8]; float ss[2] = {0.f, 0.f};
#pragma unroll
                for (int bj = 0; bj < 2; ++bj)
#pragma unroll
                    for (int n = 0; n < 2; ++n)
#pragma unroll
                        for (int e = 0; e < 4; ++e) { const float x = acc[ai][bj][m][n][e] * r; v[bj][4 * n + e] = x; ss[bj] += x * x; }
                if (pn < 2) {
                    const float s = red_fq(ss[0] + ss[1]); const float r2 = __builtin_amdgcn_rsqf(s * (1.0f / 64.0f) + EPS);
                    const int head = 4 * pn + wc;
#pragma unroll
                    for (int bj = 0; bj < 2; ++bj) {
#pragma unroll
                        for (int j = 0; j < 8; ++j) v[bj][j] = v[bj][j] * r2 * gv[bj][j];
                        *(u32x4*)(QD + (size_t)row * 768 + head * 96 + 32 * bj + 8 * fq) = pack8(v[bj]); }
                } else {
                    const int pidx = pos_index(row);
#pragma unroll
                    for (int bj = 0; bj < 2; ++bj) {
                        const float s = red_fq(ss[bj]); const float r2 = __builtin_amdgcn_rsqf(s * (1.0f / 32.0f) + EPS);
#pragma unroll
                        for (int j = 0; j < 8; ++j) v[bj][j] = v[bj][j] * r2 * gv[bj][j];
                        rope8(v[bj], fq, ropetab, pidx);
                        const int head = 2 * wc + bj;
                        *(u32x4*)(QD + (size_t)row * 768 + head * 96 + 64 + 8 * fq) = pack8(v[bj]); }
                }
                asm volatile("" ::: "memory");
            }
    }
};

struct EpiKvb {
    static constexpr bool PERM = false, AFTER_DRAIN = false;
    Ctx C;
    EP_PREFETCH(WS_ROWSQ + 7 * ROWSQ_STRIDE)
    __device__ __forceinline__ void operator()(const f32x4 (&acc)[2][2][4][2], const Unit& u, int wr, int wc, int fr, int fq, float (&rfpre)[8]) const {
        EP_OPEN(); bf16_t* const KD = EPW(bf16_t, WS_R + R_KD); bf16_t* const VD = EPW(bf16_t, WS_R + R_VD); const float* const rsq_kva = EPW(float, WS_ROWSQ + 7 * ROWSQ_STRIDE); const float* const knn = in_[34];
        const int head = 2 * u.pn + (wc >> 1), part = wc & 1;
        EP_ROWF(rf, rsq_kva, 1.0f / 128.0f);
        float gv[2][8];
#pragma unroll
        for (int bj = 0; bj < 2; ++bj)
#pragma unroll
            for (int j = 0; j < 8; ++j) gv[bj][j] = knn[32 * bj + 8 * fq + j];
#pragma unroll
        for (int ai = 0; ai < 2; ++ai)
#pragma unroll
            for (int m = 0; m < 4; ++m) {
                const int row = u.pm * 256 + ai * 128 + wr * 64 + m * 16 + fr;
                const float r = rf[4 * ai + m];
                float v[2][8]; float ss = 0.f;
#pragma unroll
                for (int bj = 0; bj < 2; ++bj)
#pragma unroll
                    for (int n = 0; n < 2; ++n)
#pragma unroll
                        for (int e = 0; e < 4; ++e) { const float x = acc[ai][bj][m][n][e] * r; v[bj][4 * n + e] = x; ss += x * x; }
                if (part == 0) { ss = red_fq(ss); const float r2 = __builtin_amdgcn_rsqf(ss * (1.0f / 64.0f) + EPS);
#pragma unroll
                    for (int bj = 0; bj < 2; ++bj)
#pragma unroll
                        for (int j = 0; j < 8; ++j) v[bj][j] = v[bj][j] * r2 * gv[bj][j]; }
                bf16_t* dst = (part == 0 ? KD : VD) + (size_t)row * 512 + head * 64 + 8 * fq;
#pragma unroll
                for (int bj = 0; bj < 2; ++bj) *(u32x4*)(dst + 32 * bj) = pack8(v[bj]);
                asm volatile("" ::: "memory");
            }
    }
};

struct EpiNull {
    static constexpr bool PERM = false, AFTER_DRAIN = false;
    static constexpr int NPRE = 0; __device__ __forceinline__ void prefetch(float (&)[8], const Unit&, int) const {}
    __device__ __forceinline__ void operator()(const f32x4 (&acc)[2][2][4][2], const Unit& u, int wr, int wc, int fr, int fq, const float (&)[8]) const {
#pragma unroll
        for (int ai = 0; ai < 2; ++ai)
#pragma unroll
            for (int bj = 0; bj < 2; ++bj)
#pragma unroll
                for (int m = 0; m < 4; ++m)
#pragma unroll
                    for (int n = 0; n < 2; ++n) asm volatile("" :: "v"(acc[ai][bj][m][n]));
    }
};
}

typedef unsigned u32x2t __attribute__((ext_vector_type(2)));
struct Frame {
    LAS unsigned char* lds;
    volatile LAS unsigned* MISC;
    gu32* ctl;
    int vcu, G, wave_s;
    const float* const* in;
    float* out; unsigned char* ws;
};
#define WSP(T_, off) ((T_*)(F.ws + (off)))
#define LOCAL_IDS() int lane_; asm volatile("v_mbcnt_lo_u32_b32 %0, -1, 0\n\tv_mbcnt_hi_u32_b32 %0, -1, %0" : "=v"(lane_)); const int lane = lane_; const int wave = F.wave_s; const int tid = wave * 64 + lane; (void)tid
__device__ __forceinline__ float wave_sum(float v) {
#pragma unroll
    for (int o = 1; o < 64; o <<= 1) v += __shfl_xor(v, o);
    return v;
}

struct WMat { const float* W; int K, Nsrc; bf16* dst; int Kdst, ngroups; const float* gain; int kind; int natural; };
__device__ __forceinline__ int wsrc_base(int kind, int G) {
    const int pn = G >> 3, bj = (G >> 2) & 1, wc = G & 3;
    switch (kind) {
    case 0: return 32 * G;
    case 1: return bj * FF + 128 * pn + 32 * wc;
    case 2: return 256 * pn + 64 * wc + 32 * bj;
    case 3: if (pn < 2) return 32 * G; if (pn < 6) return (bj ? 1024 : 512) + 128 * (pn - 2) + 32 * wc; if (pn == 6) return 1536 + 128 * bj + 32 * wc;
            return bj == 0 ? 1792 + 32 * wc : (wc == 0 ? 1920 : -1);
    case 4: if (pn < 2) return 96 * (4 * pn + wc) + 32 * bj; return 96 * (2 * wc + bj) + 64;
    default: return 128 * (2 * pn + (wc >> 1)) + 64 * (wc & 1) + 32 * bj;
    }
}
__device__ __forceinline__ void wconv_item(const WMat& M, int item, LAS float* scr, int lane) {
    const int nkb = M.Kdst / 64, G = item / nkb, kb = item % nkb, k0 = 64 * kb;
    const int sb = wsrc_base(M.kind, G);
    const bool zero = (sb < 0) || (k0 >= M.K);
    const int c = lane & 7;
    float gk[8];
#pragma unroll
    for (int i = 0; i < 8; ++i) gk[i] = 1.0f;
    if (!zero) {
        float wv[32];
        const float* wp = M.W + (size_t)(k0 + (lane >> 5)) * M.Nsrc + sb + (lane & 31);
#pragma unroll
        for (int i = 0; i < 32; ++i) wv[i] = wp[(size_t)(2 * i) * M.Nsrc];
        if (M.gain) {
#pragma unroll
            for (int i = 0; i < 8; ++i) gk[i] = M.gain[k0 + 8 * c + i]; }
#pragma unroll
        for (int i = 0; i < 32; ++i) scr[(2 * i + (lane >> 5)) * 33 + (lane & 31)] = wv[i];
    }
    LDS_WAIT(); asm volatile("" ::: "memory");
#pragma unroll
    for (int j = 0; j < 4; ++j) { const int rho = (lane >> 3) + 8 * j; const int n = M.natural ? rho : pg8::perm32(rho); const LAS float* s = scr + (8 * c) * 33 + n;
        v4u o; if (zero) o = (v4u){0u, 0u, 0u, 0u}; else { o.x = pk2(s[0 * 33] * gk[0], s[1 * 33] * gk[1]); o.y = pk2(s[2 * 33] * gk[2], s[3 * 33] * gk[3]); o.z = pk2(s[4 * 33] * gk[4], s[5 * 33] * gk[5]); o.w = pk2(s[6 * 33] * gk[6], s[7 * 33] * gk[7]); }
        *(GAS v4u*)(M.dst + (size_t)(32 * G + rho) * M.Kdst + k0 + 8 * c) = o; }
    LDS_WAIT(); asm volatile("" ::: "memory");
}

__device__ __forceinline__ int t5_bucket(int rel) {
    int n = -rel; int ret = n < 0 ? 16 : 0; n = n < 0 ? -n : n;
    if (n < 8) return ret + n;
    const int q = (n * n) >> 6; int lg = 31 - __builtin_clz(q); int large = 8 + lg; if (large > 15) large = 15;
    return ret + large;
}

__device__ __forceinline__ WMat get_mat(const Frame& F, int mi) {
    const float* const* in = F.in; WMat M;
    if (mi < 8) { const int l = mi >> 2, f = (mi >> 1) & 1;
        if ((mi & 1) == 0) { M.W = (f ? in[14] : in[10]) + (size_t)l * DM * NGU; M.K = DM; M.Nsrc = NGU; M.dst = (bf16*)(F.ws + WS_W + W_GU0 + (size_t)(l * 2 + f) * W_GU_BYTES); M.Kdst = DM; M.ngroups = NGU / 32; M.gain = (f ? in[13] : in[9]) + l * DM; M.kind = 1; M.natural = 0; }
        else { M.W = (f ? in[15] : in[11]) + (size_t)l * FF * DM; M.K = FF; M.Nsrc = DM; M.dst = (bf16*)(F.ws + WS_W + W_D0 + (size_t)(l * 2 + f) * W_D_BYTES); M.Kdst = FF; M.ngroups = DM / 32; M.gain = nullptr; M.kind = 0; M.natural = 0; }
    } else if (mi == 8) { M.W = in[17]; M.K = DM; M.Nsrc = EV_IN; M.dst = (bf16*)(F.ws + WS_W + W_EVIN); M.Kdst = DM; M.ngroups = EV_IN / 32; M.gain = in[12]; M.kind = 2; M.natural = 0; }
    else if (mi == 9) { M.W = in[18]; M.K = DM; M.Nsrc = DM; M.dst = (bf16*)(F.ws + WS_W + W_EVOUT); M.Kdst = DM; M.ngroups = DM / 32; M.gain = nullptr; M.kind = 0; M.natural = 0; }
    else if (mi == 10) { M.W = in[25]; M.K = DM; M.Nsrc = OD_IN; M.dst = (bf16*)(F.ws + WS_W + W_ODIN); M.Kdst = DM; M.ngroups = OD_INP / 32; M.gain = in[12] + DM; M.kind = 3; M.natural = 0; }
    else if (mi == 11) { M.W = in[26]; M.K = DM; M.Nsrc = DM; M.dst = (bf16*)(F.ws + WS_W + W_ODOUT); M.Kdst = DM; M.ngroups = DM / 32; M.gain = nullptr; M.kind = 0; M.natural = 0; }
    else if (mi == 12) { M.W = in[29]; M.K = 256; M.Nsrc = 768; M.dst = (bf16*)(F.ws + WS_W + W_QB); M.Kdst = 256; M.ngroups = 768 / 32; M.gain = in[28]; M.kind = 4; M.natural = 0; }
    else if (mi == 13) { M.W = in[31]; M.K = 128; M.Nsrc = 1024; M.dst = (bf16*)(F.ws + WS_W + W_KVB); M.Kdst = 256; M.ngroups = 1024 / 32; M.gain = in[30]; M.kind = 5; M.natural = 0; }
    else { M.W = in[31]; M.K = 128; M.Nsrc = 1024; M.dst = (bf16*)(F.ws + WS_W + W_KVP); M.Kdst = 128; M.ngroups = 1024 / 32; M.gain = nullptr; M.kind = 0; M.natural = 1; }
    return M;
}

__device__ __forceinline__ void wconv_set(Frame& F, unsigned mask, int cu0, int ncu) {
    const int cu = (int)blockIdx.x - cu0; if (cu < 0 || cu >= ncu) return;
    LOCAL_IDS();
    LAS float* scr = (LAS float*)(F.lds + RING_OFF + wave * 16384);
    const int gw = cu * NWAVES + wave, NGW = ncu * NWAVES;
    int base = 0;
#pragma unroll 1
    for (int mi = 0; mi < 15; ++mi) {
        if (!((mask >> mi) & 1u)) continue;
        const WMat M = get_mat(F, mi);
        const int nitems = M.ngroups * (M.Kdst / 64);
        for (int it = (gw + NGW - (base % NGW)) % NGW; it < nitems; it += NGW) wconv_item(M, it, scr, lane);
        base += nitems;
    }
}
constexpr unsigned WSET_PROLOGUE = 0x001u;
constexpr unsigned WSET_PH1 = 0x306u;
constexpr unsigned WSET_PH3 = 0x7c38u;
constexpr unsigned WSET_PH6 = 0x0c0u;
static_assert((WSET_PROLOGUE | WSET_PH1 | WSET_PH3 | WSET_PH6) == 0x7fffu && (WSET_PROLOGUE & WSET_PH1) == 0 && (WSET_PH1 & WSET_PH3) == 0 && (WSET_PH3 & WSET_PH6) == 0, "every matrix converted once");

__device__ __forceinline__ void p0_prologue(Frame& F) {
    LOCAL_IDS();
    LAS float* scr = (LAS float*)(F.lds + RING_OFF + wave * 16384);
    const int gw = F.vcu * NWAVES + wave, NGW = F.G * NWAVES;
    const float* const* in = F.in;
    wconv_set(F, WSET_PROLOGUE, 0, F.G);
    {
        bf16* XB = WSP(bf16, WS_XB); float* rs0 = WSP(float, WS_ROWSQ);
        for (int m = gw; m < T; m += NGW) {
            const float* xr = m < TP ? in[0] + (size_t)m * DM : in[1] + (size_t)(m - TP) * DM;
            const GAS f32x4* xv = (const GAS f32x4*)xr + lane; float s = 0.f;
            GAS unsigned long long* o8 = (GAS unsigned long long*)(XB + (size_t)m * DM) + lane;
#pragma unroll
            for (int j = 0; j < 4; ++j) { const f32x4 v = xv[64 * j]; s += (v.x * v.x + v.y * v.y) + (v.z * v.z + v.w * v.w);
                o8[64 * j] = (unsigned long long)pk2(v.x, v.y) | ((unsigned long long)pk2(v.z, v.w) << 32); }
            s = wave_sum(s); if (lane == 0) rs0[m] = s;
        }
    }
}
__device__ __forceinline__ void p0_aux(Frame& F, int cu0, int ncu) {
    const int cu = (int)blockIdx.x - cu0; if (cu < 0 || cu >= ncu) return;
    LOCAL_IDS();
    const int gw = cu * NWAVES + wave, NGW = ncu * NWAVES;
    const float* const* in = F.in;
    {
        const size_t gt = (size_t)gw * 64 + lane, NT_ = (size_t)NGW * 64;
        bf16* cak = WSP(bf16, WS_R + R_CAK); bf16* cav = WSP(bf16, WS_R + R_CAV); bf16* cbk = WSP(bf16, WS_R + R_CBK); bf16* cbv = WSP(bf16, WS_R + R_CBV);
        for (size_t i = gt; i < 131072 / 4; i += NT_) { const f32x4 a = ((const f32x4*)in[2])[i], b = ((const f32x4*)in[3])[i];
            ((u32x2t*)cak)[i] = (u32x2t){pk2(a.x, a.y), pk2(a.z, a.w)}; ((u32x2t*)cav)[i] = (u32x2t){pk2(b.x, b.y), pk2(b.z, b.w)}; }
        for (size_t i = gt; i < 2097152 / 4; i += NT_) { const f32x4 a = ((const f32x4*)in[4])[i], b = ((const f32x4*)in[5])[i];
            ((u32x2t*)cbk)[i] = (u32x2t){pk2(a.x, a.y), pk2(a.z, a.w)}; ((u32x2t*)cbv)[i] = (u32x2t){pk2(b.x, b.y), pk2(b.z, b.w)}; }
        for (size_t i = gt; i < (size_t)NB * 64 * 32; i += NT_) { const size_t b = i / (64 * 32), r = i % (64 * 32);
            ((f32x4*)(F.out + O_AKS))[b * 128 * 32 + r] = ((const f32x4*)in[2])[b * 128 * 32 + 64 * 32 + r];
            ((f32x4*)(F.out + O_AVS))[b * 128 * 32 + r] = ((const f32x4*)in[3])[b * 128 * 32 + 64 * 32 + r]; }
        for (size_t i = gt; i < (size_t)NB * 448 * 128; i += NT_) { const size_t b = i / (448 * 128), r = i % (448 * 128);
            ((f32x4*)(F.out + O_BKS))[b * 512 * 128 + r] = ((const f32x4*)in[4])[b * 512 * 128 + 64 * 128 + r];
            ((f32x4*)(F.out + O_BVS))[b * 512 * 128 + r] = ((const f32x4*)in[5])[b * 512 * 128 + 64 * 128 + r]; }
        float* biasA = WSP(float, WS_TAB + TAB_BIASA); float* biasB = WSP(float, WS_TAB + TAB_BIASB); float* rope = WSP(float, WS_TAB + TAB_ROPE);
        for (size_t i = gt; i < 8 * 256; i += NT_) { const int h = (int)(i >> 8), k = (int)(i & 255); const int rel = k - 191; biasA[i] = (k < 255) ? in[16][t5_bucket(rel) * 8 + h] * LOG2E : 0.f; }
        for (size_t i = gt; i < 8 * 640; i += NT_) { const int h = (int)(i / 640), k = (int)(i % 640); int rel = k - 575; rel = rel < -128 ? -128 : (rel > 128 ? 128 : rel); biasB[i] = in[24][h * 257 + rel + 128] * LOG2E; }
        for (size_t i = gt; i < (size_t)NPOS * 16; i += NT_) { const int p = (int)(i >> 4), j = (int)(i & 15); const int pos = p < SEQ ? p : PAST + (p - SEQ);
            const float inv = 1.0f / __builtin_powf(10000.0f, (float)j / 16.0f); const float ang = (float)pos * inv;
            const double a = (double)ang; const double k2 = __builtin_rint(a * 0.15915494309189535); const float red = (float)(a - k2 * 6.283185307179586);
            rope[i] = __builtin_cosf(red); rope[(size_t)NPOS * 16 + i] = __builtin_sinf(red); }
    }
}

namespace att {
#define GLD(T_, base_, boff_) (*(const GAS T_*)((const GAS unsigned char*)(base_) + (unsigned)(boff_)))
#define GST(T_, base_, boff_) (*(GAS T_*)((GAS unsigned char*)(base_) + (unsigned)(boff_)))
typedef short bf16x8 __attribute__((ext_vector_type(8)));
typedef short s16x4 __attribute__((ext_vector_type(4)));
typedef float f32x16 __attribute__((ext_vector_type(16)));
typedef unsigned u32x4 __attribute__((ext_vector_type(4)));
typedef unsigned u32x2 __attribute__((ext_vector_type(2)));
typedef float f32x2_t __attribute__((ext_vector_type(2))); typedef __bf16 bf16x2_t __attribute__((ext_vector_type(2)));
__device__ __forceinline__ unsigned cvtpk(float lo, float hi) { f32x2_t v = {lo, hi}; bf16x2_t b = __builtin_convertvector(v, bf16x2_t); return __builtin_bit_cast(unsigned, b); }
__device__ __forceinline__ s16x4 vtr(LAS const unsigned char* p) { typedef short v4i16_t __attribute__((ext_vector_type(4))); return __builtin_bit_cast(s16x4, __builtin_amdgcn_ds_read_tr16_b64_v4i16((LAS v4i16_t*)p)); }

constexpr int KSMAX = 208;
constexpr int L_K = 0, L_KBUF = 64 * KSMAX;
constexpr int L_V = 2 * L_KBUF, L_VBUF = 8192;
constexpr int L_TAB = L_V + 2 * L_VBUF;
constexpr int L_END = L_TAB + 28672 + 64;


template <int NKA, int NKB, bool BIAS, int VS = 64>
__device__ __forceinline__ void tile_step(const LAS unsigned char* Ka, int kaj, const LAS unsigned char* Kb, int kbj, const bf16x8* qf, const LAS float* tb, const LAS unsigned char* Vb,
                                          float& m, float& l, f32x16& o0, f32x16& o1) {
    constexpr int NK = NKA + NKB;
    bf16x8 ka[NK], kc[NK];
#pragma unroll
    for (int ks = 0; ks < NKA; ++ks) { ka[ks] = *(const LAS bf16x8*)(Ka + 32 * ks); kc[ks] = *(const LAS bf16x8*)(Ka + kaj + 32 * ks); }
#pragma unroll
    for (int ks = 0; ks < NKB; ++ks) { ka[NKA + ks] = *(const LAS bf16x8*)(Kb + 32 * ks); kc[NKA + ks] = *(const LAS bf16x8*)(Kb + kbj + 32 * ks); }
    float bv0[16], bv1[16];
    if (BIAS) {
#pragma unroll
        for (int r = 0; r < 16; ++r) { bv0[r] = tb[(r & 3) + 8 * (r >> 2)]; bv1[r] = tb[32 + (r & 3) + 8 * (r >> 2)]; }
    }
    __builtin_amdgcn_sched_barrier(0);
    f32x16 p0, p1;
#pragma unroll
    for (int r = 0; r < 16; ++r) { p0[r] = BIAS ? bv0[r] : 0.f; p1[r] = BIAS ? bv1[r] : 0.f; }
#pragma unroll
    for (int ks = 0; ks < NK; ++ks) {
        p0 = __builtin_amdgcn_mfma_f32_32x32x16_bf16(ka[ks], qf[ks], p0, 0, 0, 0);
        p1 = __builtin_amdgcn_mfma_f32_32x32x16_bf16(kc[ks], qf[ks], p1, 0, 0, 0);
    }
    s16x4 vlo0[4], vhi0[4], vlo1[4], vhi1[4];
#pragma unroll
    for (int i = 0; i < 4; ++i) { const int ro = 16 * i * VS; vlo0[i] = vtr(Vb + ro); vhi0[i] = vtr(Vb + ro + 8 * VS); vlo1[i] = vtr(Vb + 64 * VS + ro); vhi1[i] = vtr(Vb + 64 * VS + ro + 8 * VS); }
    __builtin_amdgcn_sched_barrier(0);
    float mx = p0[0];
#pragma unroll
    for (int r = 1; r < 16; ++r) mx = fmaxf(mx, p0[r]);
#pragma unroll
    for (int r = 0; r < 16; ++r) mx = fmaxf(mx, p1[r]);
    mx = fmaxf(mx, __shfl_xor(mx, 32));
    const float mn = fmaxf(m, mx); const float f = __builtin_amdgcn_exp2f(m - mn); m = mn;
    const f32x2_t mn2 = {mn, mn}; f32x2_t rs2 = {0.f, 0.f};
#pragma unroll
    for (int r = 0; r < 16; r += 2) {
        f32x2_t a = {p0[r], p0[r + 1]}, b = {p1[r], p1[r + 1]}; a = a - mn2; b = b - mn2;
        a.x = __builtin_amdgcn_exp2f(a.x); a.y = __builtin_amdgcn_exp2f(a.y); b.x = __builtin_amdgcn_exp2f(b.x); b.y = __builtin_amdgcn_exp2f(b.y);
        p0[r] = a.x; p0[r + 1] = a.y; p1[r] = b.x; p1[r + 1] = b.y; rs2 = rs2 + (a + b);
    }
    const float rs = rs2.x + rs2.y;
    l = l * f + rs;
#pragma unroll
    for (int r = 0; r < 16; ++r) { o0[r] *= f; o1[r] *= f; }
#pragma unroll
    for (int i = 0; i < 4; ++i) {
        const f32x16& pp = (i >> 1) ? p1 : p0; const int s = i & 1;
        u32x4 pw; pw.x = cvtpk(pp[8 * s + 0], pp[8 * s + 1]); pw.y = cvtpk(pp[8 * s + 2], pp[8 * s + 3]); pw.z = cvtpk(pp[8 * s + 4], pp[8 * s + 5]); pw.w = cvtpk(pp[8 * s + 6], pp[8 * s + 7]);
        const bf16x8 bfrag = __builtin_bit_cast(bf16x8, pw);
        const bf16x8 a0 = (bf16x8){vlo0[i][0], vlo0[i][1], vlo0[i][2], vlo0[i][3], vhi0[i][0], vhi0[i][1], vhi0[i][2], vhi0[i][3]};
        const bf16x8 a1 = (bf16x8){vlo1[i][0], vlo1[i][1], vlo1[i][2], vlo1[i][3], vhi1[i][0], vhi1[i][1], vhi1[i][2], vhi1[i][3]};
        o0 = __builtin_amdgcn_mfma_f32_32x32x16_bf16(a0, bfrag, o0, 0, 0, 0);
        o1 = __builtin_amdgcn_mfma_f32_32x32x16_bf16(a1, bfrag, o1, 0, 0, 0);
    }
}

struct Tiles {
    int nt, n0;
    const bf16 *k0, *v0, *pe0; int kp0, vp0;
    const bf16 *k1, *v1, *pe1; int kp1, vp1;
};
struct WaveCfg {
    const bf16* q; int qpitch;
    bf16* o; int opitch;
    int active, tlo, thi;
    int tab_off;
    int rel0;
    int qrow0;
    float m0; int has_sink;
};

template <int DQK, bool BIAS>
__device__ __forceinline__ void unit(LAS unsigned char* lds, const Tiles& TL, const WaveCfg& W, int tid) {
    constexpr int KS = DQK * 2 + 16, NKS = DQK / 16;
    const int lane = tid & 63, r32 = lane & 31, h = lane >> 5;
    const int srow = tid >> 3, sch = tid & 7;
    v4u kregA, vregA, peregA, kregB, vregB, peregB;
#define ATT_ISSUE(j_, KR, VR, PR) do { const int j__ = (j_); const bool s0 = j__ < TL.n0; const int jj = s0 ? j__ : j__ - TL.n0; \
        const bf16* kb_ = s0 ? TL.k0 : TL.k1; const bf16* vb_ = s0 ? TL.v0 : TL.v1; const int kp = s0 ? TL.kp0 : TL.kp1, vp = s0 ? TL.vp0 : TL.vp1; \
        KR = *(const GAS v4u*)(kb_ + (size_t)(64 * jj + srow) * kp + 8 * sch); VR = *(const GAS v4u*)(vb_ + (size_t)(64 * jj + srow) * vp + 8 * sch); \
        if (DQK == 96) { if (tid < 256) { const bf16* pb = s0 ? TL.pe0 : TL.pe1; PR = *(const GAS v4u*)(pb + (size_t)(64 * jj + (tid >> 2)) * 32 + 8 * (tid & 3)); } } } while (0)
#define ATT_COMMIT(buf_, KR, VR, PR) do { const int b__ = (buf_); *(LAS v4u*)(lds + L_K + b__ * L_KBUF + srow * KS + 16 * sch) = KR; \
        *(LAS v4u*)(lds + L_V + b__ * L_VBUF + (sch >> 2) * 4096 + srow * 64 + (sch & 3) * 16) = VR; \
        if (DQK == 96) { *(LAS v4u*)(lds + L_K + b__ * L_KBUF + ((tid & 255) >> 2) * KS + 128 + 16 * (tid & 3)) = PR; } } while (0)
    bf16x8 qf[NKS];
    if (W.active) {
#pragma unroll
        for (int ks = 0; ks < NKS; ++ks) qf[ks] = *(const GAS bf16x8*)(W.q + (size_t)r32 * W.qpitch + 16 * ks + 8 * h);
    } else {
#pragma unroll
        for (int ks = 0; ks < NKS; ++ks) qf[ks] = (bf16x8){0, 0, 0, 0, 0, 0, 0, 0};
    }
    float m = W.m0, l = (W.has_sink && h == 0) ? 1.0f : 0.0f;
    f32x16 o0, o1;
#pragma unroll
    for (int r = 0; r < 16; ++r) { o0[r] = 0.f; o1[r] = 0.f; }
    const int vb = ((lane >> 4) & 1) * 32 + (lane & 3) * 8 + (4 * h + ((lane & 15) >> 2)) * 64;
    const LAS float* tab = (const LAS float*)(lds + L_TAB) + W.tab_off + W.rel0 - (W.qrow0 + r32) + 4 * h;

    peregA = (v4u){0u, 0u, 0u, 0u}; peregB = peregA;
    ATT_ISSUE(0, kregA, vregA, peregA);
    if (TL.nt > 1) ATT_ISSUE(1, kregB, vregB, peregB);
    ATT_COMMIT(0, kregA, vregA, peregA); __syncthreads();
#define ATT_STEP(j_, KI, VI, PI, KC, VC, PC) do { const int j = (j_); \
        if (j + 2 < TL.nt) ATT_ISSUE(j + 2, KI, VI, PI); \
        if (W.active && j >= W.tlo && j <= W.thi) \
            tile_step<NKS, 0, BIAS>(lds + L_K + (j & 1) * L_KBUF + r32 * KS + 16 * h, 32 * KS, lds, 0, qf, tab + 64 * j, lds + L_V + (j & 1) * L_VBUF + vb, m, l, o0, o1); \
        if (j + 1 < TL.nt) ATT_COMMIT((j + 1) & 1, KC, VC, PC); \
        __syncthreads(); } while (0)
    for (int j0 = 0; j0 < TL.nt; j0 += 2) {
        ATT_STEP(j0, kregA, vregA, peregA, kregB, vregB, peregB);
        if (j0 + 1 < TL.nt) ATT_STEP(j0 + 1, kregB, vregB, peregB, kregA, vregA, peregA);
    }
#undef ATT_STEP
#undef ATT_ISSUE
#undef ATT_COMMIT
    if (W.active) {
        const float lt = l + __shfl_xor(l, 32); const float inv = 1.0f / lt;
        bf16* orow = W.o + (size_t)r32 * W.opitch;
#pragma unroll
        for (int g4 = 0; g4 < 4; ++g4) {
            u32x2 w0, w1;
            w0.x = cvtpk(o0[4 * g4] * inv, o0[4 * g4 + 1] * inv); w0.y = cvtpk(o0[4 * g4 + 2] * inv, o0[4 * g4 + 3] * inv);
            w1.x = cvtpk(o1[4 * g4] * inv, o1[4 * g4 + 1] * inv); w1.y = cvtpk(o1[4 * g4 + 2] * inv, o1[4 * g4 + 3] * inv);
            *(GAS u32x2*)(orow + 8 * g4 + 4 * h) = w0; *(GAS u32x2*)(orow + 32 + 8 * g4 + 4 * h) = w1;
        }
    }
}

template <int DQK, bool BIAS, class Src>
__device__ __forceinline__ void run(LAS unsigned char* lds, const Src& S, int tid) {
    constexpr int KS = DQK * 2 + 16, NKS = DQK / 16;
    const int lane = tid & 63, r32 = lane & 31, h = lane >> 5;
    const int srow = tid >> 3, sch = tid & 7;
    Tiles Ti; WaveCfg Wc;
    int ui = 0, ji = 0, uc = 0, jc = 0, n_issued = 0, ntc = 0;
    bool more_i, more_c;
    { WaveCfg wt_; more_i = S.get(0, Ti, wt_); } if (!more_i) return;
    { Tiles tt_; more_c = S.get(0, tt_, Wc); ntc = tt_.nt; }
    v4u kregA, vregA, peregA, kregB, vregB, peregB;
    peregA = (v4u){0u, 0u, 0u, 0u}; peregB = peregA;
#define RUN_ISSUE(KR, VR, PR) do { { const bool s0 = ji < Ti.n0; const int jj = s0 ? ji : ji - Ti.n0; \
        const bf16* kb_ = s0 ? Ti.k0 : Ti.k1; const bf16* vb_ = s0 ? Ti.v0 : Ti.v1; const int kp = s0 ? Ti.kp0 : Ti.kp1, vp = s0 ? Ti.vp0 : Ti.vp1; \
        KR = *(const GAS v4u*)(kb_ + (size_t)(64 * jj + srow) * kp + 8 * sch); VR = *(const GAS v4u*)(vb_ + (size_t)(64 * jj + srow) * vp + 8 * sch); \
        if (DQK == 96) { const bf16* pb = s0 ? Ti.pe0 : Ti.pe1; PR = *(const GAS v4u*)(pb + (size_t)(64 * jj + ((tid & 255) >> 2)) * 32 + 8 * (tid & 3)); } } \
        if (more_i) { ++n_issued; if (++ji >= Ti.nt) { ji = 0; ++ui; WaveCfg wt_; more_i = S.get(ui, Ti, wt_); } } } while (0)
#define RUN_COMMIT(buf_, KR, VR, PR) do { const int b__ = (buf_); *(LAS v4u*)(lds + L_K + b__ * L_KBUF + srow * KS + 16 * sch) = KR; \
        *(LAS v4u*)(lds + L_V + b__ * L_VBUF + (sch >> 2) * 4096 + srow * 64 + (sch & 3) * 16) = VR; \
        if (DQK == 96) { *(LAS v4u*)(lds + L_K + b__ * L_KBUF + ((tid & 255) >> 2) * KS + 128 + 16 * (tid & 3)) = PR; } } while (0)
    bf16x8 qf[NKS], qn[NKS]; float m, l; f32x16 o0, o1; const LAS float* tab;
    WaveCfg Wn; bool more_n = false; int ntn = 0;
#define RUN_QLOAD(W_, Q_) do { if ((W_).active) { _Pragma("unroll") for (int ks = 0; ks < NKS; ++ks) Q_[ks] = *(const GAS bf16x8*)((W_).q + (size_t)r32 * (W_).qpitch + 16 * ks + 8 * h); } \
        else { _Pragma("unroll") for (int ks = 0; ks < NKS; ++ks) Q_[ks] = (bf16x8){0, 0, 0, 0, 0, 0, 0, 0}; } } while (0)
#define RUN_OPEN() do { \
        m = Wc.m0; l = (Wc.has_sink && h == 0) ? 1.0f : 0.0f; _Pragma("unroll") for (int r = 0; r < 16; ++r) { o0[r] = 0.f; o1[r] = 0.f; } \
        tab = (const LAS float*)(lds + L_TAB) + Wc.tab_off + Wc.rel0 - (Wc.qrow0 + r32) + 4 * h; } while (0)
#define RUN_CLOSE() do { if (Wc.active) { const float lt = l + __shfl_xor(l, 32); const float inv = 1.0f / lt; bf16* orow = Wc.o + (size_t)r32 * Wc.opitch; \
        _Pragma("unroll") for (int g4 = 0; g4 < 4; ++g4) { u32x2 w0, w1; \
            w0.x = cvtpk(o0[4 * g4] * inv, o0[4 * g4 + 1] * inv); w0.y = cvtpk(o0[4 * g4 + 2] * inv, o0[4 * g4 + 3] * inv); \
            w1.x = cvtpk(o1[4 * g4] * inv, o1[4 * g4 + 1] * inv); w1.y = cvtpk(o1[4 * g4 + 2] * inv, o1[4 * g4 + 3] * inv); \
            *(GAS u32x2*)(orow + 8 * g4 + 4 * h) = w0; *(GAS u32x2*)(orow + 32 + 8 * g4 + 4 * h) = w1; } } } while (0)
    const int vb = ((lane >> 4) & 1) * 32 + (lane & 3) * 8 + (4 * h + ((lane & 15) >> 2)) * 64;
    RUN_ISSUE(kregA, vregA, peregA);
    RUN_ISSUE(kregB, vregB, peregB);
    RUN_COMMIT(0, kregA, vregA, peregA); __syncthreads();
    RUN_QLOAD(Wc, qf);
    RUN_OPEN();
#define RUN_STEP(s_, KI, VI, PI, KC, VC, PC) do { const int s__ = (s_); \
        RUN_ISSUE(KI, VI, PI); \
        if (jc == ntc - 1) { Tiles tt_; more_n = S.get(uc + 1, tt_, Wn); ntn = tt_.nt; if (more_n) RUN_QLOAD(Wn, qn); }     \
        if (Wc.active && jc >= Wc.tlo && jc <= Wc.thi) \
            tile_step<NKS, 0, BIAS>(lds + L_K + (s__ & 1) * L_KBUF + r32 * KS + 16 * h, 32 * KS, lds, 0, qf, tab + 64 * jc, lds + L_V + (s__ & 1) * L_VBUF + vb, m, l, o0, o1); \
        if (s__ + 1 < n_issued) RUN_COMMIT((s__ + 1) & 1, KC, VC, PC); \
        __syncthreads(); \
        if (++jc >= ntc) { RUN_CLOSE(); jc = 0; ++uc; Wc = Wn; ntc = ntn; more_c = more_n; if (more_c) { _Pragma("unroll") for (int ks = 0; ks < NKS; ++ks) qf[ks] = qn[ks]; RUN_OPEN(); } } } while (0)
    for (int s = 0; more_c; s += 2) {
        RUN_STEP(s, kregA, vregA, peregA, kregB, vregB, peregB);
        if (!more_c) break;
        RUN_STEP(s + 1, kregB, vregB, peregB, kregA, vregA, peregA);
    }
#undef RUN_STEP
#undef RUN_OPEN
#undef RUN_QLOAD
#undef RUN_CLOSE
#undef RUN_ISSUE
#undef RUN_COMMIT
}

constexpr int SD_CT = 0, SD_CTS = 272;
constexpr int SD_PE = 17408, SD_PES = 80;
constexpr int SD_K = 17408 + 2 * 5120, SD_KS = 144;
constexpr int SD_VS = 72, SD_VH = 2 * 64 * SD_VS;
constexpr int SD_V = SD_K + 4 * 64 * SD_KS;
constexpr int SD_GN = SD_V + 4 * SD_VH;
constexpr int SD_END = SD_GN + 256;
typedef float f32x4v __attribute__((ext_vector_type(4)));
__device__ __forceinline__ void sampled_unit(LAS unsigned char* lds, int b, int hg, int t0, int t1, const float* cckv, const float* cpe, const bf16* ckvs, const bf16* kpes,
                                             const bf16* wt, const float* knn, const bf16* QD, float* part, int split, int wave, int lane, int tid, int sdx = 0) {
    const int r32 = lane & 31, h = lane >> 5, l15_ = lane & 15, l4_ = lane >> 4;
    const int hp = wave >> 1, prt = wave & 1, head = hg * 4 + hp;
    bf16x8 qf[6];
    { const bf16* qp = QD + (size_t)(TP + b * 64 + 32 * (wave & 1) + r32) * 768 + head * 96;
#pragma unroll
      for (int ks = 0; ks < 6; ++ks) qf[ks] = *(const GAS bf16x8*)(qp + 16 * ks + 8 * h); }
    float m = -1e30f, l = 0.f; f32x16 o0, o1;
#pragma unroll
    for (int r = 0; r < 16; ++r) { o0[r] = 0.f; o1[r] = 0.f; }
    const int vb = ((lane >> 4) & 1) * 32 + (lane & 3) * 8 + (4 * h + ((lane & 15) >> 2)) * SD_VS;
    int srow = tid >> 3, sch = tid & 7;
    f32x4v ra, rb, rc, rd, rp;
#define SD_ISSUE(t_) do { const int tt_ = (t_); const bool c_ = tt_ < 64; \
        const GAS f32x4v* src = c_ ? (const GAS f32x4v*)(cckv + (size_t)(64 * tt_ + srow) * 128 + 16 * sch) : (const GAS f32x4v*)(ckvs + (size_t)srow * 128 + 16 * sch); \
        const GAS f32x4v* ps_ = c_ ? (const GAS f32x4v*)(cpe + (size_t)(64 * tt_ + srow) * 32 + 4 * sch) : (const GAS f32x4v*)(kpes + (size_t)srow * 32 + 4 * sch); \
        ra = src[0]; rb = src[1]; rc = src[c_ ? 2 : 0]; rd = src[c_ ? 3 : 1]; rp = *ps_; } while (0)
#define SD_COMMIT(t_, pebuf) do { v4u w0, w1; u32x2 pw; \
        if ((t_) < 64) { w0.x = cvtpk(ra.x, ra.y); w0.y = cvtpk(ra.z, ra.w); w0.z = cvtpk(rb.x, rb.y); w0.w = cvtpk(rb.z, rb.w); w1.x = cvtpk(rc.x, rc.y); w1.y = cvtpk(rc.z, rc.w); w1.z = cvtpk(rd.x, rd.y); w1.w = cvtpk(rd.z, rd.w); \
            pw.x = cvtpk(rp.x, rp.y); pw.y = cvtpk(rp.z, rp.w); } else { w0 = __builtin_bit_cast(v4u, ra); w1 = __builtin_bit_cast(v4u, rb); pw.x = __float_as_uint(rp.x); pw.y = __float_as_uint(rp.y); } \
        *(LAS v4u*)(lds + SD_CT + srow * SD_CTS + 32 * sch) = w0; *(LAS v4u*)(lds + SD_CT + srow * SD_CTS + 32 * sch + 16) = w1; \
        *(LAS u32x2*)(lds + SD_PE + (pebuf) * 64 * SD_PES + srow * SD_PES + 8 * sch) = pw; } while (0)
    ra = rb = rc = rd = rp = (f32x4v){0.f, 0.f, 0.f, 0.f};
    if (tid < 64) *(LAS float*)(lds + SD_GN + 4 * tid) = knn[tid];
    SD_ISSUE(t0);
    for (int t = t0; t < t1; ++t) {
        const int pb = (t - t0) & 1;
        asm volatile("" : "+v"(srow), "+v"(sch));
        int l15w = l15_, l4w = l4_; asm volatile("" : "+v"(l15w), "+v"(l4w));
        bf16x8 wf[4][4];
#pragma unroll
        for (int db = 0; db < 4; ++db)
#pragma unroll
            for (int ks = 0; ks < 4; ++ks) wf[db][ks] = *(const GAS bf16x8*)(wt + (size_t)(head * 128 + prt * 64 + 16 * db + l15w) * 128 + 32 * ks + 8 * l4w);
        SD_COMMIT(t, pb);
        SD_ISSUE(t + 1 < t1 ? t + 1 : t);
        __syncthreads();
#pragma unroll 1
        for (int kb = 0; kb < ((sdx & 1) ? 0 : 4); ++kb) {
            int l15 = l15_, l4 = l4_; asm volatile("" : "+v"(l15), "+v"(l4));
            f32x4v acc[4];
#pragma unroll
            for (int db = 0; db < 4; ++db) acc[db] = (f32x4v){0.f, 0.f, 0.f, 0.f};
#pragma unroll
            for (int ks = 0; ks < 4; ++ks) {
                const bf16x8 bfr = *(const LAS bf16x8*)(lds + SD_CT + (16 * kb + l15) * SD_CTS + 64 * ks + 16 * l4);
#pragma unroll
                for (int db = 0; db < 4; ++db) acc[db] = __builtin_amdgcn_mfma_f32_16x16x32_bf16(wf[db][ks], bfr, acc[db], 0, 0, 0);
            }
            const int key = 16 * kb + l15;
            if (prt == 0) {
                float ss = 0.f;
#pragma unroll
                for (int db = 0; db < 4; ++db) ss += (acc[db][0] * acc[db][0] + acc[db][1] * acc[db][1]) + (acc[db][2] * acc[db][2] + acc[db][3] * acc[db][3]);
                ss += __shfl_xor(ss, 16); ss += __shfl_xor(ss, 32);
                const float r2 = __builtin_amdgcn_rsqf(ss * (1.0f / 64.0f) + EPS);
#pragma unroll
                for (int db = 0; db < 4; ++db) { const f32x4v gn = *(const LAS f32x4v*)(lds + SD_GN + (16 * db + 4 * l4) * 4); u32x2 w; w.x = cvtpk(acc[db][0] * r2 * gn[0], acc[db][1] * r2 * gn[1]); w.y = cvtpk(acc[db][2] * r2 * gn[2], acc[db][3] * r2 * gn[3]);
                    *(LAS u32x2*)(lds + SD_K + hp * 64 * SD_KS + key * SD_KS + (16 * db + 4 * l4) * 2) = w; }
            } else {
#pragma unroll
                for (int db = 0; db < 4; ++db) { u32x2 w; w.x = cvtpk(acc[db][0], acc[db][1]); w.y = cvtpk(acc[db][2], acc[db][3]); const int dv = 16 * db + 4 * l4;
                    *(LAS u32x2*)(lds + SD_V + hp * SD_VH + (dv >> 5) * 64 * SD_VS + key * SD_VS + (dv & 31) * 2) = w; }
            }
        }
        __syncthreads();
        if (!(sdx & 2)) tile_step<4, 2, false, SD_VS>(lds + SD_K + hp * 64 * SD_KS + r32 * SD_KS + 16 * h, 32 * SD_KS, lds + SD_PE + pb * 64 * SD_PES + r32 * SD_PES + 16 * h, 32 * SD_PES, qf, nullptr, lds + SD_V + hp * SD_VH + vb, m, l, o0, o1);
    }
    __syncthreads();
#undef SD_ISSUE
#undef SD_COMMIT
    if (sdx & 8) return;
    float* P = part + ((size_t)((b * 8 + head) * NSPLIT + split)) * (64 * 66);
    const int q = 32 * (wave & 1) + r32;
#pragma unroll
    for (int g4 = 0; g4 < 4; ++g4) {
        *(GAS f32x4v*)(P + (((wave & 1) * 8 + g4) * 64 + lane) * 4) = (f32x4v){o0[4 * g4], o0[4 * g4 + 1], o0[4 * g4 + 2], o0[4 * g4 + 3]};
        *(GAS f32x4v*)(P + (((wave & 1) * 8 + 4 + g4) * 64 + lane) * 4) = (f32x4v){o1[4 * g4], o1[4 * g4 + 1], o1[4 * g4 + 2], o1[4 * g4 + 3]};
    }
    const float lt = l + __shfl_xor(l, 32);
    if (h == 0) { P[4096 + q] = m; P[4160 + q] = lt; }
}
}

constexpr int NU_BP = NB * 8 * 8, NU_BS = NB * 8, NU_AP = NB * 32 * 2, NU_AS = NB * 2, NU_L0 = NU_BP + NU_BS + NU_AP + NU_AS;
__device__ __forceinline__ int att0_unit(int c, int slot) {
    if (slot == 0 || (slot == 1 && c < 128)) { const int i = slot == 0 ? c : 256 + c; const int b = i / 48, r = i - 48 * b; return b * 64 + (r / 6) * 8 + 2 + (r % 6); }
    if (slot == 1) { if (c < 192) return NU_BP + (c - 128); const int j = c - 192; return (j >> 3) * 64 + (j & 7) * 8 + 1; }
    int a;
    if (slot == 2) { if (c >= 192) { const int j = c - 192; return (j >> 3) * 64 + (j & 7) * 8; } a = c >= 128 ? c - 128 : 64 + c; }
    else if (slot == 3) { if (c < 128) return -1; a = 192 + (c - 128); }
    else { if (c >= 208) return -1; a = 320 + c; }
    return NU_BP + NU_BS + a;
}
struct SrcL0 {
    const bf16 *QKV, *cak, *cav, *cbk, *cbv; bf16* MIX; const LAS float* sinks; int c, G, w; int cls;
    __device__ __forceinline__ int unit_of(int it) const {
        if (G == 256) { const int nu = (c < 128 || c >= 208) ? 4 : 5; if (it >= nu) return -1; return att0_unit(c, (c < 128 && it >= 3) ? it + 1 : it); }
        const int ui = c + it * G; return ui >= NU_L0 ? -1 : ui; }
    __device__ __forceinline__ bool get(int it, att::Tiles& TL, att::WaveCfg& W) const {
        const int ui = unit_of(it);
        if (ui < 0) return false;
        TL.pe0 = nullptr; TL.pe1 = nullptr; TL.k1 = nullptr; TL.v1 = nullptr; TL.kp1 = 0; TL.vp1 = 0;
        W.qpitch = EV_IN; W.opitch = DM; W.tab_off = 0; W.has_sink = 0; W.m0 = -1e30f; W.active = 1; W.qrow0 = 32 * (w & 1);
        if (ui < NU_BP + NU_BS) {
            int b, h;
            if (ui < NU_BP) {
                b = ui >> 6; h = (ui >> 3) & 7; const int cg = ui & 7; const int cw = 4 * cg + (w >> 1); const int c0 = (4 * cg - 8) > 0 ? (4 * cg - 8) : 0;
                TL.nt = 4 * cg + 4 - c0; TL.n0 = TL.nt;
                const size_t r0 = (size_t)b * SEQ + (size_t)c0 * 64;
                TL.k0 = QKV + r0 * EV_IN + 1280 + h * 64; TL.v0 = QKV + r0 * EV_IN + 1792 + h * 64; TL.kp0 = EV_IN; TL.vp0 = EV_IN;
                const size_t qr = (size_t)b * SEQ + (size_t)cw * 64 + 32 * (w & 1);
                W.q = QKV + qr * EV_IN + 768 + h * 64; W.o = MIX + qr * DM + 512 + h * 64;
                const int lo = (cw - 8) > 0 ? (cw - 8) : 0; W.tlo = lo - c0; W.thi = cw - c0; W.rel0 = (c0 - cw) * 64 + 575;
            } else {
                const int u2 = ui - NU_BP; b = u2 >> 3; h = u2 & 7;
                TL.nt = 9; TL.n0 = 8;
                TL.k0 = cbk + (size_t)b * 512 * 512 + h * 64; TL.v0 = cbv + (size_t)b * 512 * 512 + h * 64; TL.kp0 = 512; TL.vp0 = 512;
                const size_t r1 = (size_t)TP + (size_t)b * 64;
                TL.k1 = QKV + r1 * EV_IN + 1280 + h * 64; TL.v1 = QKV + r1 * EV_IN + 1792 + h * 64; TL.kp1 = EV_IN; TL.vp1 = EV_IN;
                W.active = w < 2; const size_t qr = r1 + 32 * (w & 1);
                W.q = QKV + qr * EV_IN + 768 + h * 64; W.o = MIX + qr * DM + 512 + h * 64;
                W.tlo = 0; W.thi = 8; W.rel0 = -8 * 64 + 575;
            }
            W.tab_off = 2048 + h * 640;
        } else {
            int b, kvh; const int g = w >> 1;
            if (ui < NU_BP + NU_BS + NU_AP) {
                const int u2 = ui - NU_BP - NU_BS; b = u2 >> 6; const int c_ = (u2 >> 1) & 31; kvh = u2 & 1; const int c0 = (c_ - 2) > 0 ? (c_ - 2) : 0;
                TL.nt = c_ - c0 + 1; TL.n0 = TL.nt;
                const size_t r0 = (size_t)b * SEQ + (size_t)c0 * 64;
                TL.k0 = QKV + r0 * EV_IN + 512 + kvh * 64; TL.v0 = QKV + r0 * EV_IN + 640 + kvh * 64; TL.kp0 = EV_IN; TL.vp0 = EV_IN;
                const size_t qr = (size_t)b * SEQ + (size_t)c_ * 64 + 32 * (w & 1);
                W.q = QKV + qr * EV_IN + (kvh * 4 + g) * 64; W.o = MIX + qr * DM + (kvh * 4 + g) * 64;
                W.tlo = 0; W.thi = TL.nt - 1; W.rel0 = (c0 - c_) * 64 + 191;
            } else {
                const int u2 = ui - NU_BP - NU_BS - NU_AP; b = u2 >> 1; kvh = u2 & 1;
                TL.nt = 3; TL.n0 = 2;
                TL.k0 = cak + (size_t)b * 128 * 128 + kvh * 64; TL.v0 = cav + (size_t)b * 128 * 128 + kvh * 64; TL.kp0 = 128; TL.vp0 = 128;
                const size_t r1 = (size_t)TP + (size_t)b * 64;
                TL.k1 = QKV + r1 * EV_IN + 512 + kvh * 64; TL.v1 = QKV + r1 * EV_IN + 640 + kvh * 64; TL.kp1 = EV_IN; TL.vp1 = EV_IN;
                const size_t qr = r1 + 32 * (w & 1);
                W.q = QKV + qr * EV_IN + (kvh * 4 + g) * 64; W.o = MIX + qr * DM + (kvh * 4 + g) * 64;
                W.tlo = 0; W.thi = 2; W.rel0 = -2 * 64 + 191;
            }
            W.tab_off = (kvh * 4 + g) * 256; W.has_sink = 1; W.m0 = sinks[kvh * 4 + g];
        }
        return true;
    }
};
__device__ __forceinline__ void attn_phase_l0(Frame& F, int att0_rep = 0) {
    LOCAL_IDS();
    const float* biasA = WSP(float, WS_TAB + TAB_BIASA); const float* biasB = WSP(float, WS_TAB + TAB_BIASB);
    LAS float* tab = (LAS float*)(F.lds + att::L_TAB);
    for (int i = tid; i < 2048; i += 512) tab[i] = biasA[i];
    for (int i = tid; i < 5120; i += 512) tab[2048 + i] = biasB[i];
    if (tid < 8) tab[7168 + tid] = F.in[21][tid] * LOG2E;
    __syncthreads();
    int c_ = (int)blockIdx.x, w_ = wave; asm volatile("" : "+s"(c_), "+s"(w_));
    SrcL0 S{WSP(bf16, WS_R + R_QKV), WSP(bf16, WS_R + R_CAK), WSP(bf16, WS_R + R_CAV), WSP(bf16, WS_R + R_CBK), WSP(bf16, WS_R + R_CBV), WSP(bf16, WS_R + R_MIX), (const LAS float*)tab + 7168, c_, F.G, w_, 15};
#if defined(ATT0_CLS)
    if (att0_rep) S.cls = ATT0_CLS;
#endif
    att::run<64, true, SrcL0>(F.lds, S, tid);
}

struct SrcL1 {
    const bf16 *QD, *KD, *VD, *KPE; bf16* MIX; int c, G, w;
    __device__ __forceinline__ bool get(int it, att::Tiles& TL, att::WaveCfg& W) const {
        const int upc = it >> 1, ui = c + upc * G; if (ui >= 256) return false;
        const int b = ui >> 5, h = (ui >> 2) & 7, p = ui & 3;
        const int cg = (it & 1) ? 7 - p : p; const int cw = 4 * cg + (w >> 1);
        TL.nt = 4 * cg + 4; TL.n0 = TL.nt; TL.k1 = nullptr; TL.v1 = nullptr; TL.pe1 = nullptr; TL.kp1 = 0; TL.vp1 = 0;
        const size_t r0 = (size_t)b * SEQ;
        TL.k0 = KD + r0 * 512 + h * 64; TL.v0 = VD + r0 * 512 + h * 64; TL.pe0 = KPE + r0 * 32; TL.kp0 = 512; TL.vp0 = 512;
        const size_t qr = r0 + (size_t)cw * 64 + 32 * (w & 1);
        W.q = QD + qr * 768 + h * 96; W.qpitch = 768; W.o = MIX + qr * DM + 512 + h * 64; W.opitch = DM;
        W.active = 1; W.tlo = 0; W.thi = cw; W.tab_off = 0; W.rel0 = 0; W.qrow0 = 0; W.m0 = -1e30f; W.has_sink = 0;
        return true;
    }
};
__device__ __forceinline__ void attn_phase_l1(Frame& F) {
    const bf16* QD = WSP(bf16, WS_R + R_QD); const bf16* KD = WSP(bf16, WS_R + R_KD); const bf16* VD = WSP(bf16, WS_R + R_VD); const bf16* KPE = WSP(bf16, WS_R + R_KPE);
    bf16* MIX = WSP(bf16, WS_R + R_MIX);
    LOCAL_IDS(); const int w = wave;
#if defined(REP_DP)
    for (int rep_ = 0; rep_ < REP_DP; ++rep_)
#endif
    { int c_ = (int)blockIdx.x, w_ = w; asm volatile("" : "+s"(c_), "+s"(w_));
      SrcL1 S{QD, KD, VD, KPE, MIX, c_, F.G, w_}; att::run<96, false, SrcL1>(F.lds, S, tid); }
#if defined(REP_SD)
    for (int rep_ = 0; rep_ < REP_SD; ++rep_)
#endif
    for (int ui = (int)blockIdx.x; ui < NB * 2 * NSPLIT; ui += F.G) {
        const int b = ui >> 5, hg = (ui >> 4) & 1, sp = ui & 15;
        att::sampled_unit(F.lds, b, hg, (sp * 65) >> 4, ((sp + 1) * 65) >> 4, F.in[7] + (size_t)b * PAST * 128, F.in[8] + (size_t)b * PAST * 32, WSP(bf16, WS_R + R_CKVS) + (size_t)b * 64 * 128,
#if defined(REP_SD) && defined(SDX)
                          KPE + (size_t)(TP + b * 64) * 32, WSP(bf16, WS_W + W_KVP), F.in[34], QD, rep_ == 0 ? WSP(float, WS_R + R_QA) : WSP(float, WS_R + R_PART), sp, wave, lane, tid, rep_ == 0 ? SDX : 0);
#else
                          KPE + (size_t)(TP + b * 64) * 32, WSP(bf16, WS_W + W_KVP), F.in[34], QD, WSP(float, WS_R + R_PART), sp, wave, lane, tid);
#endif
    }
}

__device__ __forceinline__ void combine_l1(Frame& F) {
    LOCAL_IDS();
    const int gw = (int)blockIdx.x * NWAVES + wave, NGW = F.G * NWAVES;
    const float* part = WSP(float, WS_R + R_PART); bf16* MIX = WSP(bf16, WS_R + R_MIX);
    for (int it = gw; it < NB * 8 * 64; it += NGW) {
        const int q = it & 63, bh = it >> 6, b = bh >> 3, head = bh & 7;
        const float* P = part + (size_t)bh * NSPLIT * (64 * 66);
        float ms[NSPLIT]; float M = -3e38f;
#pragma unroll
        for (int s = 0; s < NSPLIT; ++s) { ms[s] = P[(size_t)s * (64 * 66) + 4096 + q]; M = fmaxf(M, ms[s]); }
        float L = 0.f, O = 0.f;
#pragma unroll
        for (int s = 0; s < NSPLIT; ++s) { const float f = __builtin_amdgcn_exp2f(ms[s] - M); L += P[(size_t)s * (64 * 66) + 4160 + q] * f; O += P[(size_t)s * (64 * 66) + ((((q >> 5) * 8 + (lane >> 5) * 4 + ((lane >> 3) & 3)) * 64 + ((lane >> 2) & 1) * 32 + (q & 31)) * 4) + (lane & 3)] * f; }
        MIX[(size_t)(TP + b * 64 + q) * DM + 512 + head * 64 + lane] = (bf16)f2bf(O / L);
    }
}

__device__ __forceinline__ void side_l1(Frame& F) {
    LOCAL_IDS();
    const int gw = (int)blockIdx.x * NWAVES + wave, NGW = F.G * NWAVES;
    const bf16* KVA = WSP(bf16, WS_R + R_KVA); const float* rs = WSP(float, WS_ROWSQ + 7 * ROWSQ_STRIDE); const float* g = F.in[30];
    bf16* CKVS = WSP(bf16, WS_R + R_CKVS);
    const float g0_ = g[2 * lane], g1_ = g[2 * lane + 1];
    for (int c = gw; c < T / 8; c += NGW) {
        const int r0 = 8 * c;
        float rr[8]; unsigned pk[8];
#pragma unroll
        for (int i = 0; i < 8; ++i) { rr[i] = rs[r0 + i]; pk[i] = *(const GAS unsigned*)(KVA + (size_t)(r0 + i) * 256 + 2 * lane); }
#pragma unroll
        for (int i = 0; i < 8; ++i) {
            const int row = r0 + i;
            const float r = __builtin_amdgcn_rsqf(rr[i] * (1.0f / 128.0f) + EPS);
            const float a = __uint_as_float(pk[i] << 16) * r * g0_, b = __uint_as_float(pk[i] & 0xffff0000u) * r * g1_;
            float* dst = row < TP ? F.out + O_CKVP + (size_t)row * 128 : F.out + O_CKVS + (size_t)(row - TP) * 128;
            *(GAS f32x2v*)(dst + 2 * lane) = (f32x2v){a, b};
            if (row >= TP) *(GAS unsigned*)(CKVS + (size_t)(row - TP) * 128 + 2 * lane) = pk2(a, b);
        }
    }
    const bf16* U = WSP(bf16, WS_R + R_U); bf16* MIX = WSP(bf16, WS_R + R_MIX); const float* cw = F.in[27]; const float* st = F.in[6];
    float w0[8], w1[8], w2[8];
#pragma unroll
    for (int j = 0; j < 8; ++j) { w0[j] = cw[8 * lane + j]; w1[j] = cw[512 + 8 * lane + j]; w2[j] = cw[1024 + 8 * lane + j]; }
    for (int c = gw; c < T / 8; c += NGW) {
        const int r0 = 8 * c;
        int t0, b; const bool samp = r0 >= TP; if (!samp) { b = r0 >> 11; t0 = r0 & (SEQ - 1); } else { b = (r0 - TP) >> 6; t0 = (r0 - TP) & 63; }
        v4u ux[10], cbx[8];
#pragma unroll
        for (int i = 0; i < 8; ++i) { ux[2 + i] = *(const GAS v4u*)(U + (size_t)(r0 + i) * 512 + 8 * lane); cbx[i] = *(const GAS v4u*)(MIX + (size_t)(r0 + i) * DM + 8 * lane); }
        float h0[8], h1[8];
        if (t0 > 0) {
            ux[0] = *(const GAS v4u*)(U + (size_t)(r0 - 2) * 512 + 8 * lane); ux[1] = *(const GAS v4u*)(U + (size_t)(r0 - 1) * 512 + 8 * lane);
#pragma unroll
            for (int j = 0; j < 4; ++j) { h0[2 * j] = __uint_as_float(ux[0][j] << 16); h0[2 * j + 1] = __uint_as_float(ux[0][j] & 0xffff0000u); h1[2 * j] = __uint_as_float(ux[1][j] << 16); h1[2 * j + 1] = __uint_as_float(ux[1][j] & 0xffff0000u); }
        } else {
#pragma unroll
            for (int j = 0; j < 8; ++j) { h0[j] = samp ? st[(size_t)(b * 2 + 0) * 512 + 8 * lane + j] : 0.f; h1[j] = samp ? st[(size_t)(b * 2 + 1) * 512 + 8 * lane + j] : 0.f; }
        }
#pragma unroll
        for (int i = 0; i < 8; ++i) {
            float u2[8], cb[8];
#pragma unroll
            for (int j = 0; j < 4; ++j) { u2[2 * j] = __uint_as_float(ux[2 + i][j] << 16); u2[2 * j + 1] = __uint_as_float(ux[2 + i][j] & 0xffff0000u);
                                          cb[2 * j] = __uint_as_float(cbx[i][j] << 16); cb[2 * j + 1] = __uint_as_float(cbx[i][j] & 0xffff0000u); }
            v4u o;
#pragma unroll
            for (int j = 0; j < 4; ++j) { const float y0 = cb[2 * j] * (w0[2 * j] * h0[2 * j] + w1[2 * j] * h1[2 * j] + w2[2 * j] * u2[2 * j]);
                const float y1 = cb[2 * j + 1] * (w0[2 * j + 1] * h0[2 * j + 1] + w1[2 * j + 1] * h1[2 * j + 1] + w2[2 * j + 1] * u2[2 * j + 1]); o[j] = pk2(y0, y1); }
            *(GAS v4u*)(MIX + (size_t)(r0 + i) * DM + 8 * lane) = o;
#pragma unroll
            for (int j = 0; j < 8; ++j) { h0[j] = h1[j]; h1[j] = u2[j]; }
        }
    }
}


__device__ __forceinline__ void mini_resid(Frame& F, const bf16* A, const bf16* Bt, int K, float alpha, bool first, bool last, int rsi) {
    LOCAL_IDS();
    typedef float f32x16 __attribute__((ext_vector_type(16)));
    const int r32 = lane & 31, h = lane >> 5;
    float* const X = F.out; bf16* const XB = WSP(bf16, WS_XB); float* const rowsq = WSP(float, WS_ROWSQ + (size_t)rsi * ROWSQ_STRIDE);
    (void)first;
    LAS float* red = (LAS float*)(F.lds + RING_OFF);
    for (int mt = (int)blockIdx.x; mt < 256; mt += F.G) {
        const int rt = mt >> 4, ct = mt & 15;
        LAS unsigned char* const sA = F.lds + RING_OFF + wave * 13824; LAS unsigned char* const sB = sA + 32 * 144;
        const int crow = lane >> 3, cseg = lane & 7;
        const bf16* ag = A + (size_t)(32 * rt + crow) * K + 8 * cseg;
        const bf16* bg = Bt + (size_t)(64 * ct + crow) * K + 8 * cseg;
        const int ng = K >> 6, g0 = (ng * wave) >> 3, g1 = (ng * (wave + 1)) >> 3;
        f32x16 c0, c1;
#pragma unroll
        for (int r = 0; r < 16; ++r) { c0[r] = 0.f; c1[r] = 0.f; }
        v4u ra[4], rb[8];
#define MINI_LOAD(g_) do { _Pragma("unroll") for (int i = 0; i < 4; ++i) ra[i] = *(const GAS v4u*)(ag + (size_t)(8 * i) * K + 64 * (g_)); \
                           _Pragma("unroll") for (int i = 0; i < 8; ++i) rb[i] = *(const GAS v4u*)(bg + (size_t)(8 * i) * K + 64 * (g_)); } while (0)
#if defined(REP_MINI)
        for (int rep_ = 0; rep_ < REP_MINI; ++rep_) {
        if (rep_ > 0) { asm volatile("" : "+v"(c0), "+v"(c1));
#pragma unroll
            for (int r = 0; r < 16; ++r) { c0[r] = 0.f; c1[r] = 0.f; } }
#endif
        if (g0 < g1) MINI_LOAD(g0);
        for (int g = g0; g < g1; ++g) {
#pragma unroll
            for (int i = 0; i < 4; ++i) *(LAS v4u*)(sA + (crow + 8 * i) * 144 + 16 * cseg) = ra[i];
#pragma unroll
            for (int i = 0; i < 8; ++i) *(LAS v4u*)(sB + (crow + 8 * i) * 144 + 16 * cseg) = rb[i];
            if (g + 1 < g1) MINI_LOAD(g + 1);
            bf16x8 a[4], x[4], y[4];
#pragma unroll
            for (int ks = 0; ks < 4; ++ks) { a[ks] = *(const LAS bf16x8*)(sA + r32 * 144 + 32 * ks + 16 * h); x[ks] = *(const LAS bf16x8*)(sB + r32 * 144 + 32 * ks + 16 * h); y[ks] = *(const LAS bf16x8*)(sB + (32 + r32) * 144 + 32 * ks + 16 * h); }
#pragma unroll
            for (int ks = 0; ks < 4; ++ks) { c0 = __builtin_amdgcn_mfma_f32_32x32x16_bf16(a[ks], x[ks], c0, 0, 0, 0); c1 = __builtin_amdgcn_mfma_f32_32x32x16_bf16(a[ks], y[ks], c1, 0, 0, 0); }
        }
#if defined(REP_MINI)
        }
#endif
#undef MINI_LOAD
        __syncthreads();
#pragma unroll
        for (int r = 0; r < 16; ++r) { const int i = (r & 3) + 8 * (r >> 2) + 4 * h; red[wave * 2048 + i * 64 + r32] = c0[r]; red[wave * 2048 + i * 64 + 32 + r32] = c1[r]; }
        __syncthreads();
        {
            const int i = tid >> 4, j4 = 4 * (tid & 15);
            f32x4 v = (f32x4){0.f, 0.f, 0.f, 0.f};
#pragma unroll
            for (int w = 0; w < 8; ++w) v += *(const LAS f32x4*)(red + w * 2048 + i * 64 + j4);
            const int a8 = (j4 & 31) >> 2; const int col = 64 * ct + (j4 & 32) + 8 * (a8 & 3) + 4 * (a8 >> 2);
            const int srow = 32 * rt + i; const size_t row = (size_t)TP + srow;
            const u32x2t xo2 = *(const GAS u32x2t*)(XB + row * DM + col);
            const f32x4 xo = (f32x4){__uint_as_float(xo2.x << 16), __uint_as_float(xo2.x & 0xffff0000u), __uint_as_float(xo2.y << 16), __uint_as_float(xo2.y & 0xffff0000u)};
            const f32x4 xn = xo + v * alpha;
            if (last) *(GAS f32x4*)(X + row * DM + col) = xn;
            else {
                *(GAS u32x2t*)(XB + row * DM + col) = (u32x2t){pk2(xn.x, xn.y), pk2(xn.z, xn.w)};
                float ss = (xn.x * xn.x + xn.y * xn.y) + (xn.z * xn.z + xn.w * xn.w);
                ss += __shfl_xor(ss, 1); ss += __shfl_xor(ss, 2); ss += __shfl_xor(ss, 4); ss += __shfl_xor(ss, 8);
                if ((tid & 15) == 0) atomicAdd(rowsq + row, ss);
            }
        }
        __syncthreads();
    }
}

struct Args { const float* in[36]; float* out; unsigned char* ws; int ph_lo, ph_hi; };
constexpr int NPHASE = 17;
__global__ void __launch_bounds__(NWAVES * 64, 2) enc_fwd(Args args) {
    extern __shared__ __attribute__((aligned(16))) unsigned char lds[];
    Frame F;
    F.lds = (LAS unsigned char*)lds;
    F.MISC = (volatile LAS unsigned*)(F.lds + MISC_OFF);
    F.wave_s = __builtin_amdgcn_readfirstlane((int)threadIdx.x >> 6);
    F.G = gridDim.x; { const int bx = blockIdx.x; F.vcu = (F.G % 8 == 0) ? (bx % 8) * (F.G / 8) + bx / 8 : bx; }
    F.in = args.in; F.out = args.out; F.ws = args.ws; F.ctl = (gu32*)(args.ws + WS_CTL);
    for (int u = threadIdx.x; u < (LDS_BYTES - LDSCTL_OFF) / 4; u += NWAVES * 64) ((LAS unsigned*)(F.lds + LDSCTL_OFF))[u] = 0u;
    __syncthreads();
    const int lo = args.ph_lo, hi = args.ph_hi;
    const bool use_bar = (hi - lo) > 1;
    XcdBarrier bar; bar.bar = (unsigned*)(F.ctl + CW_BAR); bar.x = 0; bar.st = nullptr;
    if (use_bar) bar = xcd_barrier_post((unsigned*)(F.ctl + CW_BAR), F.MISC + 8);
    bar.w0 = (F.wave_s == 0) ? 1u : 0u;
#if defined(REPEAT_MASK)
    int rep_done = 0;
#endif
#pragma unroll 1
    for (int ph = lo; ph < hi; ++ph) {
        int z = 0; asm volatile("" : "+s"(z));
        F.in = args.in + z; F.out = args.out + z; F.ws = args.ws + z;
        bf16* XB = WSP(bf16, WS_XB); bf16* H = WSP(bf16, WS_R + R_H); bf16* MIX = WSP(bf16, WS_R + R_MIX);
        (void)XB;
        int kind, l = 0, f = 0;
        switch (ph) {
            case 0: kind = 0; break;
            case 1: kind = 1; l = 0; f = 0; break;   case 2: kind = 2; l = 0; f = 0; break;
            case 3: kind = 3; break;                 case 4: kind = 4; break;                 case 5: kind = 5; l = 0; break;
            case 6: kind = 1; l = 0; f = 1; break;   case 7: kind = 2; l = 0; f = 1; break;
            case 8: kind = 1; l = 1; f = 0; break;   case 9: kind = 2; l = 1; f = 0; break;
            case 10: kind = 6; break;                case 11: kind = 7; break;                case 12: kind = 8; break;   case 13: kind = 9; break;   case 14: kind = 5; l = 1; break;
            case 15: kind = 1; l = 1; f = 1; break;  default: kind = 2; l = 1; f = 1; break;
        }
        if (kind == 0) { p0_prologue(F); }
        else if (kind == 1) {
            pg8::Gemm g{XB, WSP(bf16, WS_W + W_GU0 + (size_t)(l * 2 + f) * W_GU_BYTES), T, NGU, DM}; pg8::StaticOrder S; S.init(T, NGU, F.G, (int)blockIdx.x);
#if defined(REPEAT_NULL)
            if (rep_done) { ep::EpiNull E0; pg8::gemm_phase<ep::EpiNull, pg8::StaticOrder, true, true>(F.lds + RING_OFF, g, S, E0, F.wave_s); } else
#endif
            { ep::EpiGU E{ep::Ctx{F.ws, F.out, F.in}, 3 * l + 2 * f};
            pg8::gemm_phase<ep::EpiGU, pg8::StaticOrder, true, true>(F.lds + RING_OFF, g, S, E, F.wave_s); }
            if (F.G == 256) { if (ph == 1) wconv_set(F, WSET_PH1, 172, 84); else if (ph == 6) wconv_set(F, WSET_PH6, 172, 84); }
            else { if (ph == 1) wconv_set(F, WSET_PH1, 0, F.G); else if (ph == 6) wconv_set(F, WSET_PH6, 0, F.G); }
        } else if (kind == 2 || kind == 5) {
            const bool isout = kind == 5; const bool first = (!isout && l == 0 && f == 0), last = (!isout && l == 1 && f == 1);
            pg8::Gemm g; g.A = isout ? MIX : H; g.Bt = isout ? WSP(bf16, WS_W + (l ? W_ODOUT : W_EVOUT)) : WSP(bf16, WS_W + W_D0 + (size_t)(l * 2 + f) * W_D_BYTES); g.M = TP; g.N = DM; g.K = isout ? DM : FF;
            pg8::StaticOrder S; S.init(TP, DM, F.G, (int)blockIdx.x);
            int rsi = isout ? 3 * l + 2 : (f == 0 ? 3 * l + 1 : 3 * (l + 1));
#if defined(REPEAT_MASK)
            if (rep_done) rsi = 8;
#endif
            ep::EpiResid E; E.C = ep::Ctx{F.ws, F.out, F.in}; E.last = last; E.rsi = rsi; E.alpha = isout ? 1.0f : 0.5f; (void)first;
            pg8::gemm_phase<ep::EpiResid, pg8::StaticOrder, true, true>(F.lds + RING_OFF, g, S, E, F.wave_s);
            mini_resid(F, g.A + (size_t)TP * g.K, g.Bt, g.K, E.alpha, first, last, rsi);
        } else if (kind == 3) {
            pg8::Gemm g{XB, WSP(bf16, WS_W + W_EVIN), T, EV_IN, DM}; pg8::StaticOrder S; S.init(T, EV_IN, F.G, (int)blockIdx.x);
            ep::EpiEvIn E{ep::Ctx{F.ws, F.out, F.in}};
            pg8::gemm_phase<ep::EpiEvIn, pg8::StaticOrder, true, true>(F.lds + RING_OFF, g, S, E, F.wave_s);
            if (F.G == 256) { wconv_set(F, WSET_PH3, 82, 174); p0_aux(F, 82, 174); } else { wconv_set(F, WSET_PH3, 0, F.G); p0_aux(F, 0, F.G); }
#if defined(REPEAT_MASK)
        } else if (kind == 4) { attn_phase_l0(F, rep_done); }
#else
        } else if (kind == 4) { attn_phase_l0(F); }
#endif
        else if (kind == 6) {
            pg8::Gemm g{XB, WSP(bf16, WS_W + W_ODIN), T, OD_INP, DM}; pg8::StaticOrder S; S.init(T, OD_INP, F.G, (int)blockIdx.x);
            ep::EpiOdIn E{ep::Ctx{F.ws, F.out, F.in}};
            pg8::gemm_phase<ep::EpiOdIn, pg8::StaticOrder, true, true>(F.lds + RING_OFF, g, S, E, F.wave_s);
        } else if (kind == 7) {
            side_l1(F);
            { pg8::Gemm g{WSP(bf16, WS_R + R_QA), WSP(bf16, WS_W + W_QB), T, 768, 256}; pg8::StaticOrder S; S.init(T, 768, F.G, (int)blockIdx.x);
              ep::EpiQb E{ep::Ctx{F.ws, F.out, F.in}};
              pg8::gemm_phase<ep::EpiQb, pg8::StaticOrder, true, true>(F.lds + RING_OFF, g, S, E, F.wave_s); }
            { pg8::Gemm g{WSP(bf16, WS_R + R_KVA), WSP(bf16, WS_W + W_KVB), TP, 1024, 256}; pg8::StaticOrder S; S.init(TP, 1024, F.G, (int)blockIdx.x);
              ep::EpiKvb E{ep::Ctx{F.ws, F.out, F.in}};
              pg8::gemm_phase<ep::EpiKvb, pg8::StaticOrder, true, true>(F.lds + RING_OFF, g, S, E, F.wave_s); }
        } else if (kind == 8) { attn_phase_l1(F); }
        else { combine_l1(F); }
#if defined(REPEAT_MASK)
        if (((REPEAT_MASK >> ph) & 1) && !rep_done) { rep_done = 1; xcd_barrier(bar); --ph; continue; }
        rep_done = 0;
#endif
        if (ph + 1 < hi) xcd_barrier(bar);
    }
}

#ifndef MK_MULTI
#define MK_MULTI 0
#endif
extern "C" void kernel_launch(void* const* d_in, const int* in_sizes, int n_in, void* d_out, int out_size, void* d_ws, size_t ws_size, hipStream_t stream) {
    static int grid = 0;
    if (grid == 0) {
        if (n_in != 36 || (size_t)out_size != O_END || ws_size < WS_END) { fprintf(stderr, "kernel_launch: unexpected shapes: n_in %d out %d ws %zu (need %zu)\n", n_in, out_size, ws_size, (size_t)WS_END); grid = -1; return; }
        int dev = 0, cus = 0;
        if (hipGetDevice(&dev) != hipSuccess || hipDeviceGetAttribute(&cus, hipDeviceAttributeMultiprocessorCount, dev) != hipSuccess) { grid = -1; return; }
        if (hipFuncSetAttribute((const void*)enc_fwd, hipFuncAttributeMaxDynamicSharedMemorySize, LDS_BYTES) != hipSuccess) { grid = -1; return; }
        grid = cus;
    }
    if (grid < 0) return;
    if (hipMemsetAsync((char*)d_ws + WS_CTL, 0, CTL_ZERO_BYTES, stream) != hipSuccess) return;
    Args a{};
    for (int i = 0; i < 36; ++i) a.in[i] = (const float*)d_in[i];
    a.out = (float*)d_out; a.ws = (unsigned char*)d_ws;
#if MK_MULTI
    for (int p = 0; p < NPHASE; ++p) { a.ph_lo = p; a.ph_hi = p + 1; hipLaunchKernelGGL(enc_fwd, dim3(grid), dim3(NWAVES * 64), LDS_BYTES, stream, a); }
#else
    a.ph_lo = 0; a.ph_hi = NPHASE;
    { void* kargs[] = {(void*)&a};
      if (hipLaunchCooperativeKernel((const void*)enc_fwd, dim3(grid), dim3(NWAVES * 64), kargs, LDS_BYTES, stream) != hipSuccess) fprintf(stderr, "kernel_launch: cooperative launch failed (grid %d)\n", grid); }
#endif
}
```

```cpp
#include <hip/hip_runtime.h>
#include <cstdio>
#include <cstdint>
#define GAS __attribute__((address_space(1)))
#define LAS __attribute__((address_space(3)))
typedef unsigned short bf16;
typedef unsigned v4u __attribute__((ext_vector_type(4)));
typedef float f32x4 __attribute__((ext_vector_type(4)));
typedef short bf16x8 __attribute__((ext_vector_type(8)));
typedef GAS unsigned gu32;
typedef GAS unsigned long long gu64;
#define RLX_AGENT __ATOMIC_RELAXED, __HIP_MEMORY_SCOPE_AGENT
#define LDS_WAIT() asm volatile("s_waitcnt lgkmcnt(0)" ::: "memory")
#define VM_WAIT() asm volatile("s_waitcnt vmcnt(0)" ::: "memory")
__device__ __forceinline__ unsigned long long rt() { return __builtin_amdgcn_s_memrealtime(); }
__device__ __forceinline__ unsigned f2bf(float f) { unsigned u = __builtin_bit_cast(unsigned, f); return (u + 0x7fffu + ((u >> 16) & 1u)) >> 16; }
__device__ __forceinline__ unsigned pk2(float lo, float hi) { return f2bf(lo) | (f2bf(hi) << 16); }
typedef float f32x2v __attribute__((ext_vector_type(2)));
#define XB_TMO      128
#define XB_XCNT(j)  (256  + 64 * (j))
#define XB_XSUB(j)  (1280 + 64 * (j))
#define XB_XGEN(j)  (2304 + 64 * (j))
#define XB_TOP      3328
#define XB_TOPGEN   3392
#define XCD_BAR_WORDS 3456
#define XB_SPIN_CAP (1u << 18)

__device__ __forceinline__ unsigned xb_ld(unsigned* p)              { return __hip_atomic_load(p, __ATOMIC_RELAXED, __HIP_MEMORY_SCOPE_AGENT); }
__device__ __forceinline__ unsigned xb_add(unsigned* p, unsigned v) { return __hip_atomic_fetch_add(p, v, __ATOMIC_RELAXED, __HIP_MEMORY_SCOPE_AGENT); }
__device__ __forceinline__ unsigned xb_xcc_id() { return (unsigned)__builtin_amdgcn_s_getreg((3 << 11) | 20) & 0xFu; }
#define XB_SPIN(cond, bar) do { unsigned _sp = 0; while (cond) { __builtin_amdgcn_s_sleep(1); \
    if ((++_sp & 255u) == 0u) { if (xb_ld(&(bar)[XB_TMO])) break; if (_sp > XB_SPIN_CAP) { atomicAdd(&(bar)[XB_TMO], 1u); break; } } } } while (0)

struct XcdBarrier {
    unsigned* bar; unsigned x; unsigned w0;
    volatile LAS unsigned* st;
};

__device__ __forceinline__ XcdBarrier xcd_barrier_post(unsigned* bar, volatile LAS unsigned* st) {
    XcdBarrier b; b.bar = bar; b.x = xb_xcc_id(); b.st = st;
    if (threadIdx.x == 0) (void)xb_add(&bar[XB_XCNT(b.x)], 1u);
    return b;
}
__device__ __forceinline__ void xcd_barrier_complete(unsigned* bar, unsigned x, unsigned& nloc, unsigned& nx) {
    const unsigned G = gridDim.x * gridDim.y * gridDim.z;
    unsigned sum, cnt, mine, sp = 0u;
    for (;;) {
        sum = 0u; cnt = 0u; mine = 0u;
#pragma unroll
        for (unsigned j = 0; j < 16; ++j) { const unsigned c = xb_ld(&bar[XB_XCNT(j)]); sum += c; cnt += (c > 0u) ? 1u : 0u; mine = (j == x) ? c : mine; }
        if (sum == G) break;
        __builtin_amdgcn_s_sleep(1);
        if ((++sp & 255u) == 0u) { if (xb_ld(&bar[XB_TMO])) break; if (sp > XB_SPIN_CAP) { atomicAdd(&bar[XB_TMO], 1u); break; } }
    }
    nloc = mine > 0u ? mine : 1u; nx = cnt > 0u ? cnt : 1u;
}

__device__ __forceinline__ void xcd_barrier(const XcdBarrier& b) {
    asm volatile("s_waitcnt vmcnt(0)" ::: "memory");
    __syncthreads();
    if (b.w0 && __builtin_amdgcn_mbcnt_hi(~0u, __builtin_amdgcn_mbcnt_lo(~0u, 0u)) == 0u) {
        unsigned* bar = b.bar;
        __builtin_amdgcn_s_waitcnt(0);
        unsigned nloc = b.st[0], nx = b.st[1];
        if (nloc == 0u) { xcd_barrier_complete(bar, b.x, nloc, nx); b.st[0] = nloc; b.st[1] = nx; }
        const unsigned old = xb_add(&bar[XB_XSUB(b.x)], 1u);
        const unsigned gen = old / nloc;
        if (old + 1u == (gen + 1u) * nloc) {
            __builtin_amdgcn_fence(__ATOMIC_RELEASE, "agent");
            asm volatile("s_waitcnt vmcnt(0)" ::: "memory");
            const unsigned og = xb_add(&bar[XB_TOP], 1u);
            const unsigned tg = og / nx;
            if (og + 1u == (tg + 1u) * nx) xb_add(&bar[XB_TOPGEN], 1u);
            else XB_SPIN(xb_ld(&bar[XB_TOPGEN]) == tg, bar);
            __builtin_amdgcn_fence(__ATOMIC_ACQUIRE, "agent");
            xb_add(&bar[XB_XGEN(b.x)], 1u);
            asm volatile("s_waitcnt vmcnt(0)" ::: "memory");
        } else {
            XB_SPIN(xb_ld(&bar[XB_XGEN(b.x)]) == gen, bar);
            __builtin_amdgcn_fence(__ATOMIC_ACQUIRE, "agent");
            asm volatile("s_waitcnt vmcnt(0)" ::: "memory");
        }
    }
    __syncthreads();
}
namespace pg8 {
#define PG8_LAS __attribute__((address_space(3)))
typedef unsigned short bf16_t;
typedef short bf16x8 __attribute__((ext_vector_type(8)));
typedef float f32x4 __attribute__((ext_vector_type(4)));
typedef unsigned u32x4 __attribute__((ext_vector_type(4)));
constexpr int BM = 256, BK = 64, HALF = 128, HTB = HALF * BK * 2  , STAGE_BYTES = 8 * HTB, NXCD = 8, WGM = 8;

__host__ __device__ __forceinline__ int lds_byte(int r, int c) { const int st = (r >> 4) * 2 + (c >> 5), rr = r & 15, cc = c & 31, ob = rr * 64 + cc * 2; return st * 1024 + (ob ^ (((ob >> 9) & 1) << 5)); }
__host__ __device__ __forceinline__ void stage_rc(int b, int& R, int& C) { const int st = b / 1024, sb = b % 1024, swz = sb ^ (((sb >> 9) & 1) << 5); R = (st >> 1) * 16 + swz / 64; C = (st & 1) * 32 + (swz % 64) / 2; }
__host__ __device__ __forceinline__ int perm32(int rho) { const int n = rho >> 4, i = rho & 15; return 8 * (i >> 2) + 4 * n + (i & 3); }

struct Unit { int pm, pn; };
struct Gemm { const bf16_t* A; const bf16_t* Bt; int M, N, K; };

struct StaticOrder {
    int nM, nN, nwg, G, c;
    __host__ __device__ void init(int M, int N, int G_, int c_) { nM = M / BM; nN = N / BM; nwg = nM * nN; G = G_; c = c_; }
    __host__ __device__ bool next(int i, Unit& u) const {
        const long L = (long)i * G + c; if (L >= nwg) return false;
        int wgid = (int)L; { const int q = nwg / NXCD, r = nwg % NXCD, xcd = wgid % NXCD, off = wgid / NXCD; wgid = (xcd < r ? xcd * (q + 1) : r * (q + 1) + (xcd - r) * q) + off; }
        const int nig = WGM * nN, gid = wgid / nig, fm = gid * WGM, gsz = (nM - fm) < WGM ? (nM - fm) : WGM;
        u.pm = fm + ((wgid % nig) % gsz); u.pn = (wgid % nig) / gsz; return true;
    }
    __device__ __forceinline__ void a_ready(const Unit&) const {}
    __device__ __forceinline__ void done(const Unit&) const {}
};

__device__ __forceinline__ unsigned cvt_pk_bf16(float lo, float hi) { unsigned r; asm volatile("v_cvt_pk_bf16_f32 %0, %1, %2" : "=v"(r) : "v"(lo), "v"(hi)); return r; }
typedef float f32x2 __attribute__((ext_vector_type(2)));
template <class Epi, class Sched, bool ALIGN_EPI = false, bool SP2 = false>
__device__ __forceinline__ void gemm_phase(PG8_LAS unsigned char* lds, const Gemm g, const Sched& S, const Epi& E, const int wid  ) {
    int lane_; asm volatile("v_mbcnt_lo_u32_b32 %0, -1, 0\n\tv_mbcnt_hi_u32_b32 %0, -1, %0" : "=v"(lane_));
    const int lane = lane_, tid = wid * 64 + lane, wr = wid >> 2, wc = wid & 3, fr = lane & 15, fq = lane >> 4;
    int K_ = g.K; asm volatile("" : "+s"(K_));
    const int K = K_, nt = K / BK;
    unsigned voffA[2], voffB[2];
#pragma unroll
    for (int i = 0; i < 2; ++i) { int R, C; stage_rc(tid * 16 + i * 8192, R, C); const int Rb = Epi::PERM ? ((R & ~31) + perm32(R & 31)) : R;
        voffA[i] = (unsigned)(R * K + C) * 2u; voffB[i] = (unsigned)(Rb * K + C) * 2u; }
    const size_t kstep = (size_t)(BK * 2);
    const size_t hstep = (size_t)HALF * K * 2;
    const size_t tstep = 2 * hstep;
    const unsigned ldsw = (unsigned)wid * 1024u;
    const int aoff = lds_byte(wr * 64 + fr, fq * 8), boff = lds_byte(wc * 32 + fr, fq * 8);
#define PG8_SA(b, h) (((b) * 2 + (h)) * HTB)
#define PG8_SB(b, h) ((4 + (b) * 2 + (h)) * HTB)
#define PG8_STAGE(bufoff, gbase, voff) do { _Pragma("unroll") for (int _i = 0; _i < 2; ++_i) \
        __builtin_amdgcn_global_load_lds((const unsigned*)((const char*)(gbase) + (voff)[_i]), (PG8_LAS unsigned*)(lds + (bufoff) + ldsw + _i * 8192), 16, 0, 0); } while (0)
#define PG8_LDA(dst, b, h) do { _Pragma("unroll") for (int m = 0; m < 4; ++m) _Pragma("unroll") for (int k = 0; k < 2; ++k) dst[m][k] = *(const PG8_LAS bf16x8*)(lds + PG8_SA(b, h) + aoff + m * 2048 + k * 1024); } while (0)
#define PG8_LDB(dst, b, h) do { _Pragma("unroll") for (int n = 0; n < 2; ++n) _Pragma("unroll") for (int k = 0; k < 2; ++k) dst[n][k] = *(const PG8_LAS bf16x8*)(lds + PG8_SB(b, h) + boff + n * 2048 + k * 1024); } while (0)
#define PG8_MMA(ai, bj, At, Bt) do { __builtin_amdgcn_s_setprio(1); _Pragma("unroll") for (int m = 0; m < 4; ++m) _Pragma("unroll") for (int n = 0; n < 2; ++n) _Pragma("unroll") for (int k = 0; k < 2; ++k) \
        acc[ai][bj][m][n] = __builtin_amdgcn_mfma_f32_16x16x32_bf16(Bt[n][k], At[m][k], acc[ai][bj][m][n], 0, 0, 0); __builtin_amdgcn_s_setprio(0); } while (0)
#define PG8_WAIT_V(n) asm volatile("s_waitcnt vmcnt(" #n ")" ::: "memory")
#define PG8_WAIT_L(n) asm volatile("s_waitcnt lgkmcnt(" #n ")" ::: "memory")
#define PG8_BAR __builtin_amdgcn_s_barrier()
#define PG8_SCHED __builtin_amdgcn_sched_barrier(0)
    Unit cur, nxt; int ui = 0;
    if (!S.next(0, cur)) return;
    f32x4 acc[2][2][4][2];
#pragma unroll
    for (int a = 0; a < 2; ++a)
#pragma unroll
        for (int b = 0; b < 2; ++b)
#pragma unroll
            for (int m = 0; m < 4; ++m)
#pragma unroll
                for (int n = 0; n < 2; ++n) acc[a][b][m][n] = (f32x4){0.f, 0.f, 0.f, 0.f};
    bf16x8 At[4][2], B0[2][2], B1[2][2];
    float rfpre[8];
#pragma unroll
    for (int g_ = 0; g_ < 8; ++g_) rfpre[g_] = 0.f;
    const char* cA = (const char*)g.A + (size_t)cur.pm * tstep; const char* cB = (const char*)g.Bt + (size_t)cur.pn * tstep;
    S.a_ready(cur);
    if constexpr (SP2) {
        PG8_STAGE(PG8_SB(0, 0), cB, voffB); PG8_STAGE(PG8_SB(0, 1), cB + hstep, voffB); PG8_STAGE(PG8_SA(0, 0), cA, voffA); PG8_STAGE(PG8_SA(0, 1), cA + hstep, voffA);
        if (wr == 1) PG8_BAR;
        PG8_WAIT_V(2); PG8_BAR;
        PG8_STAGE(PG8_SB(1, 0), cB + kstep, voffB); PG8_STAGE(PG8_SA(1, 0), cA + kstep, voffA); PG8_STAGE(PG8_SB(1, 1), cB + hstep + kstep, voffB);
        PG8_WAIT_V(6); PG8_BAR;
    } else {
        PG8_STAGE(PG8_SB(0, 0), cB, voffB); PG8_STAGE(PG8_SA(0, 0), cA, voffA); PG8_STAGE(PG8_SB(0, 1), cB + hstep, voffB); PG8_STAGE(PG8_SA(0, 1), cA + hstep, voffA);
        if (wr == 1) PG8_BAR;
        PG8_WAIT_V(4); PG8_BAR;
        PG8_STAGE(PG8_SB(1, 0), cB + kstep, voffB); PG8_STAGE(PG8_SA(1, 0), cA + kstep, voffA); PG8_STAGE(PG8_SB(1, 1), cB + hstep + kstep, voffB);
        PG8_WAIT_V(6); PG8_BAR;
    }
    for (;;) {
        const bool has_next = S.next(ui + 1, nxt);
        const char* nA = has_next ? (const char*)g.A + (size_t)nxt.pm * tstep : cA; const char* nB = has_next ? (const char*)g.Bt + (size_t)nxt.pn * tstep : cB;
        for (int t = 0; t < nt; t += 2) {
            const bool last = (t == nt - 2);
            if (last) E.prefetch(rfpre, cur, wr);
            const char* a1 = cA + (size_t)(t + 1) * kstep;
            const char* a2 = last ? nA : cA + (size_t)(t + 2) * kstep; const char* b2 = last ? nB : cB + (size_t)(t + 2) * kstep;
            const char* a3 = a2 + kstep; const char* b3 = b2 + kstep;
            if (last && has_next) S.a_ready(nxt);
            if constexpr (SP2) {
            PG8_LDB(B0, 0, 0); PG8_LDB(B1, 0, 1); PG8_SCHED; PG8_LDA(At, 0, 0); PG8_STAGE(PG8_SA(1, 1), a1 + hstep, voffA);
            if (Epi::NPRE && last) PG8_WAIT_V(16); else PG8_WAIT_V(8);
            PG8_WAIT_L(0); PG8_BAR; PG8_MMA(0, 0, At, B0); PG8_MMA(0, 1, At, B1); PG8_BAR; PG8_SCHED;
            PG8_LDA(At, 0, 1); PG8_STAGE(PG8_SB(0, 0), b2, voffB); PG8_STAGE(PG8_SB(0, 1), b2 + hstep, voffB); PG8_STAGE(PG8_SA(0, 0), a2, voffA);
            if (Epi::NPRE && last) PG8_WAIT_V(16); else PG8_WAIT_V(8);
            PG8_WAIT_L(0); PG8_BAR; PG8_MMA(1, 0, At, B0); PG8_MMA(1, 1, At, B1); PG8_BAR; PG8_SCHED;
            PG8_LDB(B0, 1, 0); PG8_LDB(B1, 1, 1); PG8_SCHED; PG8_LDA(At, 1, 0); PG8_STAGE(PG8_SA(0, 1), a2 + hstep, voffA);
            PG8_WAIT_V(8); PG8_WAIT_L(0); PG8_BAR; PG8_MMA(0, 0, At, B0); PG8_MMA(0, 1, At, B1); PG8_BAR; PG8_SCHED;
            PG8_LDA(At, 1, 1); PG8_STAGE(PG8_SB(1, 0), b3, voffB); PG8_STAGE(PG8_SB(1, 1), b3 + hstep, voffB); PG8_STAGE(PG8_SA(1, 0), a3, voffA);
            PG8_WAIT_V(8); PG8_WAIT_L(0); PG8_BAR; PG8_MMA(1, 0, At, B0); PG8_MMA(1, 1, At, B1); PG8_BAR; PG8_SCHED;
            } else {
            PG8_LDB(B0, 0, 0); PG8_SCHED; PG8_LDA(At, 0, 0); PG8_STAGE(PG8_SA(1, 1), a1 + hstep, voffA);
            PG8_WAIT_L(8); PG8_BAR; PG8_WAIT_L(0); PG8_MMA(0, 0, At, B0); PG8_BAR; PG8_SCHED;
            PG8_LDB(B1, 0, 1); PG8_STAGE(PG8_SB(0, 0), b2, voffB);
            PG8_BAR; PG8_WAIT_L(0); PG8_MMA(0, 1, At, B1); PG8_BAR;
            PG8_LDA(At, 0, 1); PG8_STAGE(PG8_SA(0, 0), a2, voffA);
            PG8_BAR; PG8_WAIT_L(0); PG8_MMA(1, 0, At, B0); PG8_BAR; PG8_SCHED;
            PG8_STAGE(PG8_SB(0, 1), b2 + hstep, voffB);
            PG8_WAIT_V(6); PG8_BAR; PG8_MMA(1, 1, At, B1); PG8_BAR;
            PG8_LDB(B0, 1, 0); PG8_SCHED; PG8_LDA(At, 1, 0); PG8_STAGE(PG8_SA(0, 1), a2 + hstep, voffA);
            PG8_WAIT_L(8); PG8_BAR; PG8_WAIT_L(0); PG8_MMA(0, 0, At, B0); PG8_BAR; PG8_SCHED;
            PG8_LDB(B1, 1, 1); PG8_STAGE(PG8_SB(1, 0), b3, voffB);
            PG8_BAR; PG8_WAIT_L(0); PG8_MMA(0, 1, At, B1); PG8_BAR;
            PG8_LDA(At, 1, 1); PG8_STAGE(PG8_SA(1, 0), a3, voffA);
            PG8_BAR; PG8_WAIT_L(0); PG8_MMA(1, 0, At, B0); PG8_BAR; PG8_SCHED;
            PG8_STAGE(PG8_SB(1, 1), b3 + hstep, voffB);
            PG8_WAIT_V(6); PG8_BAR; PG8_MMA(1, 1, At, B1); PG8_BAR;
            }
        }
        if constexpr (ALIGN_EPI) { if (wr == 0) PG8_BAR; }
        if constexpr (!Epi::AFTER_DRAIN) { E(acc, cur, wr, wc, fr, fq, rfpre); S.done(cur); }
        if (!has_next) break;
#pragma unroll
        for (int a = 0; a < 2; ++a)
#pragma unroll
            for (int b = 0; b < 2; ++b)
#pragma unroll
                for (int m = 0; m < 4; ++m)
#pragma unroll
                    for (int n = 0; n < 2; ++n) acc[a][b][m][n] = (f32x4){0.f, 0.f, 0.f, 0.f};
        cur = nxt; cA = nA; cB = nB; ++ui;
        if constexpr (ALIGN_EPI) { if (wr == 1) PG8_BAR; }
    }
    PG8_WAIT_V(0);
    if constexpr (!ALIGN_EPI) { if (wr == 0) PG8_BAR; }
    PG8_BAR;
    if constexpr (Epi::AFTER_DRAIN) { E.fused(acc, cur, wr, wc, fr, fq, lds, wid, lane); S.done(cur); }
#undef PG8_SA
#undef PG8_SB
#undef PG8_STAGE
#undef PG8_LDA
#undef PG8_LDB
#undef PG8_MMA
#undef PG8_WAIT_V
#undef PG8_WAIT_L
#undef PG8_BAR
#undef PG8_SCHED
}
}

constexpr int DM = 1024, NB = 8, SEQ = 2048, TP = NB * SEQ, DSEQ = 64, TS = NB * DSEQ, T = TP + TS, PAST = 4096;
constexpr int FF = 2816, NGU = 2 * FF;
constexpr int EV_IN = 2304, OD_IN = 1952, OD_INP = 2048;
constexpr float EPS = 1e-6f;
constexpr float LOG2E = 1.4426950408889634f;
constexpr float QS64 = 0.125f * LOG2E;
constexpr float QS96 = 0.10206207261596575f * LOG2E;

constexpr size_t O_Y = 0;
constexpr size_t O_AKP = (size_t)T * DM;
constexpr size_t O_AVP = O_AKP + 131072;
constexpr size_t O_BKP = O_AVP + 131072;
constexpr size_t O_BVP = O_BKP + 2097152;
constexpr size_t O_CP = O_BVP + 2097152;
constexpr size_t O_CKVP = O_CP + 8192;
constexpr size_t O_KPEP = O_CKVP + 2097152;
constexpr size_t O_AKS = O_KPEP + 524288;
constexpr size_t O_AVS = O_AKS + 131072;
constexpr size_t O_BKS = O_AVS + 131072;
constexpr size_t O_BVS = O_BKS + 2097152;
constexpr size_t O_CS = O_BVS + 2097152;
constexpr size_t O_CKVS = O_CS + 8192;
constexpr size_t O_KPES = O_CKVS + 65536;
constexpr size_t O_END = O_KPES + 16384;

constexpr size_t MiB = 1u << 20;
constexpr size_t WS_CTL = 0, CTL_ZERO_BYTES = 2 * MiB;
constexpr int CW_BAR = 4096;
constexpr size_t WS_ROWSQ = 65536;
constexpr size_t ROWSQ_STRIDE = (size_t)T * 4;
constexpr size_t WS_TAB = 2 * MiB;
constexpr size_t TAB_BIASA = 0, TAB_BIASB = 8192, TAB_ROPE = 32768;
constexpr int NPOS = 2112;
constexpr size_t WS_W = 3 * MiB;
constexpr size_t W_GU_BYTES = (size_t)NGU * DM * 2, W_D_BYTES = (size_t)DM * FF * 2;
constexpr size_t W_GU0 = 0;
constexpr size_t W_D0 = 4 * W_GU_BYTES;
constexpr size_t W_EVIN = W_D0 + 4 * W_D_BYTES;
constexpr size_t W_EVOUT = W_EVIN + (size_t)EV_IN * DM * 2;
constexpr size_t W_ODIN = W_EVOUT + (size_t)DM * DM * 2;
constexpr size_t W_ODOUT = W_ODIN + (size_t)OD_INP * DM * 2;
constexpr size_t W_QB = W_ODOUT + (size_t)DM * DM * 2;
constexpr size_t W_KVB = W_QB + (size_t)768 * 256 * 2;
constexpr size_t W_KVP = W_KVB + (size_t)1024 * 256 * 2;
constexpr size_t W_END = W_KVP + (size_t)1024 * 128 * 2;
static_assert(W_END <= 80 * MiB, "weights");
constexpr size_t WS_XB = 83 * MiB;
constexpr size_t WS_R = 116 * MiB;
constexpr size_t R_H = 0;
constexpr size_t R_QKV = 0;
constexpr size_t R_CAK = 96 * MiB, R_CAV = R_CAK + 262144, R_CBK = R_CAV + 262144, R_CBV = R_CBK + 4194304;
constexpr size_t R_MIX = 105 * MiB;
constexpr size_t R_U = 0;
constexpr size_t R_QA = R_U + (size_t)T * 512 * 2;
constexpr size_t R_KVA = R_QA + (size_t)T * 256 * 2;
constexpr size_t R_KPE = R_KVA + (size_t)T * 256 * 2;
constexpr size_t R_QD = R_KPE + (size_t)T * 32 * 2;
constexpr size_t R_KD = R_QD + (size_t)T * 768 * 2;
constexpr size_t R_VD = R_KD + (size_t)TP * 512 * 2;
constexpr size_t R_CKVS = R_VD + (size_t)TP * 512 * 2;
constexpr size_t R_PART = R_U;
constexpr int NSPLIT = 16;
constexpr size_t PART_BYTES = (size_t)64 * 66 * 4;
constexpr size_t R_PART_END = R_PART + (size_t)NB * 8 * NSPLIT * PART_BYTES;
static_assert(R_CBV + 4194304 <= R_MIX && R_PART_END <= R_QA && R_CKVS + (size_t)TS * 128 * 2 <= R_MIX && (size_t)T * FF * 2 <= R_CAK, "region R map");
constexpr size_t WS_END = WS_R + R_MIX + (size_t)T * DM * 2;
static_assert(WS_END <= 256 * MiB, "workspace");

constexpr int RING_OFF = 0, RING_BYTES = 131072;
constexpr int LDSCTL_OFF = RING_BYTES, MISC_OFF = LDSCTL_OFF + 320;
constexpr int LDS_BYTES = 147456;
constexpr int NWAVES = 8;

namespace ep {
using pg8::f32x4; using pg8::u32x4; using pg8::Unit; using pg8::bf16_t;
typedef unsigned u32x2 __attribute__((ext_vector_type(2)));
__device__ __forceinline__ unsigned pkbf(float lo, float hi) { return pg8::cvt_pk_bf16(lo, hi); }
__device__ __forceinline__ u32x4 pack8(const float* v) { u32x4 w; w.x = pkbf(v[0], v[1]); w.y = pkbf(v[2], v[3]); w.z = pkbf(v[4], v[5]); w.w = pkbf(v[6], v[7]); return w; }
__device__ __forceinline__ float red_fq(float s) { s += __shfl_xor(s, 16); s += __shfl_xor(s, 32); return s; }
struct Ctx { unsigned char* ws; float* out; const float* const* in; };
#define EP_OPEN() int z_ = 0; asm volatile("" : "+s"(z_)); { int le_; asm volatile("v_mbcnt_lo_u32_b32 %0, -1, 0\n\tv_mbcnt_hi_u32_b32 %0, -1, %0" : "=v"(le_)); fr = le_ & 15; fq = le_ >> 4; }     unsigned char* const ws_ = C.ws + z_; float* const out = C.out + z_; const float* const* const in_ = C.in + z_; (void)ws_; (void)out; (void)in_
#define EPW(T_, off) ((T_*)(ws_ + (off)))
#define EP_ROWF(name, ptr, scale) float name[8]; { (void)(ptr); \
        asm volatile("s_waitcnt vmcnt(16)" : "+v"(rfpre[0]), "+v"(rfpre[1]), "+v"(rfpre[2]), "+v"(rfpre[3]), "+v"(rfpre[4]), "+v"(rfpre[5]), "+v"(rfpre[6]), "+v"(rfpre[7]));     \
        _Pragma("unroll") for (int g_ = 0; g_ < 8; ++g_) name[g_] = __builtin_amdgcn_rsqf(rfpre[g_] * (scale) + EPS); }
#define EP_PREFETCH(off_expr) static constexpr int NPRE = 8; __device__ __forceinline__ void prefetch(float (&rf)[8], const Unit& u, int wr) const { \
        int le_; asm volatile("v_mbcnt_lo_u32_b32 %0, -1, 0\n\tv_mbcnt_hi_u32_b32 %0, -1, %0" : "=v"(le_)); const int fr_ = le_ & 15; \
        unsigned char* ws_ = C.ws; asm volatile("" : "+s"(ws_)); const float* p_ = (const float*)(ws_ + (off_expr)); \
        const unsigned vo_ = (unsigned)(u.pm * 256 + wr * 64 + fr_) * 4u; \
          \
          \
        asm volatile("global_load_dword %0, %8, %9\n\tglobal_load_dword %1, %8, %9 offset:64\n\tglobal_load_dword %2, %8, %9 offset:128\n\tglobal_load_dword %3, %8, %9 offset:192\n\t" \
                     "global_load_dword %4, %8, %9 offset:512\n\tglobal_load_dword %5, %8, %9 offset:576\n\tglobal_load_dword %6, %8, %9 offset:640\n\tglobal_load_dword %7, %8, %9 offset:704" \
                     : "=&v"(rf[0]), "=&v"(rf[1]), "=&v"(rf[2]), "=&v"(rf[3]), "=&v"(rf[4]), "=&v"(rf[5]), "=&v"(rf[6]), "=&v"(rf[7]) : "v"(vo_), "s"(p_)); }
__device__ __forceinline__ int pos_index(int row) { return row < TP ? (row & (SEQ - 1)) : SEQ + ((row - TP) & (DSEQ - 1)); }

struct EpiGU {
    static constexpr bool PERM = false, AFTER_DRAIN = false;
    Ctx C; int rsi;
    EP_PREFETCH(WS_ROWSQ + (size_t)rsi * ROWSQ_STRIDE)
    __device__ __forceinline__ void operator()(const f32x4 (&acc)[2][2][4][2], const Unit& u, int wr, int wc, int fr, int fq, float (&rfpre)[8]) const {
        EP_OPEN(); bf16_t* const H = EPW(bf16_t, WS_R + R_H); const float* const rowsq = EPW(float, WS_ROWSQ + (size_t)rsi * ROWSQ_STRIDE);
        EP_ROWF(rf, rowsq, 1.0f / DM);
#pragma unroll
        for (int ai = 0; ai < 2; ++ai)
#pragma unroll
            for (int m = 0; m < 4; ++m) {
                const int row = u.pm * 256 + ai * 128 + wr * 64 + m * 16 + fr;
                const float r = rf[4 * ai + m];
                const pg8::f32x2 nr = {-LOG2E * r, -LOG2E * r}, r2 = {r * r, r * r}, one = {1.0f, 1.0f};
                pg8::f32x2 tt[4], pp[4];
#pragma unroll
                for (int q = 0; q < 4; ++q) { const pg8::f32x2 a = {acc[ai][0][m][q >> 1][2 * (q & 1)], acc[ai][0][m][q >> 1][2 * (q & 1) + 1]}, b = {acc[ai][1][m][q >> 1][2 * (q & 1)], acc[ai][1][m][q >> 1][2 * (q & 1) + 1]};
                    tt[q] = a * nr; pp[q] = (a * b) * r2; }
#pragma unroll
                for (int q = 0; q < 4; ++q) { tt[q].x = __builtin_amdgcn_exp2f(tt[q].x); tt[q].y = __builtin_amdgcn_exp2f(tt[q].y); }
#pragma unroll
                for (int q = 0; q < 4; ++q) tt[q] = tt[q] + one;
#pragma unroll
                for (int q = 0; q < 4; ++q) { tt[q].x = __builtin_amdgcn_rcpf(tt[q].x); tt[q].y = __builtin_amdgcn_rcpf(tt[q].y); }
                float hv[8];
#pragma unroll
                for (int q = 0; q < 4; ++q) { const pg8::f32x2 hq = pp[q] * tt[q]; hv[2 * q] = hq.x; hv[2 * q + 1] = hq.y; }
                *(u32x4*)(H + (size_t)row * FF + u.pn * 128 + wc * 32 + 8 * fq) = pack8(hv);
                asm volatile("" ::: "memory");
            }
    }
};

struct EpiResid {
    static constexpr bool PERM = false, AFTER_DRAIN = false;
    Ctx C; int last, rsi; float alpha;
    static constexpr int NPRE = 0; __device__ __forceinline__ void prefetch(float (&)[8], const Unit&, int) const {}
    __device__ __forceinline__ void operator()(const f32x4 (&acc)[2][2][4][2], const Unit& u, int wr, int wc, int fr, int fq, const float (&)[8]) const {
        EP_OPEN(); bf16_t* const xb = EPW(bf16_t, WS_XB); float* const rowsq = last ? nullptr : EPW(float, WS_ROWSQ + (size_t)rsi * ROWSQ_STRIDE);
        u32x4 xa[8][2];
        const int colb = u.pn * 256 + wc * 32 + 8 * fq;
#pragma unroll
        for (int g = 0; g < 8; ++g) { const int row_ = u.pm * 256 + (g >> 2) * 128 + wr * 64 + (g & 3) * 16 + fr;
#pragma unroll
            for (int bj = 0; bj < 2; ++bj) xa[g][bj] = *(const u32x4*)(xb + (size_t)row_ * DM + colb + bj * 128); }
        asm volatile("" : "+v"(xa[0][0]), "+v"(xa[0][1]), "+v"(xa[1][0]), "+v"(xa[1][1]), "+v"(xa[2][0]), "+v"(xa[2][1]), "+v"(xa[3][0]), "+v"(xa[3][1]));
        asm volatile("" : "+v"(xa[4][0]), "+v"(xa[4][1]), "+v"(xa[5][0]), "+v"(xa[5][1]), "+v"(xa[6][0]), "+v"(xa[6][1]), "+v"(xa[7][0]), "+v"(xa[7][1]));
        float ssg[8];
#pragma unroll
        for (int g = 0; g < 8; ++g) {
            const int ai = g >> 2, m = g & 3;
            const int row = u.pm * 256 + ai * 128 + wr * 64 + m * 16 + fr;
            pg8::f32x2 s2 = {0.f, 0.f};
#pragma unroll
            for (int bj = 0; bj < 2; ++bj) {
                const int col = colb + bj * 128; const u32x4 xo = xa[g][bj];
                const f32x4 x0 = (f32x4){__uint_as_float(xo.x << 16), __uint_as_float(xo.x & 0xffff0000u), __uint_as_float(xo.y << 16), __uint_as_float(xo.y & 0xffff0000u)};
                const f32x4 x1 = (f32x4){__uint_as_float(xo.z << 16), __uint_as_float(xo.z & 0xffff0000u), __uint_as_float(xo.w << 16), __uint_as_float(xo.w & 0xffff0000u)};
                const f32x4 v0 = x0 + acc[ai][bj][m][0] * alpha, v1 = x1 + acc[ai][bj][m][1] * alpha;
                if (last) { *(f32x4*)(out + (size_t)row * DM + col) = v0; *(f32x4*)(out + (size_t)row * DM + col + 4) = v1; }
                else { u32x4 w; w.x = pkbf(v0[0], v0[1]); w.y = pkbf(v0[2], v0[3]); w.z = pkbf(v1[0], v1[1]); w.w = pkbf(v1[2], v1[3]); *(u32x4*)(xb + (size_t)row * DM + col) = w; }
                s2 = s2 + v0.lo * v0.lo; s2 = s2 + v0.hi * v0.hi; s2 = s2 + v1.lo * v1.lo; s2 = s2 + v1.hi * v1.hi;
            }
            ssg[g] = s2.x + s2.y;
            asm volatile("" ::: "memory");
        }
        if (rowsq) {
#pragma unroll
            for (int g = 0; g < 8; ++g) ssg[g] += __shfl_xor(ssg[g], 16);
#pragma unroll
            for (int g = 0; g < 8; ++g) ssg[g] += __shfl_xor(ssg[g], 32);
            if (fq == 0) {
#pragma unroll
                for (int g = 0; g < 8; ++g) atomicAdd(rowsq + (u.pm * 256 + (g >> 2) * 128 + wr * 64 + (g & 3) * 16 + fr), ssg[g]);
            }
        }
    }
};

struct EpiEvIn {
    static constexpr bool PERM = false, AFTER_DRAIN = false;
    Ctx C;
    EP_PREFETCH(WS_ROWSQ + 1 * ROWSQ_STRIDE)
    __device__ __forceinline__ void operator()(const f32x4 (&acc)[2][2][4][2], const Unit& u, int wr, int wc, int fr, int fq, float (&rfpre)[8]) const {
        EP_OPEN(); bf16_t* const QKV = EPW(bf16_t, WS_R + R_QKV); const float* const rowsq = EPW(float, WS_ROWSQ + 1 * ROWSQ_STRIDE);
        EP_ROWF(rf, rowsq, 1.0f / DM);
        const int hs = 4 * u.pn + wc;
        const float* gp = hs < 8 ? in_[19] : hs < 10 ? in_[20] : hs < 12 ? nullptr : hs < 20 ? in_[22] : hs < 28 ? in_[23] : nullptr;
        const float qs = (hs < 8 || (hs >= 12 && hs < 20)) ? QS64 : 1.0f;
        float gv[2][8];
#pragma unroll
        for (int bj = 0; bj < 2; ++bj)
#pragma unroll
            for (int j = 0; j < 8; ++j) gv[bj][j] = gp ? gp[32 * bj + 8 * fq + j] * qs : 1.0f;
        int kind = 0; int hh = 0;
        if (hs >= 8 && hs < 10) { kind = 1; hh = hs - 8; } else if (hs >= 10 && hs < 12) { kind = 2; hh = hs - 10; } else if (hs >= 20 && hs < 28) { kind = 3; hh = hs - 20; } else if (hs >= 28) { kind = 4; hh = hs - 28; }
#pragma unroll
        for (int ai = 0; ai < 2; ++ai)
#pragma unroll
            for (int m = 0; m < 4; ++m) {
                const int row = u.pm * 256 + ai * 128 + wr * 64 + m * 16 + fr;
                const float r = rf[4 * ai + m];
                float v[2][8]; float ss = 0.f;
#pragma unroll
                for (int bj = 0; bj < 2; ++bj)
#pragma unroll
                    for (int n = 0; n < 2; ++n)
#pragma unroll
                        for (int e = 0; e < 4; ++e) { const float x = acc[ai][bj][m][n][e] * r; v[bj][4 * n + e] = x; ss += x * x; }
                if (gp) { ss = red_fq(ss); const float r2 = __builtin_amdgcn_rsqf(ss * (1.0f / 64.0f) + EPS);
#pragma unroll
                    for (int bj = 0; bj < 2; ++bj)
#pragma unroll
                        for (int j = 0; j < 8; ++j) v[bj][j] = v[bj][j] * r2 * gv[bj][j]; }
#pragma unroll
                for (int bj = 0; bj < 2; ++bj) *(u32x4*)(QKV + (size_t)row * EV_IN + 64 * hs + 32 * bj + 8 * fq) = pack8(v[bj]);
                if (kind) {
                    float* dst = nullptr;
                    if (row < TP) { const int b = row >> 11, t = row & (SEQ - 1);
                        if (kind <= 2) { if (t >= SEQ - 128) dst = out + (kind == 1 ? O_AKP : O_AVP) + ((size_t)(b * 128 + t - (SEQ - 128)) * 2 + hh) * 64; }
                        else { if (t >= SEQ - 512) dst = out + (kind == 3 ? O_BKP : O_BVP) + ((size_t)(b * 512 + t - (SEQ - 512)) * 8 + hh) * 64; }
                    } else { const int b = (row - TP) >> 6, t = (row - TP) & 63;
                        if (kind <= 2) dst = out + (kind == 1 ? O_AKS : O_AVS) + ((size_t)(b * 128 + 64 + t) * 2 + hh) * 64;
                        else dst = out + (kind == 3 ? O_BKS : O_BVS) + ((size_t)(b * 512 + 448 + t) * 8 + hh) * 64;
                    }
                    if (dst) {
#pragma unroll
                        for (int bj = 0; bj < 2; ++bj) { float* d = dst + 32 * bj + 8 * fq;
                            *(f32x4*)d = (f32x4){v[bj][0], v[bj][1], v[bj][2], v[bj][3]}; *(f32x4*)(d + 4) = (f32x4){v[bj][4], v[bj][5], v[bj][6], v[bj][7]}; }
                    }
                }
                asm volatile("" ::: "memory");
            }
    }
};

__device__ __forceinline__ void rope8(float (&v)[8], int fq, const float* ropetab, int pidx) {
    const float* ct = ropetab + (size_t)pidx * 16 + 8 * (fq & 1); const float* st = ct + (size_t)NPOS * 16;
#pragma unroll
    for (int j = 0; j < 8; ++j) { const float other = __shfl_xor(v[j], 32); const float c = ct[j], s = st[j];
        v[j] = fq < 2 ? v[j] * c - other * s : other * s + v[j] * c; }
}

struct EpiOdIn {
    static constexpr bool PERM = false, AFTER_DRAIN = false;
    Ctx C;
    EP_PREFETCH(WS_ROWSQ + 4 * ROWSQ_STRIDE)
    __device__ __forceinline__ void operator()(const f32x4 (&acc)[2][2][4][2], const Unit& u, int wr, int wc, int fr, int fq, float (&rfpre)[8]) const {
        EP_OPEN(); bf16_t* const MIX = EPW(bf16_t, WS_R + R_MIX); bf16_t* const U = EPW(bf16_t, WS_R + R_U); bf16_t* const QA = EPW(bf16_t, WS_R + R_QA); bf16_t* const KVA = EPW(bf16_t, WS_R + R_KVA); bf16_t* const KPE = EPW(bf16_t, WS_R + R_KPE);
        const float* const rowsq = EPW(float, WS_ROWSQ + 4 * ROWSQ_STRIDE); float* const rsq_qa = EPW(float, WS_ROWSQ + 6 * ROWSQ_STRIDE); float* const rsq_kva = EPW(float, WS_ROWSQ + 7 * ROWSQ_STRIDE);
        const float* const knr = in_[35]; const float* const ropetab = EPW(float, WS_TAB + TAB_ROPE);
        const int pn = u.pn;
        EP_ROWF(rf, rowsq, 1.0f / DM);
#pragma unroll
        for (int ai = 0; ai < 2; ++ai)
#pragma unroll
            for (int m = 0; m < 4; ++m) {
                const int row = u.pm * 256 + ai * 128 + wr * 64 + m * 16 + fr;
                const float r = rf[4 * ai + m];
                float v[2][8];
#pragma unroll
                for (int bj = 0; bj < 2; ++bj)
#pragma unroll
                    for (int n = 0; n < 2; ++n)
#pragma unroll
                        for (int e = 0; e < 4; ++e) v[bj][4 * n + e] = acc[ai][bj][m][n][e] * r;
                if (pn < 2) {
#pragma unroll
                    for (int bj = 0; bj < 2; ++bj) *(u32x4*)(MIX + (size_t)row * DM + 256 * pn + 128 * bj + 32 * wc + 8 * fq) = pack8(v[bj]);
                } else if (pn < 6) {
                    float uu[8];
#pragma unroll
                    for (int j = 0; j < 8; ++j) uu[j] = v[0][j] * v[1][j];
                    const int idx = 128 * (pn - 2) + 32 * wc + 8 * fq;
                    *(u32x4*)(U + (size_t)row * 512 + idx) = pack8(uu);
                    float* dst = nullptr;
                    if (row < TP) { const int b = row >> 11, t = row & (SEQ - 1); if (t >= SEQ - 2) dst = out + O_CP + (size_t)(b * 2 + t - (SEQ - 2)) * 512 + idx; }
                    else { const int b = (row - TP) >> 6, t = (row - TP) & 63; if (t >= 62) dst = out + O_CS + (size_t)(b * 2 + t - 62) * 512 + idx; }
                    if (dst) { *(f32x4*)dst = (f32x4){uu[0], uu[1], uu[2], uu[3]}; *(f32x4*)(dst + 4) = (f32x4){uu[4], uu[5], uu[6], uu[7]}; }
                } else if (pn == 6) {
                    float ss = 0.f;
#pragma unroll
                    for (int bj = 0; bj < 2; ++bj) { *(u32x4*)(QA + (size_t)row * 256 + 128 * bj + 32 * wc + 8 * fq) = pack8(v[bj]);
#pragma unroll
                        for (int j = 0; j < 8; ++j) ss += v[bj][j] * v[bj][j]; }
                    ss = red_fq(ss); if (fq == 0) atomicAdd(rsq_qa + row, ss);
                } else {
                    float ss = 0.f;
#pragma unroll
                    for (int j = 0; j < 8; ++j) ss += v[0][j] * v[0][j];
                    *(u32x4*)(KVA + (size_t)row * 256 + 32 * wc + 8 * fq) = pack8(v[0]);
                    *(u32x4*)(KVA + (size_t)row * 256 + 128 + 32 * wc + 8 * fq) = (u32x4){0u, 0u, 0u, 0u};
                    ss = red_fq(ss); if (fq == 0) atomicAdd(rsq_kva + row, ss);
                    if (wc == 0) {
                        float s2 = 0.f;
#pragma unroll
                        for (int j = 0; j < 8; ++j) s2 += v[1][j] * v[1][j];
                        s2 = red_fq(s2); const float r2 = __builtin_amdgcn_rsqf(s2 * (1.0f / 32.0f) + EPS);
                        float k[8];
#pragma unroll
                        for (int j = 0; j < 8; ++j) k[j] = v[1][j] * r2 * knr[8 * fq + j];
                        rope8(k, fq, ropetab, pos_index(row));
                        float* dst = row < TP ? out + O_KPEP + (size_t)row * 32 + 8 * fq : out + O_KPES + (size_t)(row - TP) * 32 + 8 * fq;
                        *(f32x4*)dst = (f32x4){k[0], k[1], k[2], k[3]}; *(f32x4*)(dst + 4) = (f32x4){k[4], k[5], k[6], k[7]};
                        *(u32x4*)(KPE + (size_t)row * 32 + 8 * fq) = pack8(k);
                    }
                }
                asm volatile("" ::: "memory");
            }
    }
};

struct EpiQb {
    static constexpr bool PERM = false, AFTER_DRAIN = false;
    Ctx C;
    EP_PREFETCH(WS_ROWSQ + 6 * ROWSQ_STRIDE)
    __device__ __forceinline__ void operator()(const f32x4 (&acc)[2][2][4][2], const Unit& u, int wr, int wc, int fr, int fq, float (&rfpre)[8]) const {
        EP_OPEN(); bf16_t* const QD = EPW(bf16_t, WS_R + R_QD); const float* const rsq_qa = EPW(float, WS_ROWSQ + 6 * ROWSQ_STRIDE); const float* const qnn = in_[32]; const float* const qnr = in_[33]; const float* const ropetab = EPW(float, WS_TAB + TAB_ROPE);
        const int pn = u.pn;
        EP_ROWF(rf, rsq_qa, 1.0f / 256.0f);
        float gv[2][8];
#pragma unroll
        for (int bj = 0; bj < 2; ++bj)
#pragma unroll
            for (int j = 0; j < 8; ++j) gv[bj][j] = (pn < 2 ? qnn[32 * bj + 8 * fq + j] : qnr[8 * fq + j]) * QS96;
#pragma unroll
        for (int ai = 0; ai < 2; ++ai)
#pragma unroll
            for (int m = 0; m < 4; ++m) {
                const int row = u.pm * 256 + ai * 128 + wr * 64 + m * 16 + fr;
                const float r = rf[4 * ai + m];
                float v[2][8]; float ss[2] = {0.f, 0.f};
#pragma unroll
                for (int bj = 0; bj < 2; ++bj)
#pragma unroll
                    for (int n = 0; n < 2; ++n)
#pragma unroll
                        for (int e = 0; e < 4; ++e) { const float x = acc[ai][bj][m][n][e] * r; v[bj][4 * n + e] = x; ss[bj] += x * x; }
                if (pn < 2) {
                    const float s = red_fq(ss[0] + ss[1]); const float r2 = __builtin_amdgcn_rsqf(s * (1.0f / 64.0f) + EPS);
                    const int head = 4 * pn + wc;
#pragma unroll
                    for (int bj = 0; bj < 2; ++bj) {
#pragma unroll
                        for (int j = 0; j < 8; ++j) v[bj][j] = v[bj][j] * r2 * gv[bj][j];
                        *(u32x4*)(QD + (size_t)row * 768 + head * 96 + 32 * bj + 8 * fq) = pack8(v[bj]); }
                } else {
                    const int pidx = pos_index(row);
#pragma unroll
                    for (int bj = 0; bj < 2; ++bj) {
                        const float s = red_fq(ss[bj]); const float r2 = __builtin_amdgcn_rsqf(s * (1.0f / 32.0f) + EPS);
#pragma unroll
                        for (int j = 0; j < 8; ++j) v[bj][j] = v[bj][j] * r2 * gv[bj][j];
                        rope8(v[bj], fq, ropetab, pidx);
                        const int head = 2 * wc + bj;
                        *(u32x4*)(QD + (size_t)row * 768 + head * 96 + 64 + 8 * fq) = pack8(v[bj]); }
                }
                asm volatile("" ::: "memory");
            }
    }
};

struct EpiKvb {
    static constexpr bool PERM = false, AFTER_DRAIN = false;
    Ctx C;
    EP_PREFETCH(WS_ROWSQ + 7 * ROWSQ_STRIDE)
    __device__ __forceinline__ void operator()(const f32x4 (&acc)[2][2][4][2], const Unit& u, int wr, int wc, int fr, int fq, float (&rfpre)[8]) const {
        EP_OPEN(); bf16_t* const KD = EPW(bf16_t, WS_R + R_KD); bf16_t* const VD = EPW(bf16_t, WS_R + R_VD); const float* const rsq_kva = EPW(float, WS_ROWSQ + 7 * ROWSQ_STRIDE); const float* const knn = in_[34];
        const int head = 2 * u.pn + (wc >> 1), part = wc & 1;
        EP_ROWF(rf, rsq_kva, 1.0f / 128.0f);
        float gv[2][8];
#pragma unroll
        for (int bj = 0; bj < 2; ++bj)
#pragma unroll
            for (int j = 0; j < 8; ++j) gv[bj][j] = knn[32 * bj + 8 * fq + j];
#pragma unroll
        for (int ai = 0; ai < 2; ++ai)
#pragma unroll
            for (int m = 0; m < 4; ++m) {
                const int row = u.pm * 256 + ai * 128 + wr * 64 + m * 16 + fr;
                const float r = rf[4 * ai + m];
                float v[2][8]; float ss = 0.f;
#pragma unroll
                for (int bj = 0; bj < 2; ++bj)
#pragma unroll
                    for (int n = 0; n < 2; ++n)
#pragma unroll
                        for (int e = 0; e < 4; ++e) { const float x = acc[ai][bj][m][n][e] * r; v[bj][4 * n + e] = x; ss += x * x; }
                if (part == 0) { ss = red_fq(ss); const float r2 = __builtin_amdgcn_rsqf(ss * (1.0f / 64.0f) + EPS);
#pragma unroll
                    for (int bj = 0; bj < 2; ++bj)
#pragma unroll
                        for (int j = 0; j < 8; ++j) v[bj][j] = v[bj][j] * r2 * gv[bj][j]; }
                bf16_t* dst = (part == 0 ? KD : VD) + (size_t)row * 512 + head * 64 + 8 * fq;
#pragma unroll
                for (int bj = 0; bj < 2; ++bj) *(u32x4*)(dst + 32 * bj) = pack8(v[bj]);
                asm volatile("" ::: "memory");
            }
    }
};

struct EpiNull {
    static constexpr bool PERM = false, AFTER_DRAIN = false;
    static constexpr int NPRE = 0; __device__ __forceinline__ void prefetch(float (&)[8], const Unit&, int) const {}
    __device__ __forceinline__ void operator()(const f32x4 (&acc)[2][2][4][2], const Unit& u, int wr, int wc, int fr, int fq, const float (&)[8]) const {
#pragma unroll
        for (int ai = 0; ai < 2; ++ai)
#pragma unroll
            for (int bj = 0; bj < 2; ++bj)
#pragma unroll
                for (int m = 0; m < 4; ++m)
#pragma unroll
                    for (int n = 0; n < 2; ++n) asm volatile("" :: "v"(acc[ai][bj][m][n]));
    }
};
}

typedef unsigned u32x2t __attribute__((ext_vector_type(2)));
struct Frame {
    LAS unsigned char* lds;
    volatile LAS unsigned* MISC;
    gu32* ctl;
    int vcu, G, wave_s;
    const float* const* in;
    float* out; unsigned char* ws;
};
#define WSP(T_, off) ((T_*)(F.ws + (off)))
#define LOCAL_IDS() int lane_; asm volatile("v_mbcnt_lo_u32_b32 %0, -1, 0\n\tv_mbcnt_hi_u32_b32 %0, -1, %0" : "=v"(lane_)); const int lane = lane_; const int wave = F.wave_s; const int tid = wave * 64 + lane; (void)tid
__device__ __forceinline__ float wave_sum(float v) {
#pragma unroll
    for (int o = 1; o < 64; o <<= 1) v += __shfl_xor(v, o);
    return v;
}

struct WMat { const float* W; int K, Nsrc; bf16* dst; int Kdst, ngroups; const float* gain; int kind; int natural; };
__device__ __forceinline__ int wsrc_base(int kind, int G) {
    const int pn = G >> 3, bj = (G >> 2) & 1, wc = G & 3;
    switch (kind) {
    case 0: return 32 * G;
    case 1: return bj * FF + 128 * pn + 32 * wc;
    case 2: return 256 * pn + 64 * wc + 32 * bj;
    case 3: if (pn < 2) return 32 * G; if (pn < 6) return (bj ? 1024 : 512) + 128 * (pn - 2) + 32 * wc; if (pn == 6) return 1536 + 128 * bj + 32 * wc;
            return bj == 0 ? 1792 + 32 * wc : (wc == 0 ? 1920 : -1);
    case 4: if (pn < 2) return 96 * (4 * pn + wc) + 32 * bj; return 96 * (2 * wc + bj) + 64;
    default: return 128 * (2 * pn + (wc >> 1)) + 64 * (wc & 1) + 32 * bj;
    }
}
__device__ __forceinline__ void wconv_item(const WMat& M, int item, LAS float* scr, int lane) {
    const int nkb = M.Kdst / 64, G = item / nkb, kb = item % nkb, k0 = 64 * kb;
    const int sb = wsrc_base(M.kind, G);
    const bool zero = (sb < 0) || (k0 >= M.K);
    const int c = lane & 7;
    float gk[8];
#pragma unroll
    for (int i = 0; i < 8; ++i) gk[i] = 1.0f;
    if (!zero) {
        float wv[32];
        const float* wp = M.W + (size_t)(k0 + (lane >> 5)) * M.Nsrc + sb + (lane & 31);
#pragma unroll
        for (int i = 0; i < 32; ++i) wv[i] = wp[(size_t)(2 * i) * M.Nsrc];
        if (M.gain) {
#pragma unroll
            for (int i = 0; i < 8; ++i) gk[i] = M.gain[k0 + 8 * c + i]; }
#pragma unroll
        for (int i = 0; i < 32; ++i) scr[(2 * i + (lane >> 5)) * 33 + (lane & 31)] = wv[i];
    }
    LDS_WAIT(); asm volatile("" ::: "memory");
#pragma unroll
    for (int j = 0; j < 4; ++j) { const int rho = (lane >> 3) + 8 * j; const int n = M.natural ? rho : pg8::perm32(rho); const LAS float* s = scr + (8 * c) * 33 + n;
        v4u o; if (zero) o = (v4u){0u, 0u, 0u, 0u}; else { o.x = pk2(s[0 * 33] * gk[0], s[1 * 33] * gk[1]); o.y = pk2(s[2 * 33] * gk[2], s[3 * 33] * gk[3]); o.z = pk2(s[4 * 33] * gk[4], s[5 * 33] * gk[5]); o.w = pk2(s[6 * 33] * gk[6], s[7 * 33] * gk[7]); }
        *(GAS v4u*)(M.dst + (size_t)(32 * G + rho) * M.Kdst + k0 + 8 * c) = o; }
    LDS_WAIT(); asm volatile("" ::: "memory");
}

__device__ __forceinline__ int t5_bucket(int rel) {
    int n = -rel; int ret = n < 0 ? 16 : 0; n = n < 0 ? -n : n;
    if (n < 8) return ret + n;
    const int q = (n * n) >> 6; int lg = 31 - __builtin_clz(q); int large = 8 + lg; if (large > 15) large = 15;
    return ret + large;
}

__device__ __forceinline__ WMat get_mat(const Frame& F, int mi) {
    const float* const* in = F.in; WMat M;
    if (mi < 8) { const int l = mi >> 2, f = (mi >> 1) & 1;
        if ((mi & 1) == 0) { M.W = (f ? in[14] : in[10]) + (size_t)l * DM * NGU; M.K = DM; M.Nsrc = NGU; M.dst = (bf16*)(F.ws + WS_W + W_GU0 + (size_t)(l * 2 + f) * W_GU_BYTES); M.Kdst = DM; M.ngroups = NGU / 32; M.gain = (f ? in[13] : in[9]) + l * DM; M.kind = 1; M.natural = 0; }
        else { M.W = (f ? in[15] : in[11]) + (size_t)l * FF * DM; M.K = FF; M.Nsrc = DM; M.dst = (bf16*)(F.ws + WS_W + W_D0 + (size_t)(l * 2 + f) * W_D_BYTES); M.Kdst = FF; M.ngroups = DM / 32; M.gain = nullptr; M.kind = 0; M.natural = 0; }
    } else if (mi == 8) { M.W = in[17]; M.K = DM; M.Nsrc = EV_IN; M.dst = (bf16*)(F.ws + WS_W + W_EVIN); M.Kdst = DM; M.ngroups = EV_IN / 32; M.gain = in[12]; M.kind = 2; M.natural = 0; }
    else if (mi == 9) { M.W = in[18]; M.K = DM; M.Nsrc = DM; M.dst = (bf16*)(F.ws + WS_W + W_EVOUT); M.Kdst = DM; M.ngroups = DM / 32; M.gain = nullptr; M.kind = 0; M.natural = 0; }
    else if (mi == 10) { M.W = in[25]; M.K = DM; M.Nsrc = OD_IN; M.dst = (bf16*)(F.ws + WS_W + W_ODIN); M.Kdst = DM; M.ngroups = OD_INP / 32; M.gain = in[12] + DM; M.kind = 3; M.natural = 0; }
    else if (mi == 11) { M.W = in[26]; M.K = DM; M.Nsrc = DM; M.dst = (bf16*)(F.ws + WS_W + W_ODOUT); M.Kdst = DM; M.ngroups = DM / 32; M.gain = nullptr; M.kind = 0; M.natural = 0; }
    else if (mi == 12) { M.W = in[29]; M.K = 256; M.Nsrc = 768; M.dst = (bf16*)(F.ws + WS_W + W_QB); M.Kdst = 256; M.ngroups = 768 / 32; M.gain = in[28]; M.kind = 4; M.natural = 0; }
    else if (mi == 13) { M.W = in[31]; M.K = 128; M.Nsrc = 1024; M.dst = (bf16*)(F.ws + WS_W + W_KVB); M.Kdst = 256; M.ngroups = 1024 / 32; M.gain = in[30]; M.kind = 5; M.natural = 0; }
    else { M.W = in[31]; M.K = 128; M.Nsrc = 1024; M.dst = (bf16*)(F.ws + WS_W + W_KVP); M.Kdst = 128; M.ngroups = 1024 / 32; M.gain = nullptr; M.kind = 0; M.natural = 1; }
    return M;
}

__device__ __forceinline__ void wconv_set(Frame& F, unsigned mask, int cu0, int ncu) {
    const int cu = (int)blockIdx.x - cu0; if (cu < 0 || cu >= ncu) return;
    LOCAL_IDS();
    LAS float* scr = (LAS float*)(F.lds + RING_OFF + wave * 16384);
    const int gw = cu * NWAVES + wave, NGW = ncu * NWAVES;
    int base = 0;
#pragma unroll 1
    for (int mi = 0; mi < 15; ++mi) {
        if (!((mask >> mi) & 1u)) continue;
        const WMat M = get_mat(F, mi);
        const int nitems = M.ngroups * (M.Kdst / 64);
        for (int it = (gw + NGW - (base % NGW)) % NGW; it < nitems; it += NGW) wconv_item(M, it, scr, lane);
        base += nitems;
    }
}
constexpr unsigned WSET_PROLOGUE = 0x001u;
constexpr unsigned WSET_PH1 = 0x306u;
constexpr unsigned WSET_PH3 = 0x7c38u;
constexpr unsigned WSET_PH6 = 0x0c0u;
static_assert((WSET_PROLOGUE | WSET_PH1 | WSET_PH3 | WSET_PH6) == 0x7fffu && (WSET_PROLOGUE & WSET_PH1) == 0 && (WSET_PH1 & WSET_PH3) == 0 && (WSET_PH3 & WSET_PH6) == 0, "every matrix converted once");

__device__ __forceinline__ void p0_prologue(Frame& F) {
    LOCAL_IDS();
    LAS float* scr = (LAS float*)(F.lds + RING_OFF + wave * 16384);
    const int gw = F.vcu * NWAVES + wave, NGW = F.G * NWAVES;
    const float* const* in = F.in;
    wconv_set(F, WSET_PROLOGUE, 0, F.G);
    {
        bf16* XB = WSP(bf16, WS_XB); float* rs0 = WSP(float, WS_ROWSQ);
        for (int m = gw; m < T; m += NGW) {
            const float* xr = m < TP ? in[0] + (size_t)m * DM : in[1] + (size_t)(m - TP) * DM;
            const GAS f32x4* xv = (const GAS f32x4*)xr + lane; float s = 0.f;
            GAS unsigned long long* o8 = (GAS unsigned long long*)(XB + (size_t)m * DM) + lane;
#pragma unroll
            for (int j = 0; j < 4; ++j) { const f32x4 v = xv[64 * j]; s += (v.x * v.x + v.y * v.y) + (v.z * v.z + v.w * v.w);
                o8[64 * j] = (unsigned long long)pk2(v.x, v.y) | ((unsigned long long)pk2(v.z, v.w) << 32); }
            s = wave_sum(s); if (lane == 0) rs0[m] = s;
        }
    }
}
__device__ __forceinline__ void p0_aux(Frame& F, int cu0, int ncu) {
    const int cu = (int)blockIdx.x - cu0; if (cu < 0 || cu >= ncu) return;
    LOCAL_IDS();
    const int gw = cu * NWAVES + wave, NGW = ncu * NWAVES;
    const float* const* in = F.in;
    {
        const size_t gt = (size_t)gw * 64 + lane, NT_ = (size_t)NGW * 64;
        bf16* cak = WSP(bf16, WS_R + R_CAK); bf16* cav = WSP(bf16, WS_R + R_CAV); bf16* cbk = WSP(bf16, WS_R + R_CBK); bf16* cbv = WSP(bf16, WS_R + R_CBV);
        for (size_t i = gt; i < 131072 / 4; i += NT_) { const f32x4 a = ((const f32x4*)in[2])[i], b = ((const f32x4*)in[3])[i];
            ((u32x2t*)cak)[i] = (u32x2t){pk2(a.x, a.y), pk2(a.z, a.w)}; ((u32x2t*)cav)[i] = (u32x2t){pk2(b.x, b.y), pk2(b.z, b.w)}; }
        for (size_t i = gt; i < 2097152 / 4; i += NT_) { const f32x4 a = ((const f32x4*)in[4])[i], b = ((const f32x4*)in[5])[i];
            ((u32x2t*)cbk)[i] = (u32x2t){pk2(a.x, a.y), pk2(a.z, a.w)}; ((u32x2t*)cbv)[i] = (u32x2t){pk2(b.x, b.y), pk2(b.z, b.w)}; }
        for (size_t i = gt; i < (size_t)NB * 64 * 32; i += NT_) { const size_t b = i / (64 * 32), r = i % (64 * 32);
            ((f32x4*)(F.out + O_AKS))[b * 128 * 32 + r] = ((const f32x4*)in[2])[b * 128 * 32 + 64 * 32 + r];
            ((f32x4*)(F.out + O_AVS))[b * 128 * 32 + r] = ((const f32x4*)in[3])[b * 128 * 32 + 64 * 32 + r]; }
        for (size_t i = gt; i < (size_t)NB * 448 * 128; i += NT_) { const size_t b = i / (448 * 128), r = i % (448 * 128);
            ((f32x4*)(F.out + O_BKS))[b * 512 * 128 + r] = ((const f32x4*)in[4])[b * 512 * 128 + 64 * 128 + r];
            ((f32x4*)(F.out + O_BVS))[b * 512 * 128 + r] = ((const f32x4*)in[5])[b * 512 * 128 + 64 * 128 + r]; }
        float* biasA = WSP(float, WS_TAB + TAB_BIASA); float* biasB = WSP(float, WS_TAB + TAB_BIASB); float* rope = WSP(float, WS_TAB + TAB_ROPE);
        for (size_t i = gt; i < 8 * 256; i += NT_) { const int h = (int)(i >> 8), k = (int)(i & 255); const int rel = k - 191; biasA[i] = (k < 255) ? in[16][t5_bucket(rel) * 8 + h] * LOG2E : 0.f; }
        for (size_t i = gt; i < 8 * 640; i += NT_) { const int h = (int)(i / 640), k = (int)(i % 640); int rel = k - 575; rel = rel < -128 ? -128 : (rel > 128 ? 128 : rel); biasB[i] = in[24][h * 257 + rel + 128] * LOG2E; }
        for (size_t i = gt; i < (size_t)NPOS * 16; i += NT_) { const int p = (int)(i >> 4), j = (int)(i & 15); const int pos = p < SEQ ? p : PAST + (p - SEQ);
            const float inv = 1.0f / __builtin_powf(10000.0f, (float)j / 16.0f); const float ang = (float)pos * inv;
            const double a = (double)ang; const double k2 = __builtin_rint(a * 0.15915494309189535); const float red = (float)(a - k2 * 6.283185307179586);
            rope[i] = __builtin_cosf(red); rope[(size_t)NPOS * 16 + i] = __builtin_sinf(red); }
    }
}

namespace att {
#define GLD(T_, base_, boff_) (*(const GAS T_*)((const GAS unsigned char*)(base_) + (unsigned)(boff_)))
#define GST(T_, base_, boff_) (*(GAS T_*)((GAS unsigned char*)(base_) + (unsigned)(boff_)))
typedef short bf16x8 __attribute__((ext_vector_type(8)));
typedef short s16x4 __attribute__((ext_vector_type(4)));
typedef float f32x16 __attribute__((ext_vector_type(16)));
typedef unsigned u32x4 __attribute__((ext_vector_type(4)));
typedef unsigned u32x2 __attribute__((ext_vector_type(2)));
typedef float f32x2_t __attribute__((ext_vector_type(2))); typedef __bf16 bf16x2_t __attribute__((ext_vector_type(2)));
__device__ __forceinline__ unsigned cvtpk(float lo, float hi) { f32x2_t v = {lo, hi}; bf16x2_t b = __builtin_convertvector(v, bf16x2_t); return __builtin_bit_cast(unsigned, b); }
__device__ __forceinline__ s16x4 vtr(LAS const unsigned char* p) { typedef short v4i16_t __attribute__((ext_vector_type(4))); return __builtin_bit_cast(s16x4, __builtin_amdgcn_ds_read_tr16_b64_v4i16((LAS v4i16_t*)p)); }

constexpr int KSMAX = 208;
constexpr int L_K = 0, L_KBUF = 64 * KSMAX;
constexpr int L_V = 2 * L_KBUF, L_VBUF = 8192;
constexpr int L_TAB = L_V + 2 * L_VBUF;
constexpr int L_END = L_TAB + 28672 + 64;


template <int NKA, int NKB, bool BIAS, int VS = 64>
__device__ __forceinline__ void tile_step(const LAS unsigned char* Ka, int kaj, const LAS unsigned char* Kb, int kbj, const bf16x8* qf, const LAS float* tb, const LAS unsigned char* Vb,
                                          float& m, float& l, f32x16& o0, f32x16& o1) {
    constexpr int NK = NKA + NKB;
    bf16x8 ka[NK], kc[NK];
#pragma unroll
    for (int ks = 0; ks < NKA; ++ks) { ka[ks] = *(const LAS bf16x8*)(Ka + 32 * ks); kc[ks] = *(const LAS bf16x8*)(Ka + kaj + 32 * ks); }
#pragma unroll
    for (int ks = 0; ks < NKB; ++ks) { ka[NKA + ks] = *(const LAS bf16x8*)(Kb + 32 * ks); kc[NKA + ks] = *(const LAS bf16x8*)(Kb + kbj + 32 * ks); }
    float bv0[16], bv1[16];
    if (BIAS) {
#pragma unroll
        for (int r = 0; r < 16; ++r) { bv0[r] = tb[(r & 3) + 8 * (r >> 2)]; bv1[r] = tb[32 + (r & 3) + 8 * (r >> 2)]; }
    }
    __builtin_amdgcn_sched_barrier(0);
    f32x16 p0, p1;
#pragma unroll
    for (int r = 0; r < 16; ++r) { p0[r] = BIAS ? bv0[r] : 0.f; p1[r] = BIAS ? bv1[r] : 0.f; }
#pragma unroll
    for (int ks = 0; ks < NK; ++ks) {
        p0 = __builtin_amdgcn_mfma_f32_32x32x16_bf16(ka[ks], qf[ks], p0, 0, 0, 0);
        p1 = __builtin_amdgcn_mfma_f32_32x32x16_bf16(kc[ks], qf[ks], p1, 0, 0, 0);
    }
    s16x4 vlo0[4], vhi0[4], vlo1[4], vhi1[4];
#pragma unroll
    for (int i = 0; i < 4; ++i) { const int ro = 16 * i * VS; vlo0[i] = vtr(Vb + ro); vhi0[i] = vtr(Vb + ro + 8 * VS); vlo1[i] = vtr(Vb + 64 * VS + ro); vhi1[i] = vtr(Vb + 64 * VS + ro + 8 * VS); }
    __builtin_amdgcn_sched_barrier(0);
    float mx = p0[0];
#pragma unroll
    for (int r = 1; r < 16; ++r) mx = fmaxf(mx, p0[r]);
#pragma unroll
    for (int r = 0; r < 16; ++r) mx = fmaxf(mx, p1[r]);
    mx = fmaxf(mx, __shfl_xor(mx, 32));
    const float mn = fmaxf(m, mx); const float f = __builtin_amdgcn_exp2f(m - mn); m = mn;
    const f32x2_t mn2 = {mn, mn}; f32x2_t rs2 = {0.f, 0.f};
#pragma unroll
    for (int r = 0; r < 16; r += 2) {
        f32x2_t a = {p0[r], p0[r + 1]}, b = {p1[r], p1[r + 1]}; a = a - mn2; b = b - mn2;
        a.x = __builtin_amdgcn_exp2f(a.x); a.y = __builtin_amdgcn_exp2f(a.y); b.x = __builtin_amdgcn_exp2f(b.x); b.y = __builtin_amdgcn_exp2f(b.y);
        p0[r] = a.x; p0[r + 1] = a.y; p1[r] = b.x; p1[r + 1] = b.y; rs2 = rs2 + (a + b);
    }
    const float rs = rs2.x + rs2.y;
    l = l * f + rs;
#pragma unroll
    for (int r = 0; r < 16; ++r) { o0[r] *= f; o1[r] *= f; }
#pragma unroll
    for (int i = 0; i < 4; ++i) {
        const f32x16& pp = (i >> 1) ? p1 : p0; const int s = i & 1;
        u32x4 pw; pw.x = cvtpk(pp[8 * s + 0], pp[8 * s + 1]); pw.y = cvtpk(pp[8 * s + 2], pp[8 * s + 3]); pw.z = cvtpk(pp[8 * s + 4], pp[8 * s + 5]); pw.w = cvtpk(pp[8 * s + 6], pp[8 * s + 7]);
        const bf16x8 bfrag = __builtin_bit_cast(bf16x8, pw);
        const bf16x8 a0 = (bf16x8){vlo0[i][0], vlo0[i][1], vlo0[i][2], vlo0[i][3], vhi0[i][0], vhi0[i][1], vhi0[i][2], vhi0[i][3]};
        const bf16x8 a1 = (bf16x8){vlo1[i][0], vlo1[i][1], vlo1[i][2], vlo1[i][3], vhi1[i][0], vhi1[i][1], vhi1[i][2], vhi1[i][3]};
        o0 = __builtin_amdgcn_mfma_f32_32x32x16_bf16(a0, bfrag, o0, 0, 0, 0);
        o1 = __builtin_amdgcn_mfma_f32_32x32x16_bf16(a1, bfrag, o1, 0, 0, 0);
    }
}

struct Tiles {
    int nt, n0;
    const bf16 *k0, *v0, *pe0; int kp0, vp0;
    const bf16 *k1, *v1, *pe1; int kp1, vp1;
};
struct WaveCfg {
    const bf16* q; int qpitch;
    bf16* o; int opitch;
    int active, tlo, thi;
    int tab_off;
    int rel0;
    int qrow0;
    float m0; int has_sink;
};

template <int DQK, bool BIAS>
__device__ __forceinline__ void unit(LAS unsigned char* lds, const Tiles& TL, const WaveCfg& W, int tid) {
    constexpr int KS = DQK * 2 + 16, NKS = DQK / 16;
    const int lane = tid & 63, r32 = lane & 31, h = lane >> 5;
    const int srow = tid >> 3, sch = tid & 7;
    v4u kregA, vregA, peregA, kregB, vregB, peregB;
#define ATT_ISSUE(j_, KR, VR, PR) do { const int j__ = (j_); const bool s0 = j__ < TL.n0; const int jj = s0 ? j__ : j__ - TL.n0; \
        const bf16* kb_ = s0 ? TL.k0 : TL.k1; const bf16* vb_ = s0 ? TL.v0 : TL.v1; const int kp = s0 ? TL.kp0 : TL.kp1, vp = s0 ? TL.vp0 : TL.vp1; \
        KR = *(const GAS v4u*)(kb_ + (size_t)(64 * jj + srow) * kp + 8 * sch); VR = *(const GAS v4u*)(vb_ + (size_t)(64 * jj + srow) * vp + 8 * sch); \
        if (DQK == 96) { if (tid < 256) { const bf16* pb = s0 ? TL.pe0 : TL.pe1; PR = *(const GAS v4u*)(pb + (size_t)(64 * jj + (tid >> 2)) * 32 + 8 * (tid & 3)); } } } while (0)
#define ATT_COMMIT(buf_, KR, VR, PR) do { const int b__ = (buf_); *(LAS v4u*)(lds + L_K + b__ * L_KBUF + srow * KS + 16 * sch) = KR; \
        *(LAS v4u*)(lds + L_V + b__ * L_VBUF + (sch >> 2) * 4096 + srow * 64 + (sch & 3) * 16) = VR; \
        if (DQK == 96) { *(LAS v4u*)(lds + L_K + b__ * L_KBUF + ((tid & 255) >> 2) * KS + 128 + 16 * (tid & 3)) = PR; } } while (0)
    bf16x8 qf[NKS];
    if (W.active) {
#pragma unroll
        for (int ks = 0; ks < NKS; ++ks) qf[ks] = *(const GAS bf16x8*)(W.q + (size_t)r32 * W.qpitch + 16 * ks + 8 * h);
    } else {
#pragma unroll
        for (int ks = 0; ks < NKS; ++ks) qf[ks] = (bf16x8){0, 0, 0, 0, 0, 0, 0, 0};
    }
    float m = W.m0, l = (W.has_sink && h == 0) ? 1.0f : 0.0f;
    f32x16 o0, o1;
#pragma unroll
    for (int r = 0; r < 16; ++r) { o0[r] = 0.f; o1[r] = 0.f; }
    const int vb = ((lane >> 4) & 1) * 32 + (lane & 3) * 8 + (4 * h + ((lane & 15) >> 2)) * 64;
    const LAS float* tab = (const LAS float*)(lds + L_TAB) + W.tab_off + W.rel0 - (W.qrow0 + r32) + 4 * h;

    peregA = (v4u){0u, 0u, 0u, 0u}; peregB = peregA;
    ATT_ISSUE(0, kregA, vregA, peregA);
    if (TL.nt > 1) ATT_ISSUE(1, kregB, vregB, peregB);
    ATT_COMMIT(0, kregA, vregA, peregA); __syncthreads();
#define ATT_STEP(j_, KI, VI, PI, KC, VC, PC) do { const int j = (j_); \
        if (j + 2 < TL.nt) ATT_ISSUE(j + 2, KI, VI, PI); \
        if (W.active && j >= W.tlo && j <= W.thi) \
            tile_step<NKS, 0, BIAS>(lds + L_K + (j & 1) * L_KBUF + r32 * KS + 16 * h, 32 * KS, lds, 0, qf, tab + 64 * j, lds + L_V + (j & 1) * L_VBUF + vb, m, l, o0, o1); \
        if (j + 1 < TL.nt) ATT_COMMIT((j + 1) & 1, KC, VC, PC); \
        __syncthreads(); } while (0)
    for (int j0 = 0; j0 < TL.nt; j0 += 2) {
        ATT_STEP(j0, kregA, vregA, peregA, kregB, vregB, peregB);
        if (j0 + 1 < TL.nt) ATT_STEP(j0 + 1, kregB, vregB, peregB, kregA, vregA, peregA);
    }
#undef ATT_STEP
#undef ATT_ISSUE
#undef ATT_COMMIT
    if (W.active) {
        const float lt = l + __shfl_xor(l, 32); const float inv = 1.0f / lt;
        bf16* orow = W.o + (size_t)r32 * W.opitch;
#pragma unroll
        for (int g4 = 0; g4 < 4; ++g4) {
            u32x2 w0, w1;
            w0.x = cvtpk(o0[4 * g4] * inv, o0[4 * g4 + 1] * inv); w0.y = cvtpk(o0[4 * g4 + 2] * inv, o0[4 * g4 + 3] * inv);
            w1.x = cvtpk(o1[4 * g4] * inv, o1[4 * g4 + 1] * inv); w1.y = cvtpk(o1[4 * g4 + 2] * inv, o1[4 * g4 + 3] * inv);
            *(GAS u32x2*)(orow + 8 * g4 + 4 * h) = w0; *(GAS u32x2*)(orow + 32 + 8 * g4 + 4 * h) = w1;
        }
    }
}

template <int DQK, bool BIAS, class Src>
__device__ __forceinline__ void run(LAS unsigned char* lds, const Src& S, int tid) {
    constexpr int KS = DQK * 2 + 16, NKS = DQK / 16;
    const int lane = tid & 63, r32 = lane & 31, h = lane >> 5;
    const int srow = tid >> 3, sch = tid & 7;
    Tiles Ti; WaveCfg Wc;
    int ui = 0, ji = 0, uc = 0, jc = 0, n_issued = 0, ntc = 0;
    bool more_i, more_c;
    { WaveCfg wt_; more_i = S.get(0, Ti, wt_); } if (!more_i) return;
    { Tiles tt_; more_c = S.get(0, tt_, Wc); ntc = tt_.nt; }
    v4u kregA, vregA, peregA, kregB, vregB, peregB;
    peregA = (v4u){0u, 0u, 0u, 0u}; peregB = peregA;
#define RUN_ISSUE(KR, VR, PR) do { { const bool s0 = ji < Ti.n0; const int jj = s0 ? ji : ji - Ti.n0; \
        const bf16* kb_ = s0 ? Ti.k0 : Ti.k1; const bf16* vb_ = s0 ? Ti.v0 : Ti.v1; const int kp = s0 ? Ti.kp0 : Ti.kp1, vp = s0 ? Ti.vp0 : Ti.vp1; \
        KR = *(const GAS v4u*)(kb_ + (size_t)(64 * jj + srow) * kp + 8 * sch); VR = *(const GAS v4u*)(vb_ + (size_t)(64 * jj + srow) * vp + 8 * sch); \
        if (DQK == 96) { const bf16* pb = s0 ? Ti.pe0 : Ti.pe1; PR = *(const GAS v4u*)(pb + (size_t)(64 * jj + ((tid & 255) >> 2)) * 32 + 8 * (tid & 3)); } } \
        if (more_i) { ++n_issued; if (++ji >= Ti.nt) { ji = 0; ++ui; WaveCfg wt_; more_i = S.get(ui, Ti, wt_); } } } while (0)
#define RUN_COMMIT(buf_, KR, VR, PR) do { const int b__ = (buf_); *(LAS v4u*)(lds + L_K + b__ * L_KBUF + srow * KS + 16 * sch) = KR; \
        *(LAS v4u*)(lds + L_V + b__ * L_VBUF + (sch >> 2) * 4096 + srow * 64 + (sch & 3) * 16) = VR; \
        if (DQK == 96) { *(LAS v4u*)(lds + L_K + b__ * L_KBUF + ((tid & 255) >> 2) * KS + 128 + 16 * (tid & 3)) = PR; } } while (0)
    bf16x8 qf[NKS], qn[NKS]; float m, l; f32x16 o0, o1; const LAS float* tab;
    WaveCfg Wn; bool more_n = false; int ntn = 0;
#define RUN_QLOAD(W_, Q_) do { if ((W_).active) { _Pragma("unroll") for (int ks = 0; ks < NKS; ++ks) Q_[ks] = *(const GAS bf16x8*)((W_).q + (size_t)r32 * (W_).qpitch + 16 * ks + 8 * h); } \
        else { _Pragma("unroll") for (int ks = 0; ks < NKS; ++ks) Q_[ks] = (bf16x8){0, 0, 0, 0, 0, 0, 0, 0}; } } while (0)
#define RUN_OPEN() do { \
        m = Wc.m0; l = (Wc.has_sink && h == 0) ? 1.0f : 0.0f; _Pragma("unroll") for (int r = 0; r < 16; ++r) { o0[r] = 0.f; o1[r] = 0.f; } \
        tab = (const LAS float*)(lds + L_TAB) + Wc.tab_off + Wc.rel0 - (Wc.qrow0 + r32) + 4 * h; } while (0)
#define RUN_CLOSE() do { if (Wc.active) { const float lt = l + __shfl_xor(l, 32); const float inv = 1.0f / lt; bf16* orow = Wc.o + (size_t)r32 * Wc.opitch; \
        _Pragma("unroll") for (int g4 = 0; g4 < 4; ++g4) { u32x2 w0, w1; \
            w0.x = cvtpk(o0[4 * g4] * inv, o0[4 * g4 + 1] * inv); w0.y = cvtpk(o0[4 * g4 + 2] * inv, o0[4 * g4 + 3] * inv); \
            w1.x = cvtpk(o1[4 * g4] * inv, o1[4 * g4 + 1] * inv); w1.y = cvtpk(o1[4 * g4 + 2] * inv, o1[4 * g4 + 3] * inv); \
            *(GAS u32x2*)(orow + 8 * g4 + 4 * h) = w0; *(GAS u32x2*)(orow + 32 + 8 * g4 + 4 * h) = w1; } } } while (0)
    const int vb = ((lane >> 4) & 1) * 32 + (lane & 3) * 8 + (4 * h + ((lane & 15) >> 2)) * 64;
    RUN_ISSUE(kregA, vregA, peregA);
    RUN_ISSUE(kregB, vregB, peregB);
    RUN_COMMIT(0, kregA, vregA, peregA); __syncthreads();
    RUN_QLOAD(Wc, qf);
    RUN_OPEN();
#define RUN_STEP(s_, KI, VI, PI, KC, VC, PC) do { const int s__ = (s_); \
        RUN_ISSUE(KI, VI, PI); \
        if (jc == ntc - 1) { Tiles tt_; more_n = S.get(uc + 1, tt_, Wn); ntn = tt_.nt; if (more_n) RUN_QLOAD(Wn, qn); }     \
        if (Wc.active && jc >= Wc.tlo && jc <= Wc.thi) \
            tile_step<NKS, 0, BIAS>(lds + L_K + (s__ & 1) * L_KBUF + r32 * KS + 16 * h, 32 * KS, lds, 0, qf, tab + 64 * jc, lds + L_V + (s__ & 1) * L_VBUF + vb, m, l, o0, o1); \
        if (s__ + 1 < n_issued) RUN_COMMIT((s__ + 1) & 1, KC, VC, PC); \
        __syncthreads(); \
        if (++jc >= ntc) { RUN_CLOSE(); jc = 0; ++uc; Wc = Wn; ntc = ntn; more_c = more_n; if (more_c) { _Pragma("unroll") for (int ks = 0; ks < NKS; ++ks) qf[ks] = qn[ks]; RUN_OPEN(); } } } while (0)
    for (int s = 0; more_c; s += 2) {
        RUN_STEP(s, kregA, vregA, peregA, kregB, vregB, peregB);
        if (!more_c) break;
        RUN_STEP(s + 1, kregB, vregB, peregB, kregA, vregA, peregA);
    }
#undef RUN_STEP
#undef RUN_OPEN
#undef RUN_QLOAD
#undef RUN_CLOSE
#undef RUN_ISSUE
#undef RUN_COMMIT
}

constexpr int SD_CT = 0, SD_CTS = 272;
constexpr int SD_PE = 17408, SD_PES = 80;
constexpr int SD_K = 17408 + 2 * 5120, SD_KS = 144;
constexpr int SD_VS = 72, SD_VH = 2 * 64 * SD_VS;
constexpr int SD_V = SD_K + 4 * 64 * SD_KS;
constexpr int SD_GN = SD_V + 4 * SD_VH;
constexpr int SD_END = SD_GN + 256;
typedef float f32x4v __attribute__((ext_vector_type(4)));
__device__ __forceinline__ void sampled_unit(LAS unsigned char* lds, int b, int hg, int t0, int t1, const float* cckv, const float* cpe, const bf16* ckvs, const bf16* kpes,
                                             const bf16* wt, const float* knn, const bf16* QD, float* part, int split, int wave, int lane, int tid, int sdx = 0) {
    const int r32 = lane & 31, h = lane >> 5, l15_ = lane & 15, l4_ = lane >> 4;
    const int hp = wave >> 1, prt = wave & 1, head = hg * 4 + hp;
    bf16x8 qf[6];
    { const bf16* qp = QD + (size_t)(TP + b * 64 + 32 * (wave & 1) + r32) * 768 + head * 96;
#pragma unroll
      for (int ks = 0; ks < 6; ++ks) qf[ks] = *(const GAS bf16x8*)(qp + 16 * ks + 8 * h); }
    float m = -1e30f, l = 0.f; f32x16 o0, o1;
#pragma unroll
    for (int r = 0; r < 16; ++r) { o0[r] = 0.f; o1[r] = 0.f; }
    const int vb = ((lane >> 4) & 1) * 32 + (lane & 3) * 8 + (4 * h + ((lane & 15) >> 2)) * SD_VS;
    int srow = tid >> 3, sch = tid & 7;
    f32x4v ra, rb, rc, rd, rp;
#define SD_ISSUE(t_) do { const int tt_ = (t_); const bool c_ = tt_ < 64; \
        const GAS f32x4v* src = c_ ? (const GAS f32x4v*)(cckv + (size_t)(64 * tt_ + srow) * 128 + 16 * sch) : (const GAS f32x4v*)(ckvs + (size_t)srow * 128 + 16 * sch); \
        const GAS f32x4v* ps_ = c_ ? (const GAS f32x4v*)(cpe + (size_t)(64 * tt_ + srow) * 32 + 4 * sch) : (const GAS f32x4v*)(kpes + (size_t)srow * 32 + 4 * sch); \
        ra = src[0]; rb = src[1]; rc = src[c_ ? 2 : 0]; rd = src[c_ ? 3 : 1]; rp = *ps_; } while (0)
#define SD_COMMIT(t_, pebuf) do { v4u w0, w1; u32x2 pw; \
        if ((t_) < 64) { w0.x = cvtpk(ra.x, ra.y); w0.y = cvtpk(ra.z, ra.w); w0.z = cvtpk(rb.x, rb.y); w0.w = cvtpk(rb.z, rb.w); w1.x = cvtpk(rc.x, rc.y); w1.y = cvtpk(rc.z, rc.w); w1.z = cvtpk(rd.x, rd.y); w1.w = cvtpk(rd.z, rd.w); \
            pw.x = cvtpk(rp.x, rp.y); pw.y = cvtpk(rp.z, rp.w); } else { w0 = __builtin_bit_cast(v4u, ra); w1 = __builtin_bit_cast(v4u, rb); pw.x = __float_as_uint(rp.x); pw.y = __float_as_uint(rp.y); } \
        *(LAS v4u*)(lds + SD_CT + srow * SD_CTS + 32 * sch) = w0; *(LAS v4u*)(lds + SD_CT + srow * SD_CTS + 32 * sch + 16) = w1; \
        *(LAS u32x2*)(lds + SD_PE + (pebuf) * 64 * SD_PES + srow * SD_PES + 8 * sch) = pw; } while (0)
    ra = rb = rc = rd = rp = (f32x4v){0.f, 0.f, 0.f, 0.f};
    if (tid < 64) *(LAS float*)(lds + SD_GN + 4 * tid) = knn[tid];
    SD_ISSUE(t0);
    for (int t = t0; t < t1; ++t) {
        const int pb = (t - t0) & 1;
        asm volatile("" : "+v"(srow), "+v"(sch));
        int l15w = l15_, l4w = l4_; asm volatile("" : "+v"(l15w), "+v"(l4w));
        bf16x8 wf[4][4];
#pragma unroll
        for (int db = 0; db < 4; ++db)
#pragma unroll
            for (int ks = 0; ks < 4; ++ks) wf[db][ks] = *(const GAS bf16x8*)(wt + (size_t)(head * 128 + prt * 64 + 16 * db + l15w) * 128 + 32 * ks + 8 * l4w);
        SD_COMMIT(t, pb);
        SD_ISSUE(t + 1 < t1 ? t + 1 : t);
        __syncthreads();
#pragma unroll 1
        for (int kb = 0; kb < ((sdx & 1) ? 0 : 4); ++kb) {
            int l15 = l15_, l4 = l4_; asm volatile("" : "+v"(l15), "+v"(l4));
            f32x4v acc[4];
#pragma unroll
            for (int db = 0; db < 4; ++db) acc[db] = (f32x4v){0.f, 0.f, 0.f, 0.f};
#pragma unroll
            for (int ks = 0; ks < 4; ++ks) {
                const bf16x8 bfr = *(const LAS bf16x8*)(lds + SD_CT + (16 * kb + l15) * SD_CTS + 64 * ks + 16 * l4);
#pragma unroll
                for (int db = 0; db < 4; ++db) acc[db] = __builtin_amdgcn_mfma_f32_16x16x32_bf16(wf[db][ks], bfr, acc[db], 0, 0, 0);
            }
            const int key = 16 * kb + l15;
            if (prt == 0) {
                float ss = 0.f;
#pragma unroll
                for (int db = 0; db < 4; ++db) ss += (acc[db][0] * acc[db][0] + acc[db][1] * acc[db][1]) + (acc[db][2] * acc[db][2] + acc[db][3] * acc[db][3]);
                ss += __shfl_xor(ss, 16); ss += __shfl_xor(ss, 32);
                const float r2 = __builtin_amdgcn_rsqf(ss * (1.0f / 64.0f) + EPS);
#pragma unroll
                for (int db = 0; db < 4; ++db) { const f32x4v gn = *(const LAS f32x4v*)(lds + SD_GN + (16 * db + 4 * l4) * 4); u32x2 w; w.x = cvtpk(acc[db][0] * r2 * gn[0], acc[db][1] * r2 * gn[1]); w.y = cvtpk(acc[db][2] * r2 * gn[2], acc[db][3] * r2 * gn[3]);
                    *(LAS u32x2*)(lds + SD_K + hp * 64 * SD_KS + key * SD_KS + (16 * db + 4 * l4) * 2) = w; }
            } else {
#pragma unroll
                for (int db = 0; db < 4; ++db) { u32x2 w; w.x = cvtpk(acc[db][0], acc[db][1]); w.y = cvtpk(acc[db][2], acc[db][3]); const int dv = 16 * db + 4 * l4;
                    *(LAS u32x2*)(lds + SD_V + hp * SD_VH + (dv >> 5) * 64 * SD_VS + key * SD_VS + (dv & 31) * 2) = w; }
            }
        }
        __syncthreads();
        if (!(sdx & 2)) tile_step<4, 2, false, SD_VS>(lds + SD_K + hp * 64 * SD_KS + r32 * SD_KS + 16 * h, 32 * SD_KS, lds + SD_PE + pb * 64 * SD_PES + r32 * SD_PES + 16 * h, 32 * SD_PES, qf, nullptr, lds + SD_V + hp * SD_VH + vb, m, l, o0, o1);
    }
    __syncthreads();
#undef SD_ISSUE
#undef SD_COMMIT
    if (sdx & 8) return;
    float* P = part + ((size_t)((b * 8 + head) * NSPLIT + split)) * (64 * 66);
    const int q = 32 * (wave & 1) + r32;
#pragma unroll
    for (int g4 = 0; g4 < 4; ++g4) {
        *(GAS f32x4v*)(P + (((wave & 1) * 8 + g4) * 64 + lane) * 4) = (f32x4v){o0[4 * g4], o0[4 * g4 + 1], o0[4 * g4 + 2], o0[4 * g4 + 3]};
        *(GAS f32x4v*)(P + (((wave & 1) * 8 + 4 + g4) * 64 + lane) * 4) = (f32x4v){o1[4 * g4], o1[4 * g4 + 1], o1[4 * g4 + 2], o1[4 * g4 + 3]};
    }
    const float lt = l + __shfl_xor(l, 32);
    if (h == 0) { P[4096 + q] = m; P[4160 + q] = lt; }
}
}

constexpr int NU_BP = NB * 8 * 8, NU_BS = NB * 8, NU_AP = NB * 32 * 2, NU_AS = NB * 2, NU_L0 = NU_BP + NU_BS + NU_AP + NU_AS;
__device__ __forceinline__ int att0_unit(int c, int slot) {
    if (slot == 0 || (slot == 1 && c < 128)) { const int i = slot == 0 ? c : 256 + c; const int b = i / 48, r = i - 48 * b; return b * 64 + (r / 6) * 8 + 2 + (r % 6); }
    if (slot == 1) { if (c < 192) return NU_BP + (c - 128); const int j = c - 192; return (j >> 3) * 64 + (j & 7) * 8 + 1; }
    int a;
    if (slot == 2) { if (c >= 192) { const int j = c - 192; return (j >> 3) * 64 + (j & 7) * 8; } a = c >= 128 ? c - 128 : 64 + c; }
    else if (slot == 3) { if (c < 128) return -1; a = 192 + (c - 128); }
    else { if (c >= 208) return -1; a = 320 + c; }
    return NU_BP + NU_BS + a;
}
struct SrcL0 {
    const bf16 *QKV, *cak, *cav, *cbk, *cbv; bf16* MIX; const LAS float* sinks; int c, G, w; int cls;
    __device__ __forceinline__ int unit_of(int it) const {
        if (G == 256) { const int nu = (c < 128 || c >= 208) ? 4 : 5; if (it >= nu) return -1; return att0_unit(c, (c < 128 && it >= 3) ? it + 1 : it); }
        const int ui = c + it * G; return ui >= NU_L0 ? -1 : ui; }
    __device__ __forceinline__ bool get(int it, att::Tiles& TL, att::WaveCfg& W) const {
        const int ui = unit_of(it);
        if (ui < 0) return false;
        TL.pe0 = nullptr; TL.pe1 = nullptr; TL.k1 = nullptr; TL.v1 = nullptr; TL.kp1 = 0; TL.vp1 = 0;
        W.qpitch = EV_IN; W.opitch = DM; W.tab_off = 0; W.has_sink = 0; W.m0 = -1e30f; W.active = 1; W.qrow0 = 32 * (w & 1);
        if (ui < NU_BP + NU_BS) {
            int b, h;
            if (ui < NU_BP) {
                b = ui >> 6; h = (ui >> 3) & 7; const int cg = ui & 7; const int cw = 4 * cg + (w >> 1); const int c0 = (4 * cg - 8) > 0 ? (4 * cg - 8) : 0;
                TL.nt = 4 * cg + 4 - c0; TL.n0 = TL.nt;
                const size_t r0 = (size_t)b * SEQ + (size_t)c0 * 64;
                TL.k0 = QKV + r0 * EV_IN + 1280 + h * 64; TL.v0 = QKV + r0 * EV_IN + 1792 + h * 64; TL.kp0 = EV_IN; TL.vp0 = EV_IN;
                const size_t qr = (size_t)b * SEQ + (size_t)cw * 64 + 32 * (w & 1);
                W.q = QKV + qr * EV_IN + 768 + h * 64; W.o = MIX + qr * DM + 512 + h * 64;
                const int lo = (cw - 8) > 0 ? (cw - 8) : 0; W.tlo = lo - c0; W.thi = cw - c0; W.rel0 = (c0 - cw) * 64 + 575;
            } else {
                const int u2 = ui - NU_BP; b = u2 >> 3; h = u2 & 7;
                TL.nt = 9; TL.n0 = 8;
                TL.k0 = cbk + (size_t)b * 512 * 512 + h * 64; TL.v0 = cbv + (size_t)b * 512 * 512 + h * 64; TL.kp0 = 512; TL.vp0 = 512;
                const size_t r1 = (size_t)TP + (size_t)b * 64;
                TL.k1 = QKV + r1 * EV_IN + 1280 + h * 64; TL.v1 = QKV + r1 * EV_IN + 1792 + h * 64; TL.kp1 = EV_IN; TL.vp1 = EV_IN;
                W.active = w < 2; const size_t qr = r1 + 32 * (w & 1);
                W.q = QKV + qr * EV_IN + 768 + h * 64; W.o = MIX + qr * DM + 512 + h * 64;
                W.tlo = 0; W.thi = 8; W.rel0 = -8 * 64 + 575;
            }
            W.tab_off = 2048 + h * 640;
        } else {
            int b, kvh; const int g = w >> 1;
            if (ui < NU_BP + NU_BS + NU_AP) {
                const int u2 = ui - NU_BP - NU_BS; b = u2 >> 6; const int c_ = (u2 >> 1) & 31; kvh = u2 & 1; const int c0 = (c_ - 2) > 0 ? (c_ - 2) : 0;
                TL.nt = c_ - c0 + 1; TL.n0 = TL.nt;
                const size_t r0 = (size_t)b * SEQ + (size_t)c0 * 64;
                TL.k0 = QKV + r0 * EV_IN + 512 + kvh * 64; TL.v0 = QKV + r0 * EV_IN + 640 + kvh * 64; TL.kp0 = EV_IN; TL.vp0 = EV_IN;
                const size_t qr = (size_t)b * SEQ + (size_t)c_ * 64 + 32 * (w & 1);
                W.q = QKV + qr * EV_IN + (kvh * 4 + g) * 64; W.o = MIX + qr * DM + (kvh * 4 + g) * 64;
                W.tlo = 0; W.thi = TL.nt - 1; W.rel0 = (c0 - c_) * 64 + 191;
            } else {
                const int u2 = ui - NU_BP - NU_BS - NU_AP; b = u2 >> 1; kvh = u2 & 1;
                TL.nt = 3; TL.n0 = 2;
                TL.k0 = cak + (size_t)b * 128 * 128 + kvh * 64; TL.v0 = cav + (size_t)b * 128 * 128 + kvh * 64; TL.kp0 = 128; TL.vp0 = 128;
                const size_t r1 = (size_t)TP + (size_t)b * 64;
                TL.k1 = QKV + r1 * EV_IN + 512 + kvh * 64; TL.v1 = QKV + r1 * EV_IN + 640 + kvh * 64; TL.kp1 = EV_IN; TL.vp1 = EV_IN;
                const size_t qr = r1 + 32 * (w & 1);
                W.q = QKV + qr * EV_IN + (kvh * 4 + g) * 64; W.o = MIX + qr * DM + (kvh * 4 + g) * 64;
                W.tlo = 0; W.thi = 2; W.rel0 = -2 * 64 + 191;
            }
            W.tab_off = (kvh * 4 + g) * 256; W.has_sink = 1; W.m0 = sinks[kvh * 4 + g];
        }
        return true;
    }
};
__device__ __forceinline__ void attn_phase_l0(Frame& F, int att0_rep = 0) {
    LOCAL_IDS();
    const float* biasA = WSP(float, WS_TAB + TAB_BIASA); const float* biasB = WSP(float, WS_TAB + TAB_BIASB);
    LAS float* tab = (LAS float*)(F.lds + att::L_TAB);
    for (int i = tid; i < 2048; i += 512) tab[i] = biasA[i];
    for (int i = tid; i < 5120; i += 512) tab[2048 + i] = biasB[i];
    if (tid < 8) tab[7168 + tid] = F.in[21][tid] * LOG2E;
    __syncthreads();
    int c_ = (int)blockIdx.x, w_ = wave; asm volatile("" : "+s"(c_), "+s"(w_));
    SrcL0 S{WSP(bf16, WS_R + R_QKV), WSP(bf16, WS_R + R_CAK), WSP(bf16, WS_R + R_CAV), WSP(bf16, WS_R + R_CBK), WSP(bf16, WS_R + R_CBV), WSP(bf16, WS_R + R_MIX), (const LAS float*)tab + 7168, c_, F.G, w_, 15};
#if defined(ATT0_CLS)
    if (att0_rep) S.cls = ATT0_CLS;
#endif
    att::run<64, true, SrcL0>(F.lds, S, tid);
}

struct SrcL1 {
    const bf16 *QD, *KD, *VD, *KPE; bf16* MIX; int c, G, w;
    __device__ __forceinline__ bool get(int it, att::Tiles& TL, att::WaveCfg& W) const {
        const int upc = it >> 1, ui = c + upc * G; if (ui >= 256) return false;
        const int b = ui >> 5, h = (ui >> 2) & 7, p = ui & 3;
        const int cg = (it & 1) ? 7 - p : p; const int cw = 4 * cg + (w >> 1);
        TL.nt = 4 * cg + 4; TL.n0 = TL.nt; TL.k1 = nullptr; TL.v1 = nullptr; TL.pe1 = nullptr; TL.kp1 = 0; TL.vp1 = 0;
        const size_t r0 = (size_t)b * SEQ;
        TL.k0 = KD + r0 * 512 + h * 64; TL.v0 = VD + r0 * 512 + h * 64; TL.pe0 = KPE + r0 * 32; TL.kp0 = 512; TL.vp0 = 512;
        const size_t qr = r0 + (size_t)cw * 64 + 32 * (w & 1);
        W.q = QD + qr * 768 + h * 96; W.qpitch = 768; W.o = MIX + qr * DM + 512 + h * 64; W.opitch = DM;
        W.active = 1; W.tlo = 0; W.thi = cw; W.tab_off = 0; W.rel0 = 0; W.qrow0 = 0; W.m0 = -1e30f; W.has_sink = 0;
        return true;
    }
};
__device__ __forceinline__ void attn_phase_l1(Frame& F) {
    const bf16* QD = WSP(bf16, WS_R + R_QD); const bf16* KD = WSP(bf16, WS_R + R_KD); const bf16* VD = WSP(bf16, WS_R + R_VD); const bf16* KPE = WSP(bf16, WS_R + R_KPE);
    bf16* MIX = WSP(bf16, WS_R + R_MIX);
    LOCAL_IDS(); const int w = wave;
#if defined(REP_DP)
    for (int rep_ = 0; rep_ < REP_DP; ++rep_)
#endif
    { int c_ = (int)blockIdx.x, w_ = w; asm volatile("" : "+s"(c_), "+s"(w_));
      SrcL1 S{QD, KD, VD, KPE, MIX, c_, F.G, w_}; att::run<96, false, SrcL1>(F.lds, S, tid); }
#if defined(REP_SD)
    for (int rep_ = 0; rep_ < REP_SD; ++rep_)
#endif
    for (int ui = (int)blockIdx.x; ui < NB * 2 * NSPLIT; ui += F.G) {
        const int b = ui >> 5, hg = (ui >> 4) & 1, sp = ui & 15;
        att::sampled_unit(F.lds, b, hg, (sp * 65) >> 4, ((sp + 1) * 65) >> 4, F.in[7] + (size_t)b * PAST * 128, F.in[8] + (size_t)b * PAST * 32, WSP(bf16, WS_R + R_CKVS) + (size_t)b * 64 * 128,
#if defined(REP_SD) && defined(SDX)
                          KPE + (size_t)(TP + b * 64) * 32, WSP(bf16, WS_W + W_KVP), F.in[34], QD, rep_ == 0 ? WSP(float, WS_R + R_QA) : WSP(float, WS_R + R_PART), sp, wave, lane, tid, rep_ == 0 ? SDX : 0);
#else
                          KPE + (size_t)(TP + b * 64) * 32, WSP(bf16, WS_W + W_KVP), F.in[34], QD, WSP(float, WS_R + R_PART), sp, wave, lane, tid);
#endif
    }
}

__device__ __forceinline__ void combine_l1(Frame& F) {
    LOCAL_IDS();
    const int gw = (int)blockIdx.x * NWAVES + wave, NGW = F.G * NWAVES;
    const float* part = WSP(float, WS_R + R_PART); bf16* MIX = WSP(bf16, WS_R + R_MIX);
    for (int it = gw; it < NB * 8 * 64; it += NGW) {
        const int q = it & 63, bh = it >> 6, b = bh >> 3, head = bh & 7;
        const float* P = part + (size_t)bh * NSPLIT * (64 * 66);
        float ms[NSPLIT]; float M = -3e38f;
#pragma unroll
        for (int s = 0; s < NSPLIT; ++s) { ms[s] = P[(size_t)s * (64 * 66) + 4096 + q]; M = fmaxf(M, ms[s]); }
        float L = 0.f, O = 0.f;
#pragma unroll
        for (int s = 0; s < NSPLIT; ++s) { const float f = __builtin_amdgcn_exp2f(ms[s] - M); L += P[(size_t)s * (64 * 66) + 4160 + q] * f; O += P[(size_t)s * (64 * 66) + ((((q >> 5) * 8 + (lane >> 5) * 4 + ((lane >> 3) & 3)) * 64 + ((lane >> 2) & 1) * 32 + (q & 31)) * 4) + (lane & 3)] * f; }
        MIX[(size_t)(TP + b * 64 + q) * DM + 512 + head * 64 + lane] = (bf16)f2bf(O / L);
    }
}

__device__ __forceinline__ void side_l1(Frame& F) {
    LOCAL_IDS();
    const int gw = (int)blockIdx.x * NWAVES + wave, NGW = F.G * NWAVES;
    const bf16* KVA = WSP(bf16, WS_R + R_KVA); const float* rs = WSP(float, WS_ROWSQ + 7 * ROWSQ_STRIDE); const float* g = F.in[30];
    bf16* CKVS = WSP(bf16, WS_R + R_CKVS);
    const float g0_ = g[2 * lane], g1_ = g[2 * lane + 1];
    for (int c = gw; c < T / 8; c += NGW) {
        const int r0 = 8 * c;
        float rr[8]; unsigned pk[8];
#pragma unroll
        for (int i = 0; i < 8; ++i) { rr[i] = rs[r0 + i]; pk[i] = *(const GAS unsigned*)(KVA + (size_t)(r0 + i) * 256 + 2 * lane); }
#pragma unroll
        for (int i = 0; i < 8; ++i) {
            const int row = r0 + i;
            const float r = __builtin_amdgcn_rsqf(rr[i] * (1.0f / 128.0f) + EPS);
            const float a = __uint_as_float(pk[i] << 16) * r * g0_, b = __uint_as_float(pk[i] & 0xffff0000u) * r * g1_;
            float* dst = row < TP ? F.out + O_CKVP + (size_t)row * 128 : F.out + O_CKVS + (size_t)(row - TP) * 128;
            *(GAS f32x2v*)(dst + 2 * lane) = (f32x2v){a, b};
            if (row >= TP) *(GAS unsigned*)(CKVS + (size_t)(row - TP) * 128 + 2 * lane) = pk2(a, b);
        }
    }
    const bf16* U = WSP(bf16, WS_R + R_U); bf16* MIX = WSP(bf16, WS_R + R_MIX); const float* cw = F.in[27]; const float* st = F.in[6];
    float w0[8], w1[8], w2[8];
#pragma unroll
    for (int j = 0; j < 8; ++j) { w0[j] = cw[8 * lane + j]; w1[j] = cw[512 + 8 * lane + j]; w2[j] = cw[1024 + 8 * lane + j]; }
    for (int c = gw; c < T / 8; c += NGW) {
        const int r0 = 8 * c;
        int t0, b; const bool samp = r0 >= TP; if (!samp) { b = r0 >> 11; t0 = r0 & (SEQ - 1); } else { b = (r0 - TP) >> 6; t0 = (r0 - TP) & 63; }
        v4u ux[10], cbx[8];
#pragma unroll
        for (int i = 0; i < 8; ++i) { ux[2 + i] = *(const GAS v4u*)(U + (size_t)(r0 + i) * 512 + 8 * lane); cbx[i] = *(const GAS v4u*)(MIX + (size_t)(r0 + i) * DM + 8 * lane); }
        float h0[8], h1[8];
        if (t0 > 0) {
            ux[0] = *(const GAS v4u*)(U + (size_t)(r0 - 2) * 512 + 8 * lane); ux[1] = *(const GAS v4u*)(U + (size_t)(r0 - 1) * 512 + 8 * lane);
#pragma unroll
            for (int j = 0; j < 4; ++j) { h0[2 * j] = __uint_as_float(ux[0][j] << 16); h0[2 * j + 1] = __uint_as_float(ux[0][j] & 0xffff0000u); h1[2 * j] = __uint_as_float(ux[1][j] << 16); h1[2 * j + 1] = __uint_as_float(ux[1][j] & 0xffff0000u); }
        } else {
#pragma unroll
            for (int j = 0; j < 8; ++j) { h0[j] = samp ? st[(size_t)(b * 2 + 0) * 512 + 8 * lane + j] : 0.f; h1[j] = samp ? st[(size_t)(b * 2 + 1) * 512 + 8 * lane + j] : 0.f; }
        }
#pragma unroll
        for (int i = 0; i < 8; ++i) {
            float u2[8], cb[8];
#pragma unroll
            for (int j = 0; j < 4; ++j) { u2[2 * j] = __uint_as_float(ux[2 + i][j] << 16); u2[2 * j + 1] = __uint_as_float(ux[2 + i][j] & 0xffff0000u);
                                          cb[2 * j] = __uint_as_float(cbx[i][j] << 16); cb[2 * j + 1] = __uint_as_float(cbx[i][j] & 0xffff0000u); }
            v4u o;
#pragma unroll
            for (int j = 0; j < 4; ++j) { const float y0 = cb[2 * j] * (w0[2 * j] * h0[2 * j] + w1[2 * j] * h1[2 * j] + w2[2 * j] * u2[2 * j]);
                const float y1 = cb[2 * j + 1] * (w0[2 * j + 1] * h0[2 * j + 1] + w1[2 * j + 1] * h1[2 * j + 1] + w2[2 * j + 1] * u2[2 * j + 1]); o[j] = pk2(y0, y1); }
            *(GAS v4u*)(MIX + (size_t)(r0 + i) * DM + 8 * lane) = o;
#pragma unroll
            for (int j = 0; j < 8; ++j) { h0[j] = h1[j]; h1[j] = u2[j]; }
        }
    }
}


__device__ __forceinline__ void mini_resid(Frame& F, const bf16* A, const bf16* Bt, int K, float alpha, bool first, bool last, int rsi) {
    LOCAL_IDS();
    typedef float f32x16 __attribute__((ext_vector_type(16)));
    const int r32 = lane & 31, h = lane >> 5;
    float* const X = F.out; bf16* const XB = WSP(bf16, WS_XB); float* const rowsq = WSP(float, WS_ROWSQ + (size_t)rsi * ROWSQ_STRIDE);
    (void)first;
    LAS float* red = (LAS float*)(F.lds + RING_OFF);
    for (int mt = (int)blockIdx.x; mt < 256; mt += F.G) {
        const int rt = mt >> 4, ct = mt & 15;
        LAS unsigned char* const sA = F.lds + RING_OFF + wave * 13824; LAS unsigned char* const sB = sA + 32 * 144;
        const int crow = lane >> 3, cseg = lane & 7;
        const bf16* ag = A + (size_t)(32 * rt + crow) * K + 8 * cseg;
        const bf16* bg = Bt + (size_t)(64 * ct + crow) * K + 8 * cseg;
        const int ng = K >> 6, g0 = (ng * wave) >> 3, g1 = (ng * (wave + 1)) >> 3;
        f32x16 c0, c1;
#pragma unroll
        for (int r = 0; r < 16; ++r) { c0[r] = 0.f; c1[r] = 0.f; }
        v4u ra[4], rb[8];
#define MINI_LOAD(g_) do { _Pragma("unroll") for (int i = 0; i < 4; ++i) ra[i] = *(const GAS v4u*)(ag + (size_t)(8 * i) * K + 64 * (g_)); \
                           _Pragma("unroll") for (int i = 0; i < 8; ++i) rb[i] = *(const GAS v4u*)(bg + (size_t)(8 * i) * K + 64 * (g_)); } while (0)
#if defined(REP_MINI)
        for (int rep_ = 0; rep_ < REP_MINI; ++rep_) {
        if (rep_ > 0) { asm volatile("" : "+v"(c0), "+v"(c1));
#pragma unroll
            for (int r = 0; r < 16; ++r) { c0[r] = 0.f; c1[r] = 0.f; } }
#endif
        if (g0 < g1) MINI_LOAD(g0);
        for (int g = g0; g < g1; ++g) {
#pragma unroll
            for (int i = 0; i < 4; ++i) *(LAS v4u*)(sA + (crow + 8 * i) * 144 + 16 * cseg) = ra[i];
#pragma unroll
            for (int i = 0; i < 8; ++i) *(LAS v4u*)(sB + (crow + 8 * i) * 144 + 16 * cseg) = rb[i];
            if (g + 1 < g1) MINI_LOAD(g + 1);
            bf16x8 a[4], x[4], y[4];
#pragma unroll
            for (int ks = 0; ks < 4; ++ks) { a[ks] = *(const LAS bf16x8*)(sA + r32 * 144 + 32 * ks + 16 * h); x[ks] = *(const LAS bf16x8*)(sB + r32 * 144 + 32 * ks + 16 * h); y[ks] = *(const LAS bf16x8*)(sB + (32 + r32) * 144 + 32 * ks + 16 * h); }
#pragma unroll
            for (int ks = 0; ks < 4; ++ks) { c0 = __builtin_amdgcn_mfma_f32_32x32x16_bf16(a[ks], x[ks], c0, 0, 0, 0); c1 = __builtin_amdgcn_mfma_f32_32x32x16_bf16(a[ks], y[ks], c1, 0, 0, 0); }
        }
#if defined(REP_MINI)
        }
#endif
#undef MINI_LOAD
        __syncthreads();
#pragma unroll
        for (int r = 0; r < 16; ++r) { const int i = (r & 3) + 8 * (r >> 2) + 4 * h; red[wave * 2048 + i * 64 + r32] = c0[r]; red[wave * 2048 + i * 64 + 32 + r32] = c1[r]; }
        __syncthreads();
        {
            const int i = tid >> 4, j4 = 4 * (tid & 15);
            f32x4 v = (f32x4){0.f, 0.f, 0.f, 0.f};
#pragma unroll
            for (int w = 0; w < 8; ++w) v += *(const LAS f32x4*)(red + w * 2048 + i * 64 + j4);
            const int a8 = (j4 & 31) >> 2; const int col = 64 * ct + (j4 & 32) + 8 * (a8 & 3) + 4 * (a8 >> 2);
            const int srow = 32 * rt + i; const size_t row = (size_t)TP + srow;
            const u32x2t xo2 = *(const GAS u32x2t*)(XB + row * DM + col);
            const f32x4 xo = (f32x4){__uint_as_float(xo2.x << 16), __uint_as_float(xo2.x & 0xffff0000u), __uint_as_float(xo2.y << 16), __uint_as_float(xo2.y & 0xffff0000u)};
            const f32x4 xn = xo + v * alpha;
            if (last) *(GAS f32x4*)(X + row * DM + col) = xn;
            else {
                *(GAS u32x2t*)(XB + row * DM + col) = (u32x2t){pk2(xn.x, xn.y), pk2(xn.z, xn.w)};
                float ss = (xn.x * xn.x + xn.y * xn.y) + (xn.z * xn.z + xn.w * xn.w);
                ss += __shfl_xor(ss, 1); ss += __shfl_xor(ss, 2); ss += __shfl_xor(ss, 4); ss += __shfl_xor(ss, 8);
                if ((tid & 15) == 0) atomicAdd(rowsq + row, ss);
            }
        }
        __syncthreads();
    }
}

struct Args { const float* in[36]; float* out; unsigned char* ws; int ph_lo, ph_hi; };
constexpr int NPHASE = 17;
__global__ void __launch_bounds__(NWAVES * 64, 2) enc_fwd(Args args) {
    extern __shared__ __attribute__((aligned(16))) unsigned char lds[];
    Frame F;
    F.lds = (LAS unsigned char*)lds;
    F.MISC = (volatile LAS unsigned*)(F.lds + MISC_OFF);
    F.wave_s = __builtin_amdgcn_readfirstlane((int)threadIdx.x >> 6);
    F.G = gridDim.x; { const int bx = blockIdx.x; F.vcu = (F.G % 8 == 0) ? (bx % 8) * (F.G / 8) + bx / 8 : bx; }
    F.in = args.in; F.out = args.out; F.ws = args.ws; F.ctl = (gu32*)(args.ws + WS_CTL);
    for (int u = threadIdx.x; u < (LDS_BYTES - LDSCTL_OFF) / 4; u += NWAVES * 64) ((LAS unsigned*)(F.lds + LDSCTL_OFF))[u] = 0u;
    __syncthreads();
    const int lo = args.ph_lo, hi = args.ph_hi;
    const bool use_bar = (hi - lo) > 1;
    XcdBarrier bar; bar.bar = (unsigned*)(F.ctl + CW_BAR); bar.x = 0; bar.st = nullptr;
    if (use_bar) bar = xcd_barrier_post((unsigned*)(F.ctl + CW_BAR), F.MISC + 8);
    bar.w0 = (F.wave_s == 0) ? 1u : 0u;
#if defined(REPEAT_MASK)
    int rep_done = 0;
#endif
#pragma unroll 1
    for (int ph = lo; ph < hi; ++ph) {
        int z = 0; asm volatile("" : "+s"(z));
        F.in = args.in + z; F.out = args.out + z; F.ws = args.ws + z;
        bf16* XB = WSP(bf16, WS_XB); bf16* H = WSP(bf16, WS_R + R_H); bf16* MIX = WSP(bf16, WS_R + R_MIX);
        (void)XB;
        int kind, l = 0, f = 0;
        switch (ph) {
            case 0: kind = 0; break;
            case 1: kind = 1; l = 0; f = 0; break;   case 2: kind = 2; l = 0; f = 0; break;
            case 3: kind = 3; break;                 case 4: kind = 4; break;                 case 5: kind = 5; l = 0; break;
            case 6: kind = 1; l = 0; f = 1; break;   case 7: kind = 2; l = 0; f = 1; break;
            case 8: kind = 1; l = 1; f = 0; break;   case 9: kind = 2; l = 1; f = 0; break;
            case 10: kind = 6; break;                case 11: kind = 7; break;                case 12: kind = 8; break;   case 13: kind = 9; break;   case 14: kind = 5; l = 1; break;
            case 15: kind = 1; l = 1; f = 1; break;  default: kind = 2; l = 1; f = 1; break;
        }
        if (kind == 0) { p0_prologue(F); }
        else if (kind == 1) {
            pg8::Gemm g{XB, WSP(bf16, WS_W + W_GU0 + (size_t)(l * 2 + f) * W_GU_BYTES), T, NGU, DM}; pg8::StaticOrder S; S.init(T, NGU, F.G, (int)blockIdx.x);
#if defined(REPEAT_NULL)
            if (rep_done) { ep::EpiNull E0; pg8::gemm_phase<ep::EpiNull, pg8::StaticOrder, true, true>(F.lds + RING_OFF, g, S, E0, F.wave_s); } else
#endif
            { ep::EpiGU E{ep::Ctx{F.ws, F.out, F.in}, 3 * l + 2 * f};
            pg8::gemm_phase<ep::EpiGU, pg8::StaticOrder, true, true>(F.lds + RING_OFF, g, S, E, F.wave_s); }
            if (F.G == 256) { if (ph == 1) wconv_set(F, WSET_PH1, 172, 84); else if (ph == 6) wconv_set(F, WSET_PH6, 172, 84); }
            else { if (ph == 1) wconv_set(F, WSET_PH1, 0, F.G); else if (ph == 6) wconv_set(F, WSET_PH6, 0, F.G); }
        } else if (kind == 2 || kind == 5) {
            const bool isout = kind == 5; const bool first = (!isout && l == 0 && f == 0), last = (!isout && l == 1 && f == 1);
            pg8::Gemm g; g.A = isout ? MIX : H; g.Bt = isout ? WSP(bf16, WS_W + (l ? W_ODOUT : W_EVOUT)) : WSP(bf16, WS_W + W_D0 + (size_t)(l * 2 + f) * W_D_BYTES); g.M = TP; g.N = DM; g.K = isout ? DM : FF;
            pg8::StaticOrder S; S.init(TP, DM, F.G, (int)blockIdx.x);
            int rsi = isout ? 3 * l + 2 : (f == 0 ? 3 * l + 1 : 3 * (l + 1));
#if defined(REPEAT_MASK)
            if (rep_done) rsi = 8;
#endif
            ep::EpiResid E; E.C = ep::Ctx{F.ws, F.out, F.in}; E.last = last; E.rsi = rsi; E.alpha = isout ? 1.0f : 0.5f; (void)first;
            pg8::gemm_phase<ep::EpiResid, pg8::StaticOrder, true, true>(F.lds + RING_OFF, g, S, E, F.wave_s);
            mini_resid(F, g.A + (size_t)TP * g.K, g.Bt, g.K, E.alpha, first, last, rsi);
        } else if (kind == 3) {
            pg8::Gemm g{XB, WSP(bf16, WS_W + W_EVIN), T, EV_IN, DM}; pg8::StaticOrder S; S.init(T, EV_IN, F.G, (int)blockIdx.x);
            ep::EpiEvIn E{ep::Ctx{F.ws, F.out, F.in}};
            pg8::gemm_phase<ep::EpiEvIn, pg8::StaticOrder, true, true>(F.lds + RING_OFF, g, S, E, F.wave_s);
            if (F.G == 256) { wconv_set(F, WSET_PH3, 82, 174); p0_aux(F, 82, 174); } else { wconv_set(F, WSET_PH3, 0, F.G); p0_aux(F, 0, F.G); }
#if defined(REPEAT_MASK)
        } else if (kind == 4) { attn_phase_l0(F, rep_done); }
#else
        } else if (kind == 4) { attn_phase_l0(F); }
#endif
        else if (kind == 6) {
            pg8::Gemm g{XB, WSP(bf16, WS_W + W_ODIN), T, OD_INP, DM}; pg8::StaticOrder S; S.init(T, OD_INP, F.G, (int)blockIdx.x);
            ep::EpiOdIn E{ep::Ctx{F.ws, F.out, F.in}};
            pg8::gemm_phase<ep::EpiOdIn, pg8::StaticOrder, true, true>(F.lds + RING_OFF, g, S, E, F.wave_s);
        } else if (kind == 7) {
            side_l1(F);
            { pg8::Gemm g{WSP(bf16, WS_R + R_QA), WSP(bf16, WS_W + W_QB), T, 768, 256}; pg8::StaticOrder S; S.init(T, 768, F.G, (int)blockIdx.x);
              ep::EpiQb E{ep::Ctx{F.ws, F.out, F.in}};
              pg8::gemm_phase<ep::EpiQb, pg8::StaticOrder, true, true>(F.lds + RING_OFF, g, S, E, F.wave_s); }
            { pg8::Gemm g{WSP(bf16, WS_R + R_KVA), WSP(bf16, WS_W + W_KVB), TP, 1024, 256}; pg8::StaticOrder S; S.init(TP, 1024, F.G, (int)blockIdx.x);
              ep::EpiKvb E{ep::Ctx{F.ws, F.out, F.in}};
              pg8::gemm_phase<ep::EpiKvb, pg8::StaticOrder, true, true>(F.lds + RING_OFF, g, S, E, F.wave_s); }
        } else if (kind == 8) { attn_phase_l1(F); }
        else { combine_l1(F); }
#if defined(REPEAT_MASK)
        if (((REPEAT_MASK >> ph) & 1) && !rep_done) { rep_done = 1; xcd_barrier(bar); --ph; continue; }
        rep_done = 0;
#endif
        if (ph + 1 < hi) xcd_barrier(bar);
    }
}

#ifndef MK_MULTI
#define MK_MULTI 0
#endif
extern "C" void kernel_launch(void* const* d_in, const int* in_sizes, int n_in, void* d_out, int out_size, void* d_ws, size_t ws_size, hipStream_t stream) {
    static int grid = 0;
    if (grid == 0) {
        if (n_in != 36 || (size_t)out_size != O_END || ws_size < WS_END) { fprintf(stderr, "kernel_launch: unexpected shapes: n_in %d out %d ws %zu (need %zu)\n", n_in, out_size, ws_size, (size_t)WS_END); grid = -1; return; }
        int dev = 0, cus = 0;
        if (hipGetDevice(&dev) != hipSuccess || hipDeviceGetAttribute(&cus, hipDeviceAttributeMultiprocessorCount, dev) != hipSuccess) { grid = -1; return; }
        if (hipFuncSetAttribute((const void*)enc_fwd, hipFuncAttributeMaxDynamicSharedMemorySize, LDS_BYTES) != hipSuccess) { grid = -1; return; }
        grid = cus;
    }
    if (grid < 0) return;
    if (hipMemsetAsync((char*)d_ws + WS_CTL, 0, CTL_ZERO_BYTES, stream) != hipSuccess) return;
    Args a{};
    for (int i = 0; i < 36; ++i) a.in[i] = (const float*)d_in[i];
    a.out = (float*)d_out; a.ws = (unsigned char*)d_ws;
#if MK_MULTI
    for (int p = 0; p < NPHASE; ++p) { a.ph_lo = p; a.ph_hi = p + 1; hipLaunchKernelGGL(enc_fwd, dim3(grid), dim3(NWAVES * 64), LDS_BYTES, stream, a); }
#else
    a.ph_lo = 0; a.ph_hi = NPHASE;
    { void* kargs[] = {(void*)&a};
      if (hipLaunchCooperativeKernel((const void*)enc_fwd, dim3(grid), dim3(NWAVES * 64), kargs, LDS_BYTES, stream) != hipSuccess) fprintf(stderr, "kernel_launch: cooperative launch failed (grid %d)\n", grid); }
#endif
}
```
